# Optimizing an MI355X kernel written in HIP

```python
import math
import jax, jax.numpy as jnp
from jax import lax
import numpy as np

D_MODEL = 1024
BATCH = 8
SEQ = 4096
DEPTH = 2

N_A_LAYERS = DEPTH // 2
N_B_LAYERS = DEPTH - N_A_LAYERS
HGRN_HEADS = 8
HGRN_DK = D_MODEL // HGRN_HEADS
HGRN_DV = D_MODEL // HGRN_HEADS
HGRN_CHUNK = 64
DIFF_HEADS = 8
DIFF_DH = D_MODEL // (2 * DIFF_HEADS)
DIFF_DV = 2 * DIFF_DH
Q_BLOCK = 128
N_EXPERTS = 16
N_GROUPS = 4
EXPERTS_PER_GROUP = N_EXPERTS // N_GROUPS
TOP_K = 2
D_EXPERT = 512
MOE_BLOCK = 128
DEEPNORM_ALPHA = (2.0 * DEPTH) ** 0.25
DEEPNORM_BETA = (8.0 * DEPTH) ** -0.25
LN_EPS = 1e-5
RMS_EPS = 1e-6

kernel_name = "yoco_hgrn2_diffattn_grouped_moe"


def layer_norm(x, g, b):
    xf = x.astype(jnp.float32)
    mu = jnp.mean(xf, axis=-1, keepdims=True)
    var = jnp.mean(jnp.square(xf - mu), axis=-1, keepdims=True)
    return ((xf - mu) * lax.rsqrt(var + LN_EPS) * g + b).astype(x.dtype)


def rms_norm(xf, g):
    return xf * lax.rsqrt(jnp.mean(jnp.square(xf), axis=-1, keepdims=True) + RMS_EPS) * g


def hgrn2_mixer(x, w_in, lb, norm_g, w_out):
    B, S, _ = x.shape
    H, DK, DV, C = HGRN_HEADS, HGRN_DK, HGRN_DV, HGRN_CHUNK
    f32 = jnp.float32
    proj = jnp.einsum('bsd,de->bse', x, w_in)
    q, fl, v, g = jnp.split(proj, 4, axis=-1)
    f = lb + (1.0 - lb) * jax.nn.sigmoid(fl.astype(f32))
    log_f = jnp.log(f)
    k = 1.0 - f

    def to_chunks(t):
        return t.astype(f32).reshape(B, S // C, C, H, t.shape[-1] // H).transpose(1, 0, 3, 2, 4)

    causal = jnp.tril(jnp.ones((C, C), dtype=bool))

    def step(state, inp):
        qc, kc, vc, lfc = inp
        b = jnp.cumsum(lfc, axis=2)
        ref = b[:, :, C // 2 - 1:C // 2, :]
        scores = jnp.einsum('bhtd,bhsd->bhts', qc * jnp.exp(b - ref), kc * jnp.exp(ref - b))
        scores = jnp.where(causal, scores, 0.0)
        o = (jnp.einsum('bhts,bhsv->bhtv', scores, vc)
             + jnp.einsum('bhtd,bhdv->bhtv', qc * jnp.exp(b), state))
        b_last = b[:, :, -1:, :]
        new_state = (jnp.exp(b_last)[:, :, 0, :, None] * state
                     + jnp.einsum('bhsd,bhsv->bhdv', kc * jnp.exp(b_last - b), vc))
        return new_state, o

    state0 = jnp.zeros((B, H, DK, DV), f32)
    _, o = lax.scan(step, state0, (to_chunks(q), to_chunks(k), to_chunks(v), to_chunks(log_f)))
    o = o.transpose(1, 0, 3, 2, 4).reshape(B, S, H, DV)
    o = rms_norm(o, norm_g).reshape(B, S, H * DV) * jax.nn.sigmoid(g.astype(f32))
    return jnp.einsum('bse,ed->bsd', o.astype(x.dtype), w_out)


def shared_kv(x, kv_w):
    B, S, _ = x.shape
    kv = jnp.einsum('bsd,de->bse', x, kv_w)
    kpart, vpart = jnp.split(kv, [2 * DIFF_HEADS * DIFF_DH], axis=-1)
    k = kpart.reshape(B, S, DIFF_HEADS, 2, DIFF_DH).transpose(0, 2, 3, 1, 4)
    v = vpart.reshape(B, S, DIFF_HEADS, DIFF_DV).transpose(0, 2, 1, 3)
    return k, v


def diff_attention(x, k, v, w_q, lam, subln_g, w_out, lambda_init):
    B, S, _ = x.shape
    H, DH, DV = DIFF_HEADS, DIFF_DH, DIFF_DV
    NB = S // Q_BLOCK
    q = jnp.einsum('bsd,de->bse', x, w_q).reshape(B, S, H, 2, DH).transpose(0, 2, 3, 1, 4)
    q = q * (DH ** -0.5)
    lamf = lam.astype(jnp.float32)
    lam_val = (jnp.exp(jnp.sum(lamf[0] * lamf[1])) - jnp.exp(jnp.sum(lamf[2] * lamf[3]))
               + lambda_init)
    q_blocks = q.reshape(B, H, 2, NB, Q_BLOCK, DH).transpose(3, 0, 1, 2, 4, 5)
    kpos = jnp.arange(S)

    def attend(inp):
        qb, bi = inp
        qpos = bi * Q_BLOCK + jnp.arange(Q_BLOCK)
        s = jnp.einsum('bhcqd,bhckd->bhcqk', qb, k).astype(jnp.float32)
        s = jnp.where(kpos[None, :] <= qpos[:, None], s, -jnp.inf)
        p = jax.nn.softmax(s, axis=-1)
        a = p[:, :, 0] - lam_val * p[:, :, 1]
        return jnp.einsum('bhqk,bhkv->bhqv', a.astype(v.dtype), v)

    o = lax.map(attend, (q_blocks, jnp.arange(NB)))
    o = o.transpose(1, 0, 3, 2, 4).reshape(B, S, H, DV).astype(jnp.float32)
    o = rms_norm(o, subln_g) * (1.0 - lambda_init)
    return jnp.einsum('bse,ed->bsd', o.reshape(B, S, H * DV).astype(x.dtype), w_out)


def moe_ffn(x, router_w, router_b, w_gate, w_up, w_down):
    B, S, D = x.shape
    NB = S // MOE_BLOCK
    xb = x.reshape(B, NB, MOE_BLOCK, D).transpose(1, 0, 2, 3).reshape(NB, B * MOE_BLOCK, D)
    expert_group = jnp.arange(N_EXPERTS) // EXPERTS_PER_GROUP

    def block(xt):
        probs = jax.nn.softmax((xt @ router_w).astype(jnp.float32), axis=-1)
        sel = probs + router_b
        gscore = lax.top_k(sel.reshape(-1, N_GROUPS, EXPERTS_PER_GROUP), TOP_K)[0].sum(-1)
        gbest = jnp.argmax(gscore, axis=-1)
        in_group = expert_group[None, :] == gbest[:, None]
        _, idx = lax.top_k(jnp.where(in_group, sel, -jnp.inf), TOP_K)
        gates = jnp.take_along_axis(probs, idx, axis=-1)
        gates = gates / jnp.sum(gates, axis=-1, keepdims=True)
        comb = jnp.sum(jax.nn.one_hot(idx, N_EXPERTS, dtype=jnp.float32) * gates[..., None], axis=1)
        h = (jax.nn.silu(jnp.einsum('td,edf->tef', xt, w_gate))
             * jnp.einsum('td,edf->tef', xt, w_up))
        h = h * comb[:, :, None].astype(h.dtype)
        return jnp.einsum('tef,efd->td', h, w_down)

    y = lax.map(block, xb)
    return y.reshape(NB, B, MOE_BLOCK, D).transpose(1, 0, 2, 3).reshape(B, S, D)


def setup_inputs(seed: int = 0) -> dict:
    key = jax.random.key(seed)
    ks = jax.random.split(key, 20)
    D = D_MODEL
    nrm = jax.random.normal
    f32 = jnp.float32
    d_a = HGRN_HEADS * HGRN_DK
    d_bq = 2 * DIFF_HEADS * DIFF_DH
    d_bv = DIFF_HEADS * DIFF_DV
    return {
        "x": nrm(ks[0], (BATCH, SEQ, D), f32),
        "a_w_in": nrm(ks[1], (N_A_LAYERS, D, 4 * d_a), f32) * D ** -0.5,
        "a_lb": nrm(ks[2], (N_A_LAYERS + 1, d_a), f32) * 0.1,
        "a_norm_g": 1.0 + 0.02 * nrm(ks[3], (N_A_LAYERS, HGRN_HEADS, HGRN_DV), f32),
        "a_w_out": nrm(ks[4], (N_A_LAYERS, d_a, D), f32) * d_a ** -0.5 * DEEPNORM_BETA,
        "kv_w": nrm(ks[5], (D, d_bq + d_bv), f32) * D ** -0.5,
        "b_w_q": nrm(ks[6], (N_B_LAYERS, D, d_bq), f32) * D ** -0.5,
        "b_lam": nrm(ks[7], (N_B_LAYERS, 4, DIFF_DH), f32) * 0.1,
        "b_subln_g": 1.0 + 0.02 * nrm(ks[8], (N_B_LAYERS, DIFF_DV), f32),
        "b_w_out": nrm(ks[9], (N_B_LAYERS, d_bv, D), f32) * d_bv ** -0.5 * DEEPNORM_BETA,
        "ln1_g": 1.0 + 0.02 * nrm(ks[10], (DEPTH, D), f32),
        "ln1_b": 0.02 * nrm(ks[11], (DEPTH, D), f32),
        "ln2_g": 1.0 + 0.02 * nrm(ks[12], (DEPTH, D), f32),
        "ln2_b": 0.02 * nrm(ks[13], (DEPTH, D), f32),
        "router_w": nrm(ks[14], (D, N_EXPERTS), f32) * D ** -0.5,
        "router_b": 0.01 * nrm(ks[15], (N_EXPERTS,), f32),
        "moe_w_gate": nrm(ks[16], (DEPTH, N_EXPERTS, D, D_EXPERT), f32) * D ** -0.5,
        "moe_w_up": nrm(ks[17], (DEPTH, N_EXPERTS, D, D_EXPERT), f32) * D ** -0.5,
        "moe_w_down": nrm(ks[18], (DEPTH, N_EXPERTS, D_EXPERT, D), f32) * D_EXPERT ** -0.5 * DEEPNORM_BETA,
    }


def reference(x, a_w_in, a_lb, a_norm_g, a_w_out, kv_w, b_w_q, b_lam, b_subln_g, b_w_out,
              ln1_g, ln1_b, ln2_g, ln2_b, router_w, router_b, moe_w_gate, moe_w_up, moe_w_down):
    lb_all = jnp.cumsum(jax.nn.softmax(a_lb.astype(jnp.float32), axis=0), axis=0)
    k_sh, v_sh = None, None
    for l in range(DEPTH):
        if l < N_A_LAYERS:
            mix = hgrn2_mixer(x, a_w_in[l], lb_all[l], a_norm_g[l], a_w_out[l])
        else:
            if l == N_A_LAYERS:
                k_sh, v_sh = shared_kv(x, kv_w)
            j = l - N_A_LAYERS
            lambda_init = 0.8 - 0.6 * math.exp(-0.3 * l)
            mix = diff_attention(x, k_sh, v_sh, b_w_q[j], b_lam[j], b_subln_g[j], b_w_out[j],
                                 lambda_init)
        x = layer_norm(DEEPNORM_ALPHA * x + mix, ln1_g[l], ln1_b[l])
        ffn = moe_ffn(x, router_w, router_b, moe_w_gate[l], moe_w_up[l], moe_w_down[l])
        x = layer_norm(DEEPNORM_ALPHA * x + ffn, ln2_g[l], ln2_b[l])
    return x
```

```cpp
#include <hip/hip_runtime.h>
#include <hip/hip_bf16.h>
#include <cstdio>
#include <cstdint>
#include <cmath>

namespace pg8 {
#define PG8_LAS __attribute__((address_space(3)))
typedef unsigned short bf16_t;
typedef short bf16x8 __attribute__((ext_vector_type(8)));
typedef float f32x4 __attribute__((ext_vector_type(4)));
typedef float f32x2 __attribute__((ext_vector_type(2)));
typedef unsigned u32x4 __attribute__((ext_vector_type(4)));
typedef unsigned u32x2 __attribute__((ext_vector_type(2)));
constexpr int BM = 256, BK = 64, HALF = 128, HTB = HALF * BK * 2  , STAGE_BYTES = 8 * HTB, NXCD = 8, WGM = 8;

__host__ __device__ __forceinline__ int lds_byte(int r, int c) { const int st = (r >> 4) * 2 + (c >> 5), rr = r & 15, cc = c & 31, ob = rr * 64 + cc * 2; return st * 1024 + (ob ^ (((ob >> 9) & 1) << 5)); }
__host__ __device__ __forceinline__ void stage_rc(int b, int& R, int& C) { const int st = b / 1024, sb = b % 1024, swz = sb ^ (((sb >> 9) & 1) << 5); R = (st >> 1) * 16 + swz / 64; C = (st & 1) * 32 + (swz % 64) / 2; }
__host__ __device__ __forceinline__ int perm32(int rho) { const int n = rho >> 4, i = rho & 15; return 8 * (i >> 2) + 4 * n + (i & 3); }

struct Unit { int pm, pn, e, row0, cnt, slot0; };
struct Gemm { const bf16_t* A; const bf16_t* Bt; int K; };

struct StaticOrder {
    int nM, nN, nwg, G, c, K;
    __device__ void init(int M, int N, int K_, int G_, int c_) { nM = M / BM; nN = N / BM; nwg = nM * nN; G = G_; c = c_; K = K_; }
    __device__ bool next(int i, Unit& u) const {
        const long L = (long)i * G + c; if (L >= nwg) return false;
        int wgid = (int)L; { const int q = nwg / NXCD, r = nwg % NXCD, xcd = wgid % NXCD, off = wgid / NXCD; wgid = (xcd < r ? xcd * (q + 1) : r * (q + 1) + (xcd - r) * q) + off; }
        const int nig = WGM * nN, gid = wgid / nig, fm = gid * WGM, gsz = (nM - fm) < WGM ? (nM - fm) : WGM;
        u.pm = fm + ((wgid % nig) % gsz); u.pn = (wgid % nig) / gsz; u.e = 0; u.row0 = 0; u.cnt = BM; u.slot0 = u.pm * BM; return true;
    }
    __device__ __forceinline__ int a_row(const Unit& u, int r) const { return u.pm * BM + r; }
    __device__ __forceinline__ size_t b_off(const Unit& u) const { return (size_t)u.pn * BM * K; }
};
struct MoeOrder {
    const PG8_LAS int* tab; int G, c, total, K; const int* dest; size_t wstride; bool gather;
    __device__ bool next(int i, Unit& u) const {
        const int L = i * G + c; if (L >= total) return false;
        const int rt = L >> 2; int e = 0;
#pragma unroll
        for (int j = 1; j < 16; ++j) e += (rt >= tab[j]) ? 1 : 0;
        u.e = e; u.row0 = (rt - tab[e]) * BM; u.cnt = tab[34 + e]; u.slot0 = tab[17 + e] + u.row0; u.pm = 0; u.pn = L & 3; return true;
    }
    __device__ __forceinline__ int a_row(const Unit& u, int r) const {
        if (!gather) return u.slot0 + r;
        const int idx = u.row0 + r; return idx < u.cnt ? (dest[u.e * 32768 + idx] >> 1) : 0;
    }
    __device__ __forceinline__ size_t b_off(const Unit& u) const { return (size_t)u.e * wstride + (size_t)u.pn * BM * K; }
};

__device__ __forceinline__ unsigned cvt_pk_bf16(float lo, float hi) { unsigned r; asm volatile("v_cvt_pk_bf16_f32 %0, %1, %2" : "=v"(r) : "v"(lo), "v"(hi)); return r; }
__device__ __forceinline__ float bf_lo(unsigned u) { return __uint_as_float(u << 16); }
__device__ __forceinline__ float bf_hi(unsigned u) { return __uint_as_float(u & 0xffff0000u); }
__device__ __forceinline__ float sigmoidf_(float x) { return __builtin_amdgcn_rcpf(1.0f + __expf(-x)); }
__device__ __forceinline__ unsigned cvt_pk_f16(float lo, float hi) { typedef __fp16 h2 __attribute__((ext_vector_type(2))); h2 v = __builtin_amdgcn_cvt_pkrtz(lo, hi); return __builtin_bit_cast(unsigned, v); }

struct EpiBf16 {
    static constexpr bool PERM = true;
    bf16_t* O; int ldc; int split_cols; size_t split_stride; float scale0;
    __device__ __forceinline__ void operator()(const f32x4 (&acc)[2][2][4][2], const Unit& u, int wr, int wc, int fr, int fq) const {
        const int row0 = u.pm * BM + wr * 64 + fr; int colt = u.pn * BM; bf16_t* base = O;
        float sc = 1.f; if (split_cols) { const int t = colt / split_cols; base += (size_t)t * split_stride; colt -= t * split_cols; if (t == 0) sc = scale0; }
        const int col0 = colt + wc * 32 + 8 * fq;
#pragma unroll
        for (int ai = 0; ai < 2; ++ai)
#pragma unroll
            for (int m = 0; m < 4; ++m) { bf16_t* rowp = base + (size_t)(row0 + ai * HALF + m * 16) * ldc + col0;
#pragma unroll
                for (int bj = 0; bj < 2; ++bj) { const f32x4 v0 = acc[ai][bj][m][0] * sc, v1 = acc[ai][bj][m][1] * sc;
                    u32x4 w; w.x = cvt_pk_bf16(v0[0], v0[1]); w.y = cvt_pk_bf16(v0[2], v0[3]); w.z = cvt_pk_bf16(v1[0], v1[1]); w.w = cvt_pk_bf16(v1[2], v1[3]);
                    *(u32x4*)(rowp + bj * HALF) = w; } }
    }
};
struct EpiProj {
    static constexpr bool PERM = true;
    bf16_t *Q, *LF, *V, *G; const float* lb;
    __device__ __forceinline__ void operator()(const f32x4 (&acc)[2][2][4][2], const Unit& u, int wr, int wc, int fr, int fq) const {
        const int grp = u.pn >> 2, row0 = u.pm * BM + wr * 64 + fr, col0 = (u.pn & 3) * BM + wc * 32 + 8 * fq;
        bf16_t* base = grp == 0 ? Q : grp == 1 ? LF : grp == 2 ? V : G;
        f32x4 lbv[2][2];
#pragma unroll
        for (int bj = 0; bj < 2; ++bj)
#pragma unroll
            for (int n = 0; n < 2; ++n) lbv[bj][n] = *(const f32x4*)(lb + col0 + bj * HALF + 4 * n);
#pragma unroll
        for (int ai = 0; ai < 2; ++ai)
#pragma unroll
            for (int m = 0; m < 4; ++m) { bf16_t* rowp = base + (size_t)(row0 + ai * HALF + m * 16) * 1024 + col0;
#pragma unroll
                for (int bj = 0; bj < 2; ++bj) { f32x4 v[2] = {acc[ai][bj][m][0], acc[ai][bj][m][1]}; u32x4 w;
                    if (grp == 1) {
#pragma unroll
                        for (int n = 0; n < 2; ++n)
#pragma unroll
                            for (int j = 0; j < 4; ++j) { const float l = lbv[bj][n][j]; v[n][j] = __logf(l + (1.0f - l) * sigmoidf_(v[n][j])); }
                        w.x = cvt_pk_f16(v[0][0], v[0][1]); w.y = cvt_pk_f16(v[0][2], v[0][3]); w.z = cvt_pk_f16(v[1][0], v[1][1]); w.w = cvt_pk_f16(v[1][2], v[1][3]);
                    } else {
                        if (grp == 3) {
#pragma unroll
                            for (int n = 0; n < 2; ++n)
#pragma unroll
                                for (int j = 0; j < 4; ++j) v[n][j] = sigmoidf_(v[n][j]); }
                        w.x = cvt_pk_bf16(v[0][0], v[0][1]); w.y = cvt_pk_bf16(v[0][2], v[0][3]); w.z = cvt_pk_bf16(v[1][0], v[1][1]); w.w = cvt_pk_bf16(v[1][2], v[1][3]);
                    }
                    *(u32x4*)(rowp + bj * HALF) = w; } }
    }
};
template <bool RES_BF16> struct EpiResid {
    static constexpr bool PERM = false;
    const void* res; float* R; float alpha;
    __device__ __forceinline__ void operator()(const f32x4 (&acc)[2][2][4][2], const Unit& u, int wr, int wc, int fr, int fq) const {
        const int row0 = u.pm * BM + wr * 64 + fr, col0 = u.pn * BM + wc * 32 + 4 * fq;
#pragma unroll
        for (int ai = 0; ai < 2; ++ai)
#pragma unroll
            for (int m = 0; m < 4; ++m) { const size_t off = (size_t)(row0 + ai * HALF + m * 16) * 1024 + col0;
#pragma unroll
                for (int bj = 0; bj < 2; ++bj)
#pragma unroll
                    for (int n = 0; n < 2; ++n) { const size_t o = off + bj * HALF + n * 16; f32x4 rv;
                        if (RES_BF16) { const u32x2 p = *(const u32x2*)((const bf16_t*)res + o); rv = (f32x4){bf_lo(p.x), bf_hi(p.x), bf_lo(p.y), bf_hi(p.y)}; }
                        else rv = *(const f32x4*)((const float*)res + o);
                        *(f32x4*)(R + o) = rv * alpha + acc[ai][bj][m][n]; } }
    }
};
struct EpiGateUp {
    static constexpr bool PERM = true;
    bf16_t* H;
    __device__ __forceinline__ void operator()(const f32x4 (&acc)[2][2][4][2], const Unit& u, int wr, int wc, int fr, int fq) const {
        const int row0 = u.slot0 + wr * 64 + fr, col0 = u.pn * HALF + wc * 32 + 8 * fq;
#pragma unroll
        for (int ai = 0; ai < 2; ++ai)
#pragma unroll
            for (int m = 0; m < 4; ++m) { f32x4 h[2];
#pragma unroll
                for (int n = 0; n < 2; ++n)
#pragma unroll
                    for (int j = 0; j < 4; ++j) { const float g = acc[ai][0][m][n][j]; h[n][j] = g * sigmoidf_(g) * acc[ai][1][m][n][j]; }
                u32x4 w; w.x = cvt_pk_bf16(h[0][0], h[0][1]); w.y = cvt_pk_bf16(h[0][2], h[0][3]); w.z = cvt_pk_bf16(h[1][0], h[1][1]); w.w = cvt_pk_bf16(h[1][2], h[1][3]);
                *(u32x4*)(H + (size_t)(row0 + ai * HALF + m * 16) * 512 + col0) = w; }
    }
};
struct EpiDown {
    static constexpr bool PERM = true;
    bf16_t* Y2; const int* dest; const float* gate;
    __device__ __forceinline__ void operator()(const f32x4 (&acc)[2][2][4][2], const Unit& u, int wr, int wc, int fr, int fq) const {
        const int col0 = u.pn * BM + wc * 32 + 8 * fq;
#pragma unroll
        for (int ai = 0; ai < 2; ++ai)
#pragma unroll
            for (int m = 0; m < 4; ++m) { const int idx = u.row0 + ai * HALF + wr * 64 + m * 16 + fr;
                if (idx < u.cnt) { const int d = dest[u.e * 32768 + idx]; const float gt = gate[u.e * 32768 + idx]; bf16_t* rowp = Y2 + (size_t)d * 1024 + col0;
#pragma unroll
                    for (int bj = 0; bj < 2; ++bj) { const f32x4 v0 = acc[ai][bj][m][0] * gt, v1 = acc[ai][bj][m][1] * gt;
                        u32x4 w; w.x = cvt_pk_bf16(v0[0], v0[1]); w.y = cvt_pk_bf16(v0[2], v0[3]); w.z = cvt_pk_bf16(v1[0], v1[1]); w.w = cvt_pk_bf16(v1[2], v1[3]);
                        *(u32x4*)(rowp + bj * HALF) = w; } } }
    }
};

template <class Epi, class Sched, bool ALIGN_EPI>
__device__ __forceinline__ void gemm_phase(PG8_LAS unsigned char* lds, const Gemm g, const Sched& S, const Epi& E) {
    const int tid = threadIdx.x, wid = __builtin_amdgcn_readfirstlane(tid >> 6), lane = tid & 63, wr = wid >> 2, wc = wid & 3, fr = lane & 15, fq = lane >> 4;
    const int K = g.K, nt = K / BK;
    int sR[2]; unsigned sC2[2], voffB[2];
#pragma unroll
    for (int i = 0; i < 2; ++i) { int R, C; stage_rc(tid * 16 + i * 8192, R, C); const int Rb = Epi::PERM ? ((R & ~31) + perm32(R & 31)) : R;
        sR[i] = R; sC2[i] = (unsigned)C * 2u; voffB[i] = (unsigned)(Rb * K + C) * 2u; }
#define PG8_MKA(dst, u) do { _Pragma("unroll") for (int _h = 0; _h < 2; ++_h) _Pragma("unroll") for (int _i = 0; _i < 2; ++_i) \
        dst[_h][_i] = (unsigned)S.a_row(u, sR[_i] + HALF * _h) * (unsigned)(K * 2) + sC2[_i]; } while (0)
    const size_t kstep = (size_t)(BK * 2);
    const size_t hstep = (size_t)HALF * K * 2;
    const unsigned ldsw = (unsigned)wid * 1024u;
    const int aoff = lds_byte(wr * 64 + fr, fq * 8), boff = lds_byte(wc * 32 + fr, fq * 8);
#define PG8_SA(b, h) (((b) * 2 + (h)) * HTB)
#define PG8_SB(b, h) ((4 + (b) * 2 + (h)) * HTB)
#define PG8_STAGE(bufoff, gbase, voff) do { _Pragma("unroll") for (int _i = 0; _i < 2; ++_i) \
        __builtin_amdgcn_global_load_lds((const unsigned*)((const char*)(gbase) + (voff)[_i]), (PG8_LAS unsigned*)(lds + (bufoff) + ldsw + _i * 8192), 16, 0, 0); } while (0)
#define PG8_LDA(dst, b, h) do { _Pragma("unroll") for (int m = 0; m < 4; ++m) _Pragma("unroll") for (int k = 0; k < 2; ++k) dst[m][k] = *(const PG8_LAS bf16x8*)(lds + PG8_SA(b, h) + aoff + m * 2048 + k * 1024); } while (0)
#define PG8_LDB(dst, b, h) do { _Pragma("unroll") for (int n = 0; n < 2; ++n) _Pragma("unroll") for (int k = 0; k < 2; ++k) dst[n][k] = *(const PG8_LAS bf16x8*)(lds + PG8_SB(b, h) + boff + n * 2048 + k * 1024); } while (0)
#define PG8_MMA(ai, bj, At, Bt) do { __builtin_amdgcn_s_setprio(1); _Pragma("unroll") for (int m = 0; m < 4; ++m) _Pragma("unroll") for (int n = 0; n < 2; ++n) _Pragma("unroll") for (int k = 0; k < 2; ++k) \
        acc[ai][bj][m][n] = __builtin_amdgcn_mfma_f32_16x16x32_bf16(Bt[n][k], At[m][k], acc[ai][bj][m][n], 0, 0, 0); __builtin_amdgcn_s_setprio(0); } while (0)
#define PG8_WAIT_V(n) asm volatile("s_waitcnt vmcnt(" #n ")" ::: "memory")
#define PG8_WAIT_L(n) asm volatile("s_waitcnt lgkmcnt(" #n ")" ::: "memory")
#define PG8_BAR __builtin_amdgcn_s_barrier()
#define PG8_SCHED __builtin_amdgcn_sched_barrier(0)
    Unit cur, nxt; int ui = 0;
    if (!S.next(0, cur)) return;
    f32x4 acc[2][2][4][2];
#pragma unroll
    for (int a = 0; a < 2; ++a)
#pragma unroll
        for (int b = 0; b < 2; ++b)
#pragma unroll
            for (int m = 0; m < 4; ++m)
#pragma unroll
                for (int n = 0; n < 2; ++n) acc[a][b][m][n] = (f32x4){0.f, 0.f, 0.f, 0.f};
    bf16x8 At[4][2], B0[2][2], B1[2][2];
    unsigned cVA[2][2], nVA[2][2];
    PG8_MKA(cVA, cur);
    const char* const gA = (const char*)g.A;
    const char* cB = (const char*)g.Bt + S.b_off(cur) * 2;
    PG8_STAGE(PG8_SB(0, 0), cB, voffB); PG8_STAGE(PG8_SB(0, 1), cB + hstep, voffB); PG8_STAGE(PG8_SA(0, 0), gA, cVA[0]); PG8_STAGE(PG8_SA(0, 1), gA, cVA[1]);
    if (wr == 1) PG8_BAR;
    PG8_WAIT_V(2); PG8_BAR;
    PG8_STAGE(PG8_SB(1, 0), cB + kstep, voffB); PG8_STAGE(PG8_SA(1, 0), gA + kstep, cVA[0]); PG8_STAGE(PG8_SB(1, 1), cB + hstep + kstep, voffB);
    PG8_WAIT_V(6); PG8_BAR;
    for (;;) {
        const bool has_next = S.next(ui + 1, nxt);
        const char* nB = cB;
        if (has_next) { PG8_MKA(nVA, nxt); nB = (const char*)g.Bt + S.b_off(nxt) * 2; }
        else {
#pragma unroll
            for (int _h = 0; _h < 2; ++_h)
#pragma unroll
                for (int _i = 0; _i < 2; ++_i) nVA[_h][_i] = cVA[_h][_i]; }
        for (int t = 0; t < nt; t += 2) {
            const bool last = (t == nt - 2);
            const char* a1 = gA + (size_t)(t + 1) * kstep;
            const char* a2 = last ? gA : gA + (size_t)(t + 2) * kstep; const char* b2 = last ? nB : cB + (size_t)(t + 2) * kstep;
            const char* a3 = a2 + kstep; const char* b3 = b2 + kstep;
            unsigned xA0[2], xA1[2];
#pragma unroll
            for (int _i = 0; _i < 2; ++_i) { xA0[_i] = last ? nVA[0][_i] : cVA[0][_i]; xA1[_i] = last ? nVA[1][_i] : cVA[1][_i]; }
            PG8_LDB(B0, 0, 0); PG8_LDB(B1, 0, 1); PG8_SCHED; PG8_LDA(At, 0, 0); PG8_STAGE(PG8_SA(1, 1), a1, cVA[1]);
            PG8_WAIT_V(8); PG8_WAIT_L(0); PG8_BAR; PG8_MMA(0, 0, At, B0); PG8_MMA(0, 1, At, B1); PG8_BAR; PG8_SCHED;
            PG8_LDA(At, 0, 1); PG8_STAGE(PG8_SB(0, 0), b2, voffB); PG8_STAGE(PG8_SB(0, 1), b2 + hstep, voffB); PG8_STAGE(PG8_SA(0, 0), a2, xA0);
            PG8_WAIT_V(8); PG8_WAIT_L(0); PG8_BAR; PG8_MMA(1, 0, At, B0); PG8_MMA(1, 1, At, B1); PG8_BAR; PG8_SCHED;
            PG8_LDB(B0, 1, 0); PG8_LDB(B1, 1, 1); PG8_SCHED; PG8_LDA(At, 1, 0); PG8_STAGE(PG8_SA(0, 1), a2, xA1);
            PG8_WAIT_V(8); PG8_WAIT_L(0); PG8_BAR; PG8_MMA(0, 0, At, B0); PG8_MMA(0, 1, At, B1); PG8_BAR; PG8_SCHED;
            PG8_LDA(At, 1, 1); PG8_STAGE(PG8_SB(1, 0), b3, voffB); PG8_STAGE(PG8_SB(1, 1), b3 + hstep, voffB); PG8_STAGE(PG8_SA(1, 0), a3, xA0);
            PG8_WAIT_V(8); PG8_WAIT_L(0); PG8_BAR; PG8_MMA(1, 0, At, B0); PG8_MMA(1, 1, At, B1); PG8_BAR; PG8_SCHED;
        }
        if constexpr (ALIGN_EPI) { if (wr == 0) PG8_BAR; }
        E(acc, cur, wr, wc, fr, fq);
        if (!has_next) break;
#pragma unroll
        for (int a = 0; a < 2; ++a)
#pragma unroll
            for (int b = 0; b < 2; ++b)
#pragma unroll
                for (int m = 0; m < 4; ++m)
#pragma unroll
                    for (int n = 0; n < 2; ++n) acc[a][b][m][n] = (f32x4){0.f, 0.f, 0.f, 0.f};
        cur = nxt; cB = nB; ++ui;
#pragma unroll
        for (int _h = 0; _h < 2; ++_h)
#pragma unroll
            for (int _i = 0; _i < 2; ++_i) cVA[_h][_i] = nVA[_h][_i];
        if constexpr (ALIGN_EPI) { if (wr == 1) PG8_BAR; }
    }
    PG8_WAIT_V(0);
    if constexpr (!ALIGN_EPI) { if (wr == 0) PG8_BAR; }
    PG8_BAR;
#undef PG8_MKA
#undef PG8_SA
#undef PG8_SB
#undef PG8_STAGE
#undef PG8_LDA
#undef PG8_LDB
#undef PG8_MMA
#undef PG8_WAIT_V
#undef PG8_WAIT_L
#undef PG8_BAR
#undef PG8_SCHED
}
}
#include <hip/hip_bf16.h>
#include <cmath>
namespace attn_body {
using bf16=__hip_bfloat16;
using bf16x8=__attribute__((ext_vector_type(8)))short;
using s16x4=__attribute__((ext_vector_type(4)))short;
using f32x16=__attribute__((ext_vector_type(16)))float;
using u32x4=__attribute__((ext_vector_type(4)))unsigned;
constexpr int SEQ=4096,D=64,DM=1024;
constexpr int NW=8,QBLK=32,QB=QBLK*NW,KVBLK=64,NQB=SEQ/QB;
constexpr int ATTN_PITCH=DM, ATTN_UNIT_ROWS=QB;
__device__ __forceinline__ int crow(int r,int hi){return (r&3)+8*(r>>2)+4*hi;}
#define SBAR() __builtin_amdgcn_sched_barrier(0)
__device__ __forceinline__ void cmask(f32x16&p0,f32x16&p1,int jb,int qrel,int hi){
  const float NEG=-INFINITY; const int dd=qrel-(64*jb+4*hi);
  #pragma unroll
  for(int r=0;r<16;++r){const int cc=(r&3)+8*(r>>2); if(cc>dd)p0[r]=NEG; if(cc+32>dd)p1[r]=NEG;}
}

constexpr int NSLOT=3, SLOTB=8192;
constexpr int LDS_K=0, LDS_V=NSLOT*SLOTB, LDS_WS=2*NSLOT*SLOTB, LDS_OST=LDS_WS+NW*64*4, LDS_BYTES=LDS_OST+NW*4096;
constexpr float C2=0.125f*1.4426950408889634f;
__device__ __forceinline__ void glds16(const void*gsrc,unsigned lds_dst){unsigned keep;
  asm volatile("s_mov_b32 %0, m0\n\ts_mov_b32 m0, %2\n\ts_nop 0\n\tglobal_load_lds_dwordx4 %1, off\n\ts_mov_b32 m0, %0":"=&s"(keep):"v"(gsrc),"s"(lds_dst):"memory");}
__device__ __forceinline__ float max3f(float a,float b,float c){float r;asm("v_max3_f32 %0, %1, %2, %3":"=v"(r):"v"(a),"v"(b),"v"(c));return r;}
__device__ __forceinline__ float max2f(float a,float b){float r;asm("v_max_f32_e32 %0, %1, %2":"=v"(r):"v"(a),"v"(b));return r;}
__device__ __forceinline__ float fadd_s(float a,float b){float r;asm("v_add_f32_e32 %0, %1, %2":"=v"(r):"v"(a),"v"(b));return r;}
__device__ __forceinline__ float fsub_s(float a,float b){float r;asm("v_sub_f32_e32 %0, %1, %2":"=v"(r):"v"(a),"v"(b));return r;}
typedef float f32x2_t __attribute__((ext_vector_type(2))); typedef __bf16 bf16x2_t __attribute__((ext_vector_type(2)));
__device__ __forceinline__ unsigned cvtpk_s(float lo,float hi){f32x2_t v={lo,hi};bf16x2_t b=__builtin_convertvector(v,bf16x2_t);return __builtin_bit_cast(unsigned,b);}
#define WAIT_BAR(N) asm volatile("s_waitcnt vmcnt(" #N ") lgkmcnt(0)\n\ts_barrier":::"memory")

__device__ __forceinline__ void qkt(f32x16&p0,f32x16&p1,const char*Kslot,const bf16x8*qr,const f32x16&negm,int r32,int hi){
  const char*kb=Kslot+hi*1024+r32*16;
  #pragma unroll
  for(int d0=0;d0<4;++d0){
    const bf16x8 b0=*reinterpret_cast<const bf16x8*>(kb+d0*2048);
    const bf16x8 b1=*reinterpret_cast<const bf16x8*>(kb+d0*2048+512);
    if(d0==0){p0=__builtin_amdgcn_mfma_f32_32x32x16_bf16(b0,qr[0],negm,0,0,0);p1=__builtin_amdgcn_mfma_f32_32x32x16_bf16(b1,qr[0],negm,0,0,0);}
    else{p0=__builtin_amdgcn_mfma_f32_32x32x16_bf16(b0,qr[d0],p0,0,0,0);p1=__builtin_amdgcn_mfma_f32_32x32x16_bf16(b1,qr[d0],p1,0,0,0);}}
}
typedef __attribute__((address_space(3))) const char* lds_cptr;
typedef short v4i16_t __attribute__((ext_vector_type(4)));
__device__ __forceinline__ void kload8(bf16x8*kf,lds_cptr kp){
  kf[0]=*(const __attribute__((address_space(3))) bf16x8*)(kp);      kf[1]=*(const __attribute__((address_space(3))) bf16x8*)(kp+512);
  kf[2]=*(const __attribute__((address_space(3))) bf16x8*)(kp+2048); kf[3]=*(const __attribute__((address_space(3))) bf16x8*)(kp+2560);
  kf[4]=*(const __attribute__((address_space(3))) bf16x8*)(kp+4096); kf[5]=*(const __attribute__((address_space(3))) bf16x8*)(kp+4608);
  kf[6]=*(const __attribute__((address_space(3))) bf16x8*)(kp+6144); kf[7]=*(const __attribute__((address_space(3))) bf16x8*)(kp+6656);
}
__device__ __forceinline__ void kload2(bf16x8*kf,lds_cptr kp,int j){ kf[2*j]=*(const __attribute__((address_space(3))) bf16x8*)(kp+j*2048); kf[2*j+1]=*(const __attribute__((address_space(3))) bf16x8*)(kp+j*2048+512); }
__device__ __forceinline__ s16x4 vtr(lds_cptr p){ return __builtin_bit_cast(s16x4,__builtin_amdgcn_ds_read_tr16_b64_v4i16((__attribute__((address_space(3))) v4i16_t*)p)); }
__device__ __forceinline__ float rowmax(const f32x16&p0,const f32x16&p1){
  float a=max3f(p0[0],p0[1],p1[0]),b=max3f(p0[2],p0[3],p1[1]);a=max3f(a,p1[2],p1[3]);
  #pragma unroll
  for(int r=4;r<16;r+=4){a=max3f(a,p0[r],p0[r+1]);b=max3f(b,p0[r+2],p0[r+3]);a=max3f(a,p1[r],p1[r+1]);b=max3f(b,p1[r+2],p1[r+3]);}
  const float m=max2f(a,b);
  auto rr=__builtin_amdgcn_permlane32_swap(__float_as_uint(m),__float_as_uint(m),false,false);
  return max2f(__uint_as_float(rr[0]),__uint_as_float(rr[1]));
}
__device__ __forceinline__ void pv(f32x16*o,int vb,bf16x8 pa0,bf16x8 pa1,bf16x8 pa2,bf16x8 pa3){
  #pragma unroll
  for(int d0=0;d0<2;++d0){s16x4 lo[4],hi[4];
    #pragma unroll
    for(int ks=0;ks<4;++ks){
      asm volatile("ds_read_b64_tr_b16 %0,%1 offset:%c2":"=&v"(lo[ks]):"v"(vb),"i"(d0*4096+ks*1024):"memory");
      asm volatile("ds_read_b64_tr_b16 %0,%1 offset:%c2":"=&v"(hi[ks]):"v"(vb),"i"(d0*4096+ks*1024+512):"memory");}
    asm volatile("s_waitcnt lgkmcnt(0)":::"memory");SBAR();
    #define PK(k) (bf16x8){lo[k][0],lo[k][1],lo[k][2],lo[k][3],hi[k][0],hi[k][1],hi[k][2],hi[k][3]}
    o[d0]=__builtin_amdgcn_mfma_f32_32x32x16_bf16(pa0,PK(0),o[d0],0,0,0);
    o[d0]=__builtin_amdgcn_mfma_f32_32x32x16_bf16(pa1,PK(1),o[d0],0,0,0);
    o[d0]=__builtin_amdgcn_mfma_f32_32x32x16_bf16(pa2,PK(2),o[d0],0,0,0);
    o[d0]=__builtin_amdgcn_mfma_f32_32x32x16_bf16(pa3,PK(3),o[d0],0,0,0);
    #undef PK
  }
}

#ifndef ATTN_STORE16
#define ATTN_STORE16(p,v) (*(u32x4*)(p)=(v))
#endif
template<int THRL> __device__ __forceinline__ void attn_unit(int qb,const bf16*Qh,const bf16*__restrict__ Kh,const bf16*__restrict__ Vh,bf16*Oh,char*shm){
  const int tid=threadIdx.x,lane=tid&63,r32=lane&31,hi=lane>>5; const int wid=__builtin_amdgcn_readfirstlane(tid>>6);
  const int q0=qb*QB;
  const bf16*Qw=Qh+(long)(q0+wid*QBLK)*DM;
  const unsigned lds0=(unsigned)(uintptr_t)shm;
  float*wsf=(float*)(shm+LDS_WS)+wid*64;
  const bf16*ksrc=Kh+(long)lane*DM+wid*8;
  const bf16*vsrc=Vh+(long)(16*(wid&3)+(lane>>2))*DM+(wid>>2)*32+(lane&3)*8;
  const unsigned kdst=lds0+LDS_K+wid*1024, vdst=lds0+LDS_V+wid*1024;
  #define DMA_K(t,slot) glds16(ksrc+(long)(t)*KVBLK*DM,(unsigned)__builtin_amdgcn_readfirstlane(kdst+(slot)))
  #define DMA_V(t,slot) glds16(vsrc+(long)(t)*KVBLK*DM,(unsigned)__builtin_amdgcn_readfirstlane(vdst+(slot)))
  const int vb0=(int)(lds0+LDS_V)+((lane>>4)&1)*32+(lane&3)*8+(4*hi+((lane&15)>>2))*64;
  const char*Kbase=shm+LDS_K; bf16x8 kf[8];
  const lds_cptr shm3=(lds_cptr)shm; const lds_cptr kp0=shm3+LDS_K+hi*1024+r32*16; const lds_cptr vp0=shm3+LDS_V+((lane>>4)&1)*32+(lane&3)*8+(4*hi+((lane&15)>>2))*64;
  const int NT=(q0+QB)/KVBLK;
  DMA_K(0,0);DMA_V(0,0);DMA_K(1,SLOTB);
  bf16x8 qr[4];
  #pragma unroll
  for(int d0=0;d0<4;++d0)qr[d0]=*reinterpret_cast<const bf16x8*>(&Qw[(long)r32*DM+d0*16+hi*8]);
  float mhat=0.f,l_reg=0.f;f32x16 o[2];o[0]=f32x16{};o[1]=f32x16{};const f32x16 negm=f32x16{};
  const int qrel=wid*QBLK+r32;
  #define CMASK(P0,P1,t) do{int jb_=(t)-(NT-4); if(jb_>=0)cmask(P0,P1,jb_,qrel,hi);}while(0)
  bool resc=false;
  #define START(P0,P1) do{ const float rm=rowmax(P0,P1); resc=false; \
    { const float dl=rm; mhat=fadd_s(mhat,dl); \
      _Pragma("unroll") for(int r=0;r<16;++r){P0[r]=fsub_s(P0[r],dl);P1[r]=fsub_s(P1[r],dl);} \
      } \
    _Pragma("unroll") for(int r=0;r<16;++r)P0[r]=__builtin_amdgcn_exp2f(P0[r]); }while(0)
  #define RESC() do{ if(resc){ asm volatile("s_waitcnt lgkmcnt(0)":::"memory"); \
      _Pragma("unroll") for(int d_=0;d_<2;++d_) _Pragma("unroll") for(int r=0;r<16;++r)o[d_][r]*=wsf[crow(r,hi)]; } }while(0)
  f32x16 pA0,pA1,pB0,pB1;
  int sl_prev=0,sl_cur=0,sl_next=SLOTB;
  #define ROT() do{sl_prev=sl_cur;sl_cur=sl_next;sl_next=(sl_next==(NSLOT-1)*SLOTB)?0:sl_next+SLOTB;}while(0)
  DMA_K(2,2*SLOTB);
  WAIT_BAR(3);
  qkt(pA0,pA1,Kbase,qr,negm,r32,hi);asm volatile("s_nop 15\n\ts_nop 7":"+v"(pA0),"+v"(pA1));CMASK(pA0,pA1,0);
  START(pA0,pA1);
  _Pragma("unroll") for(int r=0;r<16;++r)pA1[r]=__builtin_amdgcn_exp2f(pA1[r]);
  WAIT_BAR(0);
  DMA_K(3,0);DMA_V(1,SLOTB);
  ROT();
  kload8(kf,kp0+sl_cur);
  WAIT_BAR(2);
  s16x4 vlo[8],vhi[8]; u32x4 pw0,pw1,pw2,pw3;
  #define PKW(P,B) cvtpk_s(P[B],P[B+1])
  #define PAF(k) __builtin_bit_cast(bf16x8,pw##k)
  #define VFR(i) (bf16x8){vlo[i][0],vlo[i][1],vlo[i][2],vlo[i][3],vhi[i][0],vhi[i][1],vhi[i][2],vhi[i][3]}
  #define PIN(x) asm volatile("":"+v"(x))
  #define MX3(a,b,c) __builtin_fmaxf(__builtin_fmaxf((a),(b)),(c))
  #define GAPA(MF,A0,A1,A2,A3,W0,W1,PW) do{ MF; sacc+=A0; sacc+=A1; sacc+=A2; sacc+=A3; PIN(sacc); W0; W1; PIN(PW); SBAR(); }while(0)
  #define EX(v) __builtin_amdgcn_exp2f(v)
  #define GAPB(MF,X,B) do{ MF; X[B]=EX(X[B]); X[B+1]=EX(X[B+1]); X[B+2]=EX(X[B+2]); X[B+3]=EX(X[B+3]); PIN(X); SBAR(); }while(0)
  #define VRD(i) do{ vlo[i]=vtr(vp_+(((i)>>2)*4096+((i)&3)*1024)); vhi[i]=vtr(vp_+(((i)>>2)*4096+((i)&3)*1024+512)); }while(0)
  #define KRD(G,j) do{ if(G){ kload2(kf,kp0+sl_next,j); SBAR(); } }while(0)
  #define STEP(C0,C1,P0,P1,t,GK,GV,GL) do{ SBAR(); \
    const lds_cptr vp_=vp0+sl_prev; \
    VRD(0); SBAR(); float sacc=(P0[0]+P0[1]); \
    GAPA(C0=__builtin_amdgcn_mfma_f32_32x32x16_bf16(kf[0],qr[0],negm,0,0,0), P0[2],P0[3],P0[4],P0[5],     pw0[0]=PKW(P0,0), pw0[1]=PKW(P0,2), pw0); \
    VRD(4); SBAR(); GAPA(C1=__builtin_amdgcn_mfma_f32_32x32x16_bf16(kf[1],qr[0],negm,0,0,0), P0[6],P0[7],P0[8],P0[9],     pw0[2]=PKW(P0,4), pw0[3]=PKW(P0,6), pw0); \
    VRD(1); SBAR(); GAPA(C0=__builtin_amdgcn_mfma_f32_32x32x16_bf16(kf[2],qr[1],C0,0,0,0),   P0[10],P0[11],P0[12],P0[13], pw1[0]=PKW(P0,8), pw1[1]=PKW(P0,10), pw1); \
    VRD(5); SBAR(); GAPA(C1=__builtin_amdgcn_mfma_f32_32x32x16_bf16(kf[3],qr[1],C1,0,0,0),   P0[14],P0[15],P1[0],P1[1],   pw1[2]=PKW(P0,12),pw1[3]=PKW(P0,14), pw1); \
    VRD(2); SBAR(); GAPA(C0=__builtin_amdgcn_mfma_f32_32x32x16_bf16(kf[4],qr[2],C0,0,0,0),   P1[2],P1[3],P1[4],P1[5],     pw2[0]=PKW(P1,0), pw2[1]=PKW(P1,2), pw2); \
    VRD(6); SBAR(); GAPA(C1=__builtin_amdgcn_mfma_f32_32x32x16_bf16(kf[5],qr[2],C1,0,0,0),   P1[6],P1[7],P1[8],P1[9],     pw2[2]=PKW(P1,4), pw2[3]=PKW(P1,6), pw2); \
    VRD(3); SBAR(); GAPA(C0=__builtin_amdgcn_mfma_f32_32x32x16_bf16(kf[6],qr[3],C0,0,0,0),   P1[10],P1[11],P1[12],P1[13], pw3[0]=PKW(P1,8), pw3[1]=PKW(P1,10), pw3); \
    VRD(7); SBAR(); GAPA(C1=__builtin_amdgcn_mfma_f32_32x32x16_bf16(kf[7],qr[3],C1,0,0,0),   P1[14],P1[15],0.f,0.f,       pw3[2]=PKW(P1,12),pw3[3]=PKW(P1,14), pw3); \
    l_reg+=sacc; \
    if(GK){DMA_K((t)+3,sl_cur);} if(GV){DMA_V((t)+1,sl_next);} \
    _Pragma("unroll") for(int r=0;r<16;++r){C0[r]-=mhat;C1[r]-=mhat;} \
    CMASK(C0,C1,t); \
    { float a=MX3(C0[0],C0[1],C1[0]),b=MX3(C0[2],C0[3],C1[1]); a=MX3(a,C1[2],C1[3]); \
      _Pragma("unroll") for(int r=4;r<16;r+=4){a=MX3(a,C0[r],C0[r+1]);b=MX3(b,C0[r+2],C0[r+3]);a=MX3(a,C1[r],C1[r+1]);b=MX3(b,C1[r+2],C1[r+3]);} \
      float rm=__builtin_fmaxf(a,b); { auto rr=__builtin_amdgcn_permlane32_swap(__float_as_uint(rm),__float_as_uint(rm),false,false); rm=__builtin_fmaxf(__uint_as_float(rr[0]),__uint_as_float(rr[1])); } \
      resc=false; \
      if(__builtin_expect(__any(rm>(float)THRL),0)){ const float dl=__builtin_fmaxf(rm,0.f); mhat+=dl; \
        _Pragma("unroll") for(int r=0;r<16;++r){C0[r]-=dl;C1[r]-=dl;} \
        const float f=__builtin_amdgcn_exp2f(-dl); l_reg*=f; if(hi==0)wsf[r32]=f; resc=true; } } \
    SBAR(); \
    GAPB(o[0]=__builtin_amdgcn_mfma_f32_32x32x16_bf16(PAF(0),VFR(0),o[0],0,0,0), C0,0); \
    GAPB(o[1]=__builtin_amdgcn_mfma_f32_32x32x16_bf16(PAF(0),VFR(4),o[1],0,0,0), C0,4); \
    KRD(GL,0); GAPB(o[0]=__builtin_amdgcn_mfma_f32_32x32x16_bf16(PAF(1),VFR(1),o[0],0,0,0), C0,8); \
    KRD(GL,1); GAPB(o[1]=__builtin_amdgcn_mfma_f32_32x32x16_bf16(PAF(1),VFR(5),o[1],0,0,0), C0,12); \
    KRD(GL,2); GAPB(o[0]=__builtin_amdgcn_mfma_f32_32x32x16_bf16(PAF(2),VFR(2),o[0],0,0,0), C1,0); \
    KRD(GL,3); GAPB(o[1]=__builtin_amdgcn_mfma_f32_32x32x16_bf16(PAF(2),VFR(6),o[1],0,0,0), C1,4); \
    GAPB(o[0]=__builtin_amdgcn_mfma_f32_32x32x16_bf16(PAF(3),VFR(3),o[0],0,0,0), C1,8); \
    GAPB(o[1]=__builtin_amdgcn_mfma_f32_32x32x16_bf16(PAF(3),VFR(7),o[1],0,0,0), C1,12); \
    }while(0)
  int t=1;
  #undef CMASK
  #define CMASK(P0,P1,t) do{}while(0)
  for(;t+5<NT;t+=2){
    STEP(pB0,pB1,pA0,pA1,t,true,true,true);     WAIT_BAR(2); RESC(); ROT();
    STEP(pA0,pA1,pB0,pB1,t+1,true,true,true);   WAIT_BAR(2); RESC(); ROT();
  }
  #undef CMASK
  #define CMASK(P0,P1,t) do{int jb_=(t)-(NT-4); if(jb_>=0)cmask(P0,P1,jb_,qrel,hi);}while(0)
  #define ENDW(tt) do{ if((tt)+3<NT){WAIT_BAR(2);} else if((tt)+2<NT){WAIT_BAR(1);} else {WAIT_BAR(0);} }while(0)
  for(;t+1<NT;t+=2){
    STEP(pB0,pB1,pA0,pA1,t,(t+3<NT),(t+1<NT),(t+1<NT));       ENDW(t);   RESC(); ROT();
    STEP(pA0,pA1,pB0,pB1,t+1,(t+4<NT),(t+2<NT),(t+2<NT));     ENDW(t+1); RESC(); ROT();
  }
  STEP(pB0,pB1,pA0,pA1,NT-1,false,false,false); RESC();
  { float sacc=pB0[0]+pB0[1]; _Pragma("unroll") for(int r=2;r<16;++r)sacc+=pB0[r]; _Pragma("unroll") for(int r=0;r<16;++r)sacc+=pB1[r]; l_reg+=sacc;
    pw0=(u32x4){PKW(pB0,0),PKW(pB0,2),PKW(pB0,4),PKW(pB0,6)};pw1=(u32x4){PKW(pB0,8),PKW(pB0,10),PKW(pB0,12),PKW(pB0,14)};pw2=(u32x4){PKW(pB1,0),PKW(pB1,2),PKW(pB1,4),PKW(pB1,6)};pw3=(u32x4){PKW(pB1,8),PKW(pB1,10),PKW(pB1,12),PKW(pB1,14)};
    SBAR(); pv(o,vb0+sl_cur,PAF(0),PAF(1),PAF(2),PAF(3)); }
  #undef PKW
  #undef PAF
  #undef VFR
  #undef PIN
  #undef MX3
  #undef GAPA
  #undef GAPB
  #undef EX
  #undef VRD
  #undef KRD
  #undef STEP
  #undef ENDW
  {auto rr=__builtin_amdgcn_permlane32_swap(__float_as_uint(l_reg),__float_as_uint(l_reg),false,false);l_reg=__uint_as_float(rr[0])+__uint_as_float(rr[1]);}
  if(hi==0)wsf[32+r32]=l_reg;asm volatile("s_waitcnt lgkmcnt(0)":::"memory");
  float rli[16];
  #pragma unroll
  for(int r=0;r<16;++r)rli[r]=__builtin_amdgcn_rcpf(wsf[32+crow(r,hi)]);
  bf16*Ow=Oh+(long)(q0+wid*QBLK)*DM;
  { bf16*stg=(bf16*)(shm+LDS_OST)+wid*2048;
    #pragma unroll
    for(int r=0;r<16;++r){const int orow=crow(r,hi);
      #pragma unroll
      for(int d0=0;d0<2;++d0)stg[orow*64+d0*32+r32]=__float2bfloat16(o[d0][r]*rli[r]);}
    asm volatile("s_waitcnt lgkmcnt(0)":::"memory");
    int lane_e=lane; asm volatile("":"+v"(lane_e));
    #pragma unroll
    for(int i=0;i<4;++i){const int row=i*8+(lane_e>>3),ch=lane_e&7; const u32x4 v=*(const u32x4*)(stg+row*64+ch*8); ATTN_STORE16(Ow+(long)row*DM+ch*8,v);} }
  asm volatile("s_waitcnt lgkmcnt(0)\n\ts_barrier":::"memory");
  #undef DMA_K
  #undef DMA_V
  #undef CMASK
  #undef START
  #undef RESC
  #undef ROT
}
constexpr int ATTN_LDS_BYTES=LDS_BYTES;
struct DiffTensors { const bf16* Q; const bf16* K; const bf16* V; bf16* O0; bf16* O1; };
template<int THRL=8> __device__ __forceinline__ void attn_phase(char*lds,const DiffTensors&T,int vcu,int G){
  for(int v=vcu;v<8*32;v+=G){
    const int b=v>>5,h=(v>>2)&7,c=(v>>1)&1,vh=v&1; const long rb=(long)b*SEQ*DM;
    const bf16*Qh=T.Q+rb+(2*h+c)*64,*Kh=T.K+rb+(2*h+c)*64,*Vh=T.V+rb+(2*h+vh)*64; bf16*Oh=(c?T.O1:T.O0)+rb+(2*h+vh)*64;
    for(int i=0;i<NQB;++i){ const int qb=(i&1)?(i>>1):(NQB-1-(i>>1)); attn_unit<THRL>(qb,Qh,Kh,Vh,Oh,lds); }
  }
}
#undef SBAR
#undef WAIT_BAR
}

constexpr int NWAVES = 8;
constexpr int BATCH = 8, SEQ = 4096, D = 1024, M = BATCH * SEQ;
constexpr int NEXP = 16, DEXP = 512, ECAP = 32768;
constexpr float LN_EPS = 1e-5f, RMS_EPS = 1e-6f;
constexpr float DN_ALPHA = 1.41421356237309515f;
constexpr float LAMBDA_INIT = 0.35550906759096926f;
#ifndef N_LAUNCH_MODE
#define N_LAUNCH_MODE 1
#endif
constexpr int N_PHASES = 16;

constexpr size_t MiB = 1u << 20;
constexpr size_t WS_CTL = 0, CTL_ZERO_BYTES = 1 * MiB;
constexpr size_t WS_TAB = 1 * MiB;
constexpr size_t WS_WIN = 2 * MiB;
constexpr size_t WS_WOUT = 10 * MiB;
constexpr size_t WS_WQKV = 12 * MiB;
constexpr size_t WS_WBO = 18 * MiB;
constexpr size_t WS_WGU = 20 * MiB;
constexpr size_t WS_WD = 84 * MiB;
constexpr size_t WS_BUF = 120 * MiB, BUFSZ = 64 * MiB;
constexpr size_t WS_A = WS_BUF, WS_B = WS_BUF + BUFSZ, WS_C = WS_BUF + 2 * BUFSZ, WS_D = WS_BUF + 3 * BUFSZ, WS_E = WS_BUF + 4 * BUFSZ, WS_F = WS_BUF + 5 * BUFSZ;
constexpr size_t WS_DEST = 504 * MiB, WS_GATE = 506 * MiB;
constexpr size_t WS_END = 508 * MiB;
constexpr int CW_CNT = 1024;
constexpr int CW_BAR = 4096;

constexpr int RING_OFF = 0, RING_BYTES = 143360;
constexpr int LDSCTL_OFF = RING_BYTES, MISC_OFF = LDSCTL_OFF + 320;
constexpr int MOETAB_OFF = LDSCTL_OFF + 1024;
constexpr int LDS_BYTES = 147456;
static_assert(MOETAB_OFF + 256 <= LDS_BYTES && MISC_OFF + 128 <= MOETAB_OFF, "LDS map");

#define GAS __attribute__((address_space(1)))
#define LAS __attribute__((address_space(3)))
typedef unsigned short bf16;
typedef unsigned v4u __attribute__((ext_vector_type(4)));
typedef unsigned v2u __attribute__((ext_vector_type(2)));
typedef float f32x4 __attribute__((ext_vector_type(4)));
typedef short bf16x8 __attribute__((ext_vector_type(8)));
typedef short s16x4 __attribute__((ext_vector_type(4)));
typedef GAS unsigned gu32;
typedef GAS unsigned long long gu64;
#define RLX_AGENT __ATOMIC_RELAXED, __HIP_MEMORY_SCOPE_AGENT
#define LDS_WAIT() asm volatile("s_waitcnt lgkmcnt(0)" ::: "memory")
#define VM_WAIT() asm volatile("s_waitcnt vmcnt(0)" ::: "memory")
__device__ __forceinline__ unsigned f2bf(float f) { unsigned u = __builtin_bit_cast(unsigned, f); return (u + 0x7fffu + ((u >> 16) & 1u)) >> 16; }
__device__ __forceinline__ unsigned pk2(float lo, float hi) { return f2bf(lo) | (f2bf(hi) << 16); }
__device__ __forceinline__ float bflo(unsigned u) { return __uint_as_float(u << 16); }
__device__ __forceinline__ float bfhi(unsigned u) { return __uint_as_float(u & 0xffff0000u); }

#define XB_TMO      128
#define XB_XCNT(j)  (256  + 64 * (j))
#define XB_XSUB(j)  (1280 + 64 * (j))
#define XB_XGEN(j)  (2304 + 64 * (j))
#define XB_TOP      3328
#define XB_TOPGEN   3392
#define XCD_BAR_WORDS 3456
#define XB_SPIN_CAP (1u << 18)

__device__ __forceinline__ unsigned xb_ld(unsigned* p)              { return __hip_atomic_load(p, __ATOMIC_RELAXED, __HIP_MEMORY_SCOPE_AGENT); }
__device__ __forceinline__ unsigned xb_add(unsigned* p, unsigned v) { return __hip_atomic_fetch_add(p, v, __ATOMIC_RELAXED, __HIP_MEMORY_SCOPE_AGENT); }
__device__ __forceinline__ unsigned xb_xcc_id() { return (unsigned)__builtin_amdgcn_s_getreg((3 << 11) | 20) & 0xFu; }
#define XB_SPIN(cond, bar) do { unsigned _sp = 0; while (cond) { __builtin_amdgcn_s_sleep(1); \
    if ((++_sp & 255u) == 0u) { if (xb_ld(&(bar)[XB_TMO])) break; if (_sp > XB_SPIN_CAP) { atomicAdd(&(bar)[XB_TMO], 1u); break; } } } } while (0)

struct XcdBarrier {
    unsigned* bar; unsigned x;
    volatile LAS unsigned* st;
};

__device__ __forceinline__ XcdBarrier xcd_barrier_post(unsigned* bar, volatile LAS unsigned* st) {
    XcdBarrier b; b.bar = bar; b.x = xb_xcc_id(); b.st = st;
    if (threadIdx.x == 0) (void)xb_add(&bar[XB_XCNT(b.x)], 1u);
    return b;
}
__device__ __forceinline__ void xcd_barrier_complete(unsigned* bar, unsigned x, unsigned& nloc, unsigned& nx) {
    const unsigned G = gridDim.x * gridDim.y * gridDim.z;
    unsigned sum, cnt, mine, sp = 0u;
    for (;;) {
        sum = 0u; cnt = 0u; mine = 0u;
#pragma unroll
        for (unsigned j = 0; j < 16; ++j) { const unsigned c = xb_ld(&bar[XB_XCNT(j)]); sum += c; cnt += (c > 0u) ? 1u : 0u; mine = (j == x) ? c : mine; }
        if (sum == G) break;
        __builtin_amdgcn_s_sleep(1);
        if ((++sp & 255u) == 0u) { if (xb_ld(&bar[XB_TMO])) break; if (sp > XB_SPIN_CAP) { atomicAdd(&bar[XB_TMO], 1u); break; } }
    }
    nloc = mine > 0u ? mine : 1u; nx = cnt > 0u ? cnt : 1u;
}

__device__ __forceinline__ void xcd_barrier(const XcdBarrier& b) {
    asm volatile("s_waitcnt vmcnt(0)" ::: "memory");
    __syncthreads();
    if (threadIdx.x == 0) {
        unsigned* bar = b.bar;
        __builtin_amdgcn_s_waitcnt(0);
        unsigned nloc = b.st[0], nx = b.st[1];
        if (nloc == 0u) { xcd_barrier_complete(bar, b.x, nloc, nx); b.st[0] = nloc; b.st[1] = nx; }
        const unsigned old = xb_add(&bar[XB_XSUB(b.x)], 1u);
        const unsigned gen = old / nloc;
        if (old + 1u == (gen + 1u) * nloc) {
            __builtin_amdgcn_fence(__ATOMIC_RELEASE, "agent");
            asm volatile("s_waitcnt vmcnt(0)" ::: "memory");
            const unsigned og = xb_add(&bar[XB_TOP], 1u);
            const unsigned tg = og / nx;
            if (og + 1u == (tg + 1u) * nx) xb_add(&bar[XB_TOPGEN], 1u);
            else XB_SPIN(xb_ld(&bar[XB_TOPGEN]) == tg, bar);
            __builtin_amdgcn_fence(__ATOMIC_ACQUIRE, "agent");
            xb_add(&bar[XB_XGEN(b.x)], 1u);
            asm volatile("s_waitcnt vmcnt(0)" ::: "memory");
        } else {
            XB_SPIN(xb_ld(&bar[XB_XGEN(b.x)]) == gen, bar);
            __builtin_amdgcn_fence(__ATOMIC_ACQUIRE, "agent");
            asm volatile("s_waitcnt vmcnt(0)" ::: "memory");
        }
    }
    __syncthreads();
}

struct Frame {
    LAS unsigned char* lds;
    gu32* ctl;
    int tid, lane, wave;
    int vcu, G;
};
__device__ __forceinline__ float wave_sum(float v) {
#pragma unroll
    for (int o = 1; o < 64; o <<= 1) v += __shfl_xor(v, o);
    return v;
}
__device__ __forceinline__ void transpose_item(const float* W, int ldw, int k0, int n0, bf16* WT, int ldk, int dst_row0, float scale, LAS float* scr, int lane) {
#pragma unroll 8
    for (int i = 0; i < 32; ++i) { const int kk = 2 * i + (lane >> 5); scr[kk * 33 + (lane & 31)] = W[(size_t)(k0 + kk) * ldw + n0 + (lane & 31)]; }
    LDS_WAIT(); asm volatile("" ::: "memory");
    const int c = lane & 7;
#pragma unroll
    for (int j = 0; j < 4; ++j) { const int n = (lane >> 3) + 8 * j; const LAS float* s = scr + (8 * c) * 33 + n;
        v4u o; o.x = pk2(s[0 * 33] * scale, s[1 * 33] * scale); o.y = pk2(s[2 * 33] * scale, s[3 * 33] * scale); o.z = pk2(s[4 * 33] * scale, s[5 * 33] * scale); o.w = pk2(s[6 * 33] * scale, s[7 * 33] * scale);
        *(GAS v4u*)(WT + (size_t)(dst_row0 + n) * ldk + k0 + 8 * c) = o; }
    LDS_WAIT(); asm volatile("" ::: "memory");
}
__device__ __forceinline__ void transpose_plain(const float* W, int K, int N, bf16* WT, int row_off, float scale, LAS float* scr, int item, int lane) {
    const int nblk = N / 32, kb = item / nblk, nb = item % nblk;
    transpose_item(W, N, 64 * kb, 32 * nb, WT, K, row_off + 32 * nb, scale, scr, lane);
}

struct Inputs { const float *x, *a_w_in, *a_lb, *a_norm_g, *a_w_out, *kv_w, *b_w_q, *b_lam, *b_subln_g, *b_w_out, *ln1_g, *ln1_b, *ln2_g, *ln2_b, *router_w, *router_b, *moe_w_gate, *moe_w_up, *moe_w_down; };

__device__ __forceinline__ void p0_prologue(Frame& F, const Inputs& in, unsigned char* ws) {
    LAS float* scr = (LAS float*)(F.lds + RING_OFF + F.wave * 16384);
    const int gw = F.vcu * NWAVES + F.wave, NGW = F.G * NWAVES;
    constexpr int I_IN = 16 * 128, I_SQ = 16 * 32, I_KV = 16 * 64;
    constexpr int NITEMS = I_IN + I_SQ + I_KV + I_SQ + I_SQ;
    for (int it = gw; it < NITEMS; it += NGW) {
        int r = it;
        if (r < I_IN) { transpose_plain(in.a_w_in, D, 4 * D, (bf16*)(ws + WS_WIN), 0, 1.f, scr, r, F.lane); continue; } r -= I_IN;
        if (r < I_SQ) { transpose_plain(in.a_w_out, D, D, (bf16*)(ws + WS_WOUT), 0, 1.f, scr, r, F.lane); continue; } r -= I_SQ;
        if (r < I_KV) { transpose_plain(in.kv_w, D, 2 * D, (bf16*)(ws + WS_WQKV), D, 1.f, scr, r, F.lane); continue; } r -= I_KV;
        if (r < I_SQ) { transpose_plain(in.b_w_q, D, D, (bf16*)(ws + WS_WQKV), 0, attn_body::C2, scr, r, F.lane); continue; } r -= I_SQ;
        transpose_plain(in.b_w_out, D, D, (bf16*)(ws + WS_WBO), 0, 1.f, scr, r, F.lane);
    }
    bf16* XB = (bf16*)(ws + WS_A);
    for (int m = gw; m < M; m += NGW) {
        const GAS f32x4* xr = (const GAS f32x4*)(in.x + (size_t)m * D) + F.lane; GAS v2u* o8 = (GAS v2u*)(XB + (size_t)m * D) + F.lane;
#pragma unroll
        for (int j = 0; j < 4; ++j) { const f32x4 v = xr[64 * j]; v2u o; o.x = pk2(v.x, v.y); o.y = pk2(v.z, v.w); o8[64 * j] = o; }
    }
    if (blockIdx.x == 0) {
        float* tab = (float*)(ws + WS_TAB);
        for (int d = F.tid; d < D; d += NWAVES * 64) { const float a0 = in.a_lb[d], a1 = in.a_lb[D + d]; tab[d] = 1.0f / (1.0f + __expf(a1 - a0)); }
        if (F.wave == 0) { const float p = wave_sum(in.b_lam[F.lane] * in.b_lam[64 + F.lane]), q = wave_sum(in.b_lam[128 + F.lane] * in.b_lam[192 + F.lane]);
            if (F.lane == 0) tab[1024] = __expf(p) - __expf(q) + LAMBDA_INIT; }
    }
}
__device__ __forceinline__ void moe_weight_convert(Frame& F, const Inputs& in, unsigned char* ws, int w0, int nw) {
    LAS float* scr = (LAS float*)(F.lds + RING_OFF + F.wave * 16384);
    bf16* WGU = (bf16*)(ws + WS_WGU); bf16* WDn = (bf16*)(ws + WS_WD);
    constexpr int PER = 768, NIT = 2 * NEXP * PER;
    for (int it = w0; it < NIT; it += nw) {
        const int le = it / PER, r = it % PER, kind = r >> 8, q = r & 255;
        if (kind < 2) { const int kb = q >> 4, nb = q & 15, n0 = 32 * nb; const float* W = (kind == 0 ? in.moe_w_gate : in.moe_w_up) + (size_t)le * D * DEXP;
            transpose_item(W, DEXP, 64 * kb, n0, WGU + (size_t)le * D * D, D, (n0 >> 7) * 256 + kind * 128 + (n0 & 127), 1.f, scr, F.lane); }
        else { const int kb = q >> 5, nb = q & 31; const float* W = in.moe_w_down + (size_t)le * DEXP * D;
            transpose_item(W, D, 64 * kb, 32 * nb, WDn + (size_t)le * D * DEXP, DEXP, 32 * nb, 1.f, scr, F.lane); }
    }
}

constexpr int SC_LFB = 0, SC_TOT = 32768, SC_DEC = SC_TOT + 2048, SC_SS = SC_DEC + 512, SC_QT = SC_SS + 2048, SC_KT = SC_QT + 17408, SC_QH = SC_KT + 17408,
              SC_KHT = SC_QH + 17408, SC_VT = SC_KHT + 18432, SC_P = SC_VT + 18432, SC_END = SC_P + 9216, SC_OUT = SC_QT;
static_assert(SC_END <= RING_BYTES && 64 * 528 <= 2 * 17408, "scan LDS map");
__device__ __forceinline__ float h2f(unsigned short h) { return (float)__builtin_bit_cast(__fp16, h); }
__device__ __forceinline__ void scan_unit(Frame& F, int b, int h, const bf16* Q0, const bf16* LF, const bf16* V0, const bf16* G0, const float* norm_g, bf16* O0) {
    LAS unsigned char* L = F.lds + RING_OFF;
    LAS float* LFB = (LAS float*)(L + SC_LFB); LAS float* TOT = (LAS float*)(L + SC_TOT); LAS float* DEC = (LAS float*)(L + SC_DEC); LAS float* SS = (LAS float*)(L + SC_SS);
    const int tid = F.tid, lane = F.lane, w = F.wave;
    const int r = tid >> 3, cs = tid & 7;
    const int row16 = lane & 15, quad = lane >> 4;
    const size_t gcol = (size_t)h * 128 + cs * 16;
    float ng[16];
#pragma unroll
    for (int i = 0; i < 16; ++i) ng[i] = norm_g[h * 128 + cs * 16 + i];
    f32x4 Sacc[8];
#pragma unroll
    for (int i = 0; i < 8; ++i) Sacc[i] = (f32x4){0.f, 0.f, 0.f, 0.f};
    v4u pq[2], pl[2], pv[2], pg[2];
    { const size_t o = ((size_t)b * SEQ + r) * D + gcol;
#pragma unroll
      for (int i = 0; i < 2; ++i) { pq[i] = *(const GAS v4u*)(Q0 + o + 8 * i); pl[i] = *(const GAS v4u*)(LF + o + 8 * i); pv[i] = *(const GAS v4u*)(V0 + o + 8 * i); pg[i] = *(const GAS v4u*)(G0 + o + 8 * i); } }
    for (int c = 0; c < SEQ / 64; ++c) {
        v4u cq[2], cl[2], cv[2], cg[2];
#pragma unroll
        for (int i = 0; i < 2; ++i) { cq[i] = pq[i]; cl[i] = pl[i]; cv[i] = pv[i]; cg[i] = pg[i]; }
        if (c + 1 < SEQ / 64) { const size_t o = ((size_t)b * SEQ + (c + 1) * 64 + r) * D + gcol;
#pragma unroll
            for (int i = 0; i < 2; ++i) { pq[i] = *(const GAS v4u*)(Q0 + o + 8 * i); pl[i] = *(const GAS v4u*)(LF + o + 8 * i); pv[i] = *(const GAS v4u*)(V0 + o + 8 * i); pg[i] = *(const GAS v4u*)(G0 + o + 8 * i); } }
        float lf[16];
#pragma unroll
        for (int i = 0; i < 2; ++i)
#pragma unroll
            for (int j = 0; j < 4; ++j) { const unsigned u = cl[i][j]; lf[8 * i + 2 * j] = h2f((unsigned short)(u & 0xffffu)); lf[8 * i + 2 * j + 1] = h2f((unsigned short)(u >> 16)); }
#pragma unroll
        for (int i = 0; i < 4; ++i) *(LAS f32x4*)(LFB + r * 128 + cs * 16 + 4 * i) = (f32x4){lf[4 * i], lf[4 * i + 1], lf[4 * i + 2], lf[4 * i + 3]};
        __syncthreads();
        { const int seg = tid >> 7, d = tid & 127; float run = 0.f;
#pragma unroll
          for (int i = 0; i < 16; ++i) { run += LFB[(seg * 16 + i) * 128 + d]; LFB[(seg * 16 + i) * 128 + d] = run; }
          TOT[seg * 128 + d] = run; }
        __syncthreads();
        { const int sg = r >> 4;
          unsigned qt[8], kt[8], qh[8];
          float qf[16];
#pragma unroll
          for (int i = 0; i < 2; ++i)
#pragma unroll
              for (int j = 0; j < 4; ++j) { qf[8 * i + 2 * j] = bflo(cq[i][j]); qf[8 * i + 2 * j + 1] = bfhi(cq[i][j]); }
          float prev_qt = 0.f, prev_kt = 0.f, prev_qh = 0.f;
#pragma unroll
          for (int i = 0; i < 16; ++i) { const int d = cs * 16 + i;
              const float t0 = TOT[d], t1 = TOT[128 + d], t2 = TOT[256 + d], t3 = TOT[384 + d];
              const float off = sg == 0 ? 0.f : sg == 1 ? t0 : sg == 2 ? (t0 + t1) : (t0 + t1 + t2);
              const float bref = LFB[31 * 128 + d] + t0, blast = ((t0 + t1) + t2) + t3, bb = LFB[r * 128 + d] + off;
              const float kv = 1.0f - __expf(lf[i]);
              const float vqt = qf[i] * __expf(bb - bref), vkt = kv * __expf(bref - bb), vqh = qf[i] * __expf(bb), vkh = kv * __expf(blast - bb);
              if (i & 1) { qt[i >> 1] = pk2(prev_qt, vqt); kt[i >> 1] = pk2(prev_kt, vkt); qh[i >> 1] = pk2(prev_qh, vqh); } else { prev_qt = vqt; prev_kt = vkt; prev_qh = vqh; }
              *(LAS unsigned short*)(L + SC_KHT + d * 144 + r * 2) = (unsigned short)f2bf(vkh);
              const unsigned vw = cv[i >> 3][(i & 7) >> 1]; *(LAS unsigned short*)(L + SC_VT + d * 144 + r * 2) = (unsigned short)((i & 1) ? (vw >> 16) : (vw & 0xffffu));
              if (r == 0) DEC[d] = __expf(blast); }
#pragma unroll
          for (int i = 0; i < 2; ++i) {
              *(LAS v4u*)(L + SC_QT + r * 272 + cs * 32 + 16 * i) = (v4u){qt[4 * i], qt[4 * i + 1], qt[4 * i + 2], qt[4 * i + 3]};
              *(LAS v4u*)(L + SC_KT + r * 272 + cs * 32 + 16 * i) = (v4u){kt[4 * i], kt[4 * i + 1], kt[4 * i + 2], kt[4 * i + 3]};
              *(LAS v4u*)(L + SC_QH + r * 272 + cs * 32 + 16 * i) = (v4u){qh[4 * i], qh[4 * i + 1], qh[4 * i + 2], qh[4 * i + 3]}; } }
        __syncthreads();
        { const int ti = w >> 1;
#pragma unroll
          for (int jj = 0; jj < 2; ++jj) { const int tj = 2 * (w & 1) + jj; f32x4 a = (f32x4){0.f, 0.f, 0.f, 0.f};
              if (tj <= ti) {
#pragma unroll
                  for (int ks = 0; ks < 4; ++ks) { const bf16x8 af = *(const LAS bf16x8*)(L + SC_QT + (16 * ti + row16) * 272 + (32 * ks + 8 * quad) * 2);
                      const bf16x8 bfr = *(const LAS bf16x8*)(L + SC_KT + (16 * tj + row16) * 272 + (32 * ks + 8 * quad) * 2);
                      a = __builtin_amdgcn_mfma_f32_16x16x32_bf16(af, bfr, a, 0, 0, 0); } }
#pragma unroll
              for (int j = 0; j < 4; ++j) { const int t = 16 * ti + 4 * quad + j, s = 16 * tj + row16; const float v = (s <= t) ? a[j] : 0.f;
                  *(LAS unsigned short*)(L + SC_P + t * 144 + s * 2) = (unsigned short)f2bf(v); } } }
        f32x4 oacc[4];
#pragma unroll
        for (int mi = 0; mi < 4; ++mi) oacc[mi] = (f32x4){0.f, 0.f, 0.f, 0.f};
#pragma unroll
        for (int ks = 0; ks < 4; ++ks) { const f32x4 s0 = Sacc[2 * ks], s1 = Sacc[2 * ks + 1];
            v4u bw; bw.x = pk2(s0[0], s0[1]); bw.y = pk2(s0[2], s0[3]); bw.z = pk2(s1[0], s1[1]); bw.w = pk2(s1[2], s1[3]);
            const bf16x8 bfr = __builtin_bit_cast(bf16x8, bw);
#pragma unroll
            for (int mi = 0; mi < 4; ++mi) { const v2u a0 = *(const LAS v2u*)(L + SC_QH + (16 * mi + row16) * 272 + (32 * ks + 4 * quad) * 2), a1 = *(const LAS v2u*)(L + SC_QH + (16 * mi + row16) * 272 + (32 * ks + 16 + 4 * quad) * 2);
                const v4u aw = (v4u){a0.x, a0.y, a1.x, a1.y};
                oacc[mi] = __builtin_amdgcn_mfma_f32_16x16x32_bf16(__builtin_bit_cast(bf16x8, aw), bfr, oacc[mi], 0, 0, 0); } }
        bf16x8 vfr[2];
#pragma unroll
        for (int ks = 0; ks < 2; ++ks) vfr[ks] = *(const LAS bf16x8*)(L + SC_VT + (16 * w + row16) * 144 + (32 * ks + 8 * quad) * 2);
#pragma unroll
        for (int i2 = 0; i2 < 8; ++i2) { const f32x4 dc = *(const LAS f32x4*)(DEC + 16 * i2 + 4 * quad); f32x4 s = Sacc[i2] * dc;
#pragma unroll
            for (int ks = 0; ks < 2; ++ks) { const bf16x8 af = *(const LAS bf16x8*)(L + SC_KHT + (16 * i2 + row16) * 144 + (32 * ks + 8 * quad) * 2);
                s = __builtin_amdgcn_mfma_f32_16x16x32_bf16(af, vfr[ks], s, 0, 0, 0); }
            Sacc[i2] = s; }
        __syncthreads();
#pragma unroll
        for (int mi = 0; mi < 4; ++mi)
#pragma unroll
            for (int ks = 0; ks < 2; ++ks) { const bf16x8 af = *(const LAS bf16x8*)(L + SC_P + (16 * mi + row16) * 144 + (32 * ks + 8 * quad) * 2);
                oacc[mi] = __builtin_amdgcn_mfma_f32_16x16x32_bf16(af, vfr[ks], oacc[mi], 0, 0, 0); }
#pragma unroll
        for (int mi = 0; mi < 4; ++mi)
#pragma unroll
            for (int j = 0; j < 4; ++j) { const float v = oacc[mi][j]; float q = v * v;
                q += __shfl_xor(q, 1); q += __shfl_xor(q, 2); q += __shfl_xor(q, 4); q += __shfl_xor(q, 8);
                const int t = 16 * mi + 4 * quad + j;
                if (row16 == 0) SS[w * 64 + t] = q;
                *(LAS float*)(L + SC_OUT + t * 528 + (16 * w + row16) * 4) = v; }
        __syncthreads();
        { float ssum = 0.f;
#pragma unroll
          for (int ww = 0; ww < 8; ++ww) ssum += SS[ww * 64 + r];
          const float rstd = 1.0f / sqrtf(ssum * (1.0f / 128.0f) + RMS_EPS);
          unsigned ow[8];
#pragma unroll
          for (int i = 0; i < 4; ++i) { const f32x4 v = *(const LAS f32x4*)(L + SC_OUT + r * 528 + (cs * 16 + 4 * i) * 4);
              const unsigned g0 = cg[i >> 1][(2 * i) & 3], g1 = cg[i >> 1][(2 * i + 1) & 3];
              ow[2 * i] = pk2(v[0] * rstd * ng[4 * i] * bflo(g0), v[1] * rstd * ng[4 * i + 1] * bfhi(g0));
              ow[2 * i + 1] = pk2(v[2] * rstd * ng[4 * i + 2] * bflo(g1), v[3] * rstd * ng[4 * i + 3] * bfhi(g1)); }
          const size_t o = ((size_t)b * SEQ + c * 64 + r) * D + gcol;
          *(GAS v4u*)(O0 + o) = (v4u){ow[0], ow[1], ow[2], ow[3]}; *(GAS v4u*)(O0 + o + 8) = (v4u){ow[4], ow[5], ow[6], ow[7]}; }
    }
    __syncthreads();
}

constexpr int RT_WT = 0, RT_LCNT = 65536, RT_LBASE = RT_LCNT + 64, RT_INFO = RT_LBASE + 64;
__device__ __forceinline__ void ln_router_phase(Frame& F, const float* R, const float* lng, const float* lnb, const float* router_w, const float* router_b,
                                                bf16* X1B, gu32* cnt, int* DEST, float* GATE) {
    LAS unsigned char* L = F.lds + RING_OFF;
    LAS float* WT = (LAS float*)(L + RT_WT); LAS int* lcnt = (LAS int*)(L + RT_LCNT); LAS int* lbase = (LAS int*)(L + RT_LBASE); LAS int* info = (LAS int*)(L + RT_INFO);
    for (int idx = F.tid; idx < 16 * D; idx += NWAVES * 64) { const int col = idx >> 4, e = idx & 15; WT[e * D + col] = router_w[idx]; }
    if (F.tid < 16) lcnt[F.tid] = 0;
    f32x4 gv[4], bv[4];
#pragma unroll
    for (int j = 0; j < 4; ++j) { gv[j] = *(const f32x4*)(lng + 4 * F.lane + 256 * j); bv[j] = *(const f32x4*)(lnb + 4 * F.lane + 256 * j); }
    float rb[16];
#pragma unroll
    for (int e = 0; e < 16; ++e) rb[e] = router_b[e];
    __syncthreads();
    for (int base = F.vcu * 128; base < M; base += F.G * 128) {
        for (int i = 0; i < 16; ++i) {
            const int lr = F.wave * 16 + i, row = base + lr;
            const GAS f32x4* xr = (const GAS f32x4*)(R + (size_t)row * D) + F.lane;
            f32x4 v[4]; float s = 0.f;
#pragma unroll
            for (int j = 0; j < 4; ++j) { v[j] = xr[64 * j]; s += (v[j].x + v[j].y) + (v[j].z + v[j].w); }
            const float mean = wave_sum(s) * (1.f / D); float s2 = 0.f;
#pragma unroll
            for (int j = 0; j < 4; ++j) { v[j] = v[j] - mean; s2 += (v[j].x * v[j].x + v[j].y * v[j].y) + (v[j].z * v[j].z + v[j].w * v[j].w); }
            const float rstd = 1.f / sqrtf(wave_sum(s2) * (1.f / D) + LN_EPS);
            GAS v2u* o8 = (GAS v2u*)(X1B + (size_t)row * D) + F.lane;
#pragma unroll
            for (int j = 0; j < 4; ++j) { v[j] = v[j] * rstd * gv[j] + bv[j]; v2u o; o.x = pk2(v[j].x, v[j].y); o.y = pk2(v[j].z, v[j].w); o8[64 * j] = o; }
            float lg[16];
#pragma unroll
            for (int e = 0; e < 16; ++e) { float p = 0.f;
#pragma unroll
                for (int j = 0; j < 4; ++j) { const f32x4 wv = *(const LAS f32x4*)(WT + e * D + 4 * F.lane + 256 * j); p += (v[j].x * wv.x + v[j].y * wv.y) + (v[j].z * wv.z + v[j].w * wv.w); }
                lg[e] = wave_sum(p); }
            float mx = lg[0];
#pragma unroll
            for (int e = 1; e < 16; ++e) mx = fmaxf(mx, lg[e]);
            float pe[16], sum = 0.f;
#pragma unroll
            for (int e = 0; e < 16; ++e) { pe[e] = __expf(lg[e] - mx); sum += pe[e]; }
            const float inv = 1.0f / sum; float sel[16];
#pragma unroll
            for (int e = 0; e < 16; ++e) { pe[e] *= inv; sel[e] = pe[e] + rb[e]; }
            float gs[4];
#pragma unroll
            for (int g = 0; g < 4; ++g) { const float a = sel[4 * g], b2 = sel[4 * g + 1], c2 = sel[4 * g + 2], d2 = sel[4 * g + 3];
                const float hi1 = fmaxf(a, b2), lo1 = fminf(a, b2), hi2 = fmaxf(c2, d2), lo2 = fminf(c2, d2);
                gs[g] = fmaxf(hi1, hi2) + fmaxf(fminf(hi1, hi2), fmaxf(lo1, lo2)); }
            int gb = 0; float gbv = gs[0];
#pragma unroll
            for (int g = 1; g < 4; ++g) if (gs[g] > gbv) { gbv = gs[g]; gb = g; }
            float s4[4], p4[4];
#pragma unroll
            for (int k = 0; k < 4; ++k) { s4[k] = gb == 0 ? sel[k] : gb == 1 ? sel[4 + k] : gb == 2 ? sel[8 + k] : sel[12 + k]; p4[k] = gb == 0 ? pe[k] : gb == 1 ? pe[4 + k] : gb == 2 ? pe[8 + k] : pe[12 + k]; }
            int i0 = 0; float b0 = s4[0];
#pragma unroll
            for (int k = 1; k < 4; ++k) if (s4[k] > b0) { b0 = s4[k]; i0 = k; }
            int i1 = -1; float b1 = -INFINITY;
#pragma unroll
            for (int k = 0; k < 4; ++k) if (k != i0 && (i1 < 0 || s4[k] > b1)) { b1 = s4[k]; i1 = k; }
            const float q0 = i0 == 0 ? p4[0] : i0 == 1 ? p4[1] : i0 == 2 ? p4[2] : p4[3], q1 = i1 == 0 ? p4[0] : i1 == 1 ? p4[1] : i1 == 2 ? p4[2] : p4[3];
            const float den = 1.0f / (q0 + q1);
            if (F.lane == 0) { const int e0 = gb * 4 + i0, e1 = gb * 4 + i1;
                const int p0 = __hip_atomic_fetch_add(lcnt + e0, 1, __ATOMIC_RELAXED, __HIP_MEMORY_SCOPE_WORKGROUP), p1 = __hip_atomic_fetch_add(lcnt + e1, 1, __ATOMIC_RELAXED, __HIP_MEMORY_SCOPE_WORKGROUP);
                info[lr] = e0; info[128 + lr] = e1; info[256 + lr] = p0; info[384 + lr] = p1; info[512 + lr] = __float_as_int(q0 * den); info[640 + lr] = __float_as_int(q1 * den); }
        }
        __syncthreads();
        if (F.tid < 16) { const int n = lcnt[F.tid]; lbase[F.tid] = n ? (int)__hip_atomic_fetch_add(cnt + 64 * F.tid, (unsigned)n, RLX_AGENT) : 0; }
        __syncthreads();
        if (F.tid < 128) { const int lr = F.tid, row = base + lr; const int e0 = info[lr], e1 = info[128 + lr];
            const int d0 = e0 * ECAP + lbase[e0] + info[256 + lr], d1 = e1 * ECAP + lbase[e1] + info[384 + lr];
            DEST[d0] = row * 2; GATE[d0] = __int_as_float(info[512 + lr]); DEST[d1] = row * 2 + 1; GATE[d1] = __int_as_float(info[640 + lr]); }
        __syncthreads();
        if (F.tid < 16) lcnt[F.tid] = 0;
        __syncthreads();
    }
}
__device__ __forceinline__ int moe_table(Frame& F, gu32* cnt) {
    LAS int* tab = (LAS int*)(F.lds + MOETAB_OFF);
    __syncthreads();
    if (F.tid == 0) { int tiles = 0, slots = 0;
        for (int e = 0; e < 16; ++e) { const int n = (int)__hip_atomic_load(cnt + 64 * e, RLX_AGENT); tab[e] = tiles; tab[17 + e] = slots; tab[34 + e] = n; const int nt = (n + 255) >> 8; tiles += nt; slots += nt * 256; }
        tab[16] = tiles; tab[33] = slots; }
    __syncthreads();
    return tab[16] * 4;
}
template <bool FINAL> __device__ __forceinline__ void ln2_phase(Frame& F, const bf16* X1B, const bf16* Y2, const float* lng, const float* lnb, bf16* XOUT, float* out) {
    float gv[16], bv[16];
#pragma unroll
    for (int j = 0; j < 2; ++j)
#pragma unroll
        for (int i = 0; i < 8; ++i) { gv[8 * j + i] = lng[8 * F.lane + 512 * j + i]; bv[8 * j + i] = lnb[8 * F.lane + 512 * j + i]; }
    const int gw = F.vcu * NWAVES + F.wave, NGW = F.G * NWAVES;
    for (int m = gw; m < M; m += NGW) {
        float v[16]; float s = 0.f;
#pragma unroll
        for (int j = 0; j < 2; ++j) { const size_t c = 8 * F.lane + 512 * j;
            const v4u a = *(const GAS v4u*)(X1B + (size_t)m * D + c), y0 = *(const GAS v4u*)(Y2 + (size_t)(2 * m) * D + c), y1 = *(const GAS v4u*)(Y2 + (size_t)(2 * m + 1) * D + c);
#pragma unroll
            for (int i = 0; i < 4; ++i) { v[8 * j + 2 * i] = DN_ALPHA * bflo(a[i]) + (bflo(y0[i]) + bflo(y1[i])); v[8 * j + 2 * i + 1] = DN_ALPHA * bfhi(a[i]) + (bfhi(y0[i]) + bfhi(y1[i])); } }
#pragma unroll
        for (int i = 0; i < 16; ++i) s += v[i];
        const float mean = wave_sum(s) * (1.f / D); float s2 = 0.f;
#pragma unroll
        for (int i = 0; i < 16; ++i) { v[i] -= mean; s2 += v[i] * v[i]; }
        const float rstd = 1.f / sqrtf(wave_sum(s2) * (1.f / D) + LN_EPS);
#pragma unroll
        for (int i = 0; i < 16; ++i) v[i] = v[i] * rstd * gv[i] + bv[i];
#pragma unroll
        for (int j = 0; j < 2; ++j) { const size_t c = (size_t)m * D + 8 * F.lane + 512 * j;
            if (FINAL) { *(GAS f32x4*)(out + c) = (f32x4){v[8 * j], v[8 * j + 1], v[8 * j + 2], v[8 * j + 3]}; *(GAS f32x4*)(out + c + 4) = (f32x4){v[8 * j + 4], v[8 * j + 5], v[8 * j + 6], v[8 * j + 7]}; }
            else *(GAS v4u*)(XOUT + c) = (v4u){pk2(v[8 * j], v[8 * j + 1]), pk2(v[8 * j + 2], v[8 * j + 3]), pk2(v[8 * j + 4], v[8 * j + 5]), pk2(v[8 * j + 6], v[8 * j + 7])}; }
    }
}
__device__ __forceinline__ void combine_phase(Frame& F, const bf16* O1, const bf16* O2, const float* subln_g, const float* tab, bf16* OA) {
    const float lam = tab[1024];
    float gv[8];
#pragma unroll
    for (int i = 0; i < 8; ++i) gv[i] = subln_g[8 * (F.lane & 15) + i] * (1.0f - LAMBDA_INIT);
    const int gw = F.vcu * NWAVES + F.wave, NGW = F.G * NWAVES;
    for (int m = gw; m < M; m += NGW) {
#pragma unroll
        for (int j = 0; j < 2; ++j) { const size_t c = (size_t)m * D + 8 * F.lane + 512 * j;
            const v4u a = *(const GAS v4u*)(O1 + c), b2 = *(const GAS v4u*)(O2 + c); float v[8]; float q = 0.f;
#pragma unroll
            for (int i = 0; i < 4; ++i) { v[2 * i] = bflo(a[i]) - lam * bflo(b2[i]); v[2 * i + 1] = bfhi(a[i]) - lam * bfhi(b2[i]); q += v[2 * i] * v[2 * i] + v[2 * i + 1] * v[2 * i + 1]; }
            q += __shfl_xor(q, 1); q += __shfl_xor(q, 2); q += __shfl_xor(q, 4); q += __shfl_xor(q, 8);
            const float rstd = 1.0f / sqrtf(q * (1.0f / 128.0f) + RMS_EPS);
            *(GAS v4u*)(OA + c) = (v4u){pk2(v[0] * rstd * gv[0], v[1] * rstd * gv[1]), pk2(v[2] * rstd * gv[2], v[3] * rstd * gv[3]), pk2(v[4] * rstd * gv[4], v[5] * rstd * gv[5]), pk2(v[6] * rstd * gv[6], v[7] * rstd * gv[7])}; }
    }
}

struct Args { const float* in[19]; float* out; unsigned char* ws; int ph_lo, ph_hi; };
__global__ void __launch_bounds__(NWAVES * 64, 2) yoco_fwd(Args args) {
    extern __shared__ __attribute__((aligned(16))) unsigned char lds[];
    Frame F;
    F.lds = (LAS unsigned char*)lds;
    F.tid = threadIdx.x; F.lane = F.tid & 63; F.wave = __builtin_amdgcn_readfirstlane(F.tid >> 6);
    F.G = gridDim.x; { const int bx = blockIdx.x; F.vcu = (F.G % 8 == 0) ? (bx % 8) * (F.G / 8) + bx / 8 : bx; }
    unsigned char* ws = args.ws;
    F.ctl = (gu32*)(ws + WS_CTL);
    Inputs in;
    in.x = args.in[0]; in.a_w_in = args.in[1]; in.a_lb = args.in[2]; in.a_norm_g = args.in[3]; in.a_w_out = args.in[4]; in.kv_w = args.in[5]; in.b_w_q = args.in[6]; in.b_lam = args.in[7];
    in.b_subln_g = args.in[8]; in.b_w_out = args.in[9]; in.ln1_g = args.in[10]; in.ln1_b = args.in[11]; in.ln2_g = args.in[12]; in.ln2_b = args.in[13]; in.router_w = args.in[14]; in.router_b = args.in[15];
    in.moe_w_gate = args.in[16]; in.moe_w_up = args.in[17]; in.moe_w_down = args.in[18];
    for (int u = F.tid; u < (LDS_BYTES - LDSCTL_OFF) / 4; u += NWAVES * 64) ((LAS unsigned*)(F.lds + LDSCTL_OFF))[u] = 0u;
    __syncthreads();
    XcdBarrier bar; bar.bar = (unsigned*)(F.ctl + CW_BAR); bar.x = 0; bar.st = nullptr;
    if (N_LAUNCH_MODE == 1) bar = xcd_barrier_post((unsigned*)(F.ctl + CW_BAR), (volatile LAS unsigned*)(F.lds + MISC_OFF) + 8);
    const int lo = args.ph_lo, hi = args.ph_hi;
#ifndef PHASE_MASK
#define PHASE_MASK 0xffff
#endif
#define IN(k) (((PHASE_MASK >> (k)) & 1) && lo <= (k) && (k) < hi)
#define SEAM(k) do { if (IN(k) && IN((k) + 1)) xcd_barrier(bar); } while (0)
    bf16* const bA = (bf16*)(ws + WS_A); bf16* const bB = (bf16*)(ws + WS_B); bf16* const bC = (bf16*)(ws + WS_C); bf16* const bD = (bf16*)(ws + WS_D); bf16* const bE = (bf16*)(ws + WS_E); bf16* const bF = (bf16*)(ws + WS_F);
    const float* const tab = (const float*)(ws + WS_TAB);
    int* const DEST = (int*)(ws + WS_DEST); float* const GATE = (float*)(ws + WS_GATE);

    if (IN(0)) { p0_prologue(F, in, ws); } SEAM(0);
    if (IN(1)) {
        pg8::Gemm g{bA, (const bf16*)(ws + WS_WIN), D}; pg8::StaticOrder S; S.init(M, 4 * D, D, F.G, (int)blockIdx.x);
        pg8::EpiProj E{bB, bC, bD, bE, tab};
        pg8::gemm_phase<pg8::EpiProj, pg8::StaticOrder, true>(F.lds + RING_OFF, g, S, E);
    } SEAM(1);
    if (IN(2)) {
        const int nscan = F.G >= 128 ? 64 : 0;
        if ((int)blockIdx.x < 64 || nscan == 0) { for (int u = (int)blockIdx.x; u < 64; u += (nscan ? 64 : F.G)) scan_unit(F, u >> 3, u & 7, bB, bC, bD, bE, in.a_norm_g, bF); }
        if (nscan == 0) moe_weight_convert(F, in, ws, (int)blockIdx.x * NWAVES + F.wave, F.G * NWAVES);
        else if ((int)blockIdx.x >= 64) moe_weight_convert(F, in, ws, ((int)blockIdx.x - 64) * NWAVES + F.wave, (F.G - 64) * NWAVES);
    } SEAM(2);
    if (IN(3)) {
        pg8::Gemm g{bF, (const bf16*)(ws + WS_WOUT), D}; pg8::StaticOrder S; S.init(M, D, D, F.G, (int)blockIdx.x);
        pg8::EpiResid<false> E{in.x, (float*)bB, DN_ALPHA};
        pg8::gemm_phase<pg8::EpiResid<false>, pg8::StaticOrder, true>(F.lds + RING_OFF, g, S, E);
    } SEAM(3);
    if (IN(4)) { ln_router_phase(F, (const float*)bB, in.ln1_g, in.ln1_b, in.router_w, in.router_b, bA, F.ctl + CW_CNT, DEST, GATE); } SEAM(4);
    if (IN(5)) {
        const int total = moe_table(F, F.ctl + CW_CNT);
        pg8::Gemm g{bA, (const bf16*)(ws + WS_WGU), D};
        pg8::MoeOrder S{(const LAS int*)(F.lds + MOETAB_OFF), F.G, (int)blockIdx.x, total, D, DEST, (size_t)D * D, true};
        pg8::EpiGateUp E{bD};
        pg8::gemm_phase<pg8::EpiGateUp, pg8::MoeOrder, true>(F.lds + RING_OFF, g, S, E);
    } SEAM(5);
    if (IN(6)) {
        const int total = moe_table(F, F.ctl + CW_CNT);
        pg8::Gemm g{bD, (const bf16*)(ws + WS_WD), DEXP};
        pg8::MoeOrder S{(const LAS int*)(F.lds + MOETAB_OFF), F.G, (int)blockIdx.x, total, DEXP, DEST, (size_t)D * DEXP, false};
        pg8::EpiDown E{bB, DEST, GATE};
        pg8::gemm_phase<pg8::EpiDown, pg8::MoeOrder, true>(F.lds + RING_OFF, g, S, E);
    } SEAM(6);
    if (IN(7)) { ln2_phase<false>(F, bA, bB, in.ln2_g, in.ln2_b, bF, nullptr); } SEAM(7);
    if (IN(8)) {
        pg8::Gemm g{bF, (const bf16*)(ws + WS_WQKV), D}; pg8::StaticOrder S; S.init(M, 3 * D, D, F.G, (int)blockIdx.x);
        pg8::EpiBf16 E{bA, D, D, (size_t)(BUFSZ / 2), 1.0f};
        pg8::gemm_phase<pg8::EpiBf16, pg8::StaticOrder, true>(F.lds + RING_OFF, g, S, E);
    } SEAM(8);
    if (IN(9)) {
        const attn_body::DiffTensors AT{(const attn_body::bf16*)bA, (const attn_body::bf16*)bB, (const attn_body::bf16*)bC, (attn_body::bf16*)bD, (attn_body::bf16*)bE};
        attn_body::attn_phase<8>((char*)lds + RING_OFF, AT, F.vcu, F.G);
    } SEAM(9);
    if (IN(10)) { combine_phase(F, bD, bE, in.b_subln_g, tab, bC); } SEAM(10);
    if (IN(11)) {
        pg8::Gemm g{bC, (const bf16*)(ws + WS_WBO), D}; pg8::StaticOrder S; S.init(M, D, D, F.G, (int)blockIdx.x);
        pg8::EpiResid<true> E{bF, (float*)bA, DN_ALPHA};
        pg8::gemm_phase<pg8::EpiResid<true>, pg8::StaticOrder, true>(F.lds + RING_OFF, g, S, E);
    } SEAM(11);
    if (IN(12)) { ln_router_phase(F, (const float*)bA, in.ln1_g + D, in.ln1_b + D, in.router_w, in.router_b, bC, F.ctl + CW_CNT + 1024, DEST, GATE); } SEAM(12);
    if (IN(13)) {
        const int total = moe_table(F, F.ctl + CW_CNT + 1024);
        pg8::Gemm g{bC, (const bf16*)(ws + WS_WGU) + (size_t)NEXP * D * D, D};
        pg8::MoeOrder S{(const LAS int*)(F.lds + MOETAB_OFF), F.G, (int)blockIdx.x, total, D, DEST, (size_t)D * D, true};
        pg8::EpiGateUp E{bD};
        pg8::gemm_phase<pg8::EpiGateUp, pg8::MoeOrder, true>(F.lds + RING_OFF, g, S, E);
    } SEAM(13);
    if (IN(14)) {
        const int total = moe_table(F, F.ctl + CW_CNT + 1024);
        pg8::Gemm g{bD, (const bf16*)(ws + WS_WD) + (size_t)NEXP * D * DEXP, DEXP};
        pg8::MoeOrder S{(const LAS int*)(F.lds + MOETAB_OFF), F.G, (int)blockIdx.x, total, DEXP, DEST, (size_t)D * DEXP, false};
        pg8::EpiDown E{bA, DEST, GATE};
        pg8::gemm_phase<pg8::EpiDown, pg8::MoeOrder, true>(F.lds + RING_OFF, g, S, E);
    } SEAM(14);
    if (IN(15)) { ln2_phase<true>(F, bC, bA, in.ln2_g + D, in.ln2_b + D, nullptr, args.out); }
#undef IN
#undef SEAM
}

extern "C" void kernel_launch(void* const* d_in, const int* in_sizes, int n_in, void* d_out, int out_size, void* d_ws, size_t ws_size, hipStream_t stream) {
    static int grid = 0;
    if (grid == 0) {
        if (n_in != 19 || in_sizes[0] != M * D || out_size != M * D || ws_size < WS_END) { fprintf(stderr, "kernel_launch: unexpected shapes (n_in %d, in0 %d, out %d, ws %zu); nothing launched\n", n_in, n_in > 0 ? in_sizes[0] : -1, out_size, ws_size); grid = -1; return; }
        int dev = 0, cus = 0, per_cu = 0;
        if (hipGetDevice(&dev) != hipSuccess || hipDeviceGetAttribute(&cus, hipDeviceAttributeMultiprocessorCount, dev) != hipSuccess) { grid = -1; return; }
        if (hipFuncSetAttribute((const void*)yoco_fwd, hipFuncAttributeMaxDynamicSharedMemorySize, LDS_BYTES) != hipSuccess) { fprintf(stderr, "kernel_launch: hipFuncSetAttribute failed\n"); grid = -1; return; }
        if (hipOccupancyMaxActiveBlocksPerMultiprocessor(&per_cu, (const void*)yoco_fwd, NWAVES * 64, LDS_BYTES) != hipSuccess || per_cu < 1) { fprintf(stderr, "kernel_launch: occupancy query reports %d workgroups per CU\n", per_cu); }
        (void)hipGetLastError();
        grid = cus;
    }
    if (grid < 0) return;
    if (hipMemsetAsync((char*)d_ws + WS_CTL, 0, CTL_ZERO_BYTES, stream) != hipSuccess) return;
    Args a{};
    for (int i = 0; i < 19; ++i) a.in[i] = (const float*)d_in[i];
    a.out = (float*)d_out; a.ws = (unsigned char*)d_ws;
    if (N_LAUNCH_MODE == 1) { a.ph_lo = 0; a.ph_hi = N_PHASES; hipLaunchKernelGGL(yoco_fwd, dim3(grid), dim3(NWAVES * 64), LDS_BYTES, stream, a); }
    else for (int p = 0; p < N_PHASES; ++p) { a.ph_lo = p; a.ph_hi = p + 1; hipLaunchKernelGGL(yoco_fwd, dim3(grid), dim3(NWAVES * 64), LDS_BYTES, stream, a); }
}
```

```cpp
#include <hip/hip_runtime.h>
#include <hip/hip_bf16.h>
#include <cstdio>
#include <cstdint>
#include <cmath>

namespace pg8 {
#define PG8_LAS __attribute__((address_space(3)))
typedef unsigned short bf16_t;
typedef short bf16x8 __attribute__((ext_vector_type(8)));
typedef float f32x4 __attribute__((ext_vector_type(4)));
typedef float f32x2 __attribute__((ext_vector_type(2)));
typedef unsigned u32x4 __attribute__((ext_vector_type(4)));
typedef unsigned u32x2 __attribute__((ext_vector_type(2)));
constexpr int BM = 256, BK = 64, HALF = 128, HTB = HALF * BK * 2  , STAGE_BYTES = 8 * HTB, NXCD = 8, WGM = 8;

__host__ __device__ __forceinline__ int lds_byte(int r, int c) { const int st = (r >> 4) * 2 + (c >> 5), rr = r & 15, cc = c & 31, ob = rr * 64 + cc * 2; return st * 1024 + (ob ^ (((ob >> 9) & 1) << 5)); }
__host__ __device__ __forceinline__ void stage_rc(int b, int& R, int& C) { const int st = b / 1024, sb = b % 1024, swz = sb ^ (((sb >> 9) & 1) << 5); R = (st >> 1) * 16 + swz / 64; C = (st & 1) * 32 + (swz % 64) / 2; }
__host__ __device__ __forceinline__ int perm32(int rho) { const int n = rho >> 4, i = rho & 15; return 8 * (i >> 2) + 4 * n + (i & 3); }

struct Unit { int pm, pn, e, row0, cnt, slot0, qm; };
struct Gemm { const void* A; const void* Bt; int K; };
typedef int v8i_t __attribute__((ext_vector_type(8)));
typedef int v4i_t __attribute__((ext_vector_type(4)));

struct StaticOrder {
    int nM, nN, nwg, G, c, K;
    __device__ void init(int M, int N, int K_, int G_, int c_) { nM = M / BM; nN = N / BM; nwg = nM * nN; G = G_; c = c_; K = K_; }
    __device__ bool next(int i, Unit& u) const {
        const long L = (long)i * G + c; if (L >= nwg) return false;
        int wgid = (int)L; { const int q = nwg / NXCD, r = nwg % NXCD, xcd = wgid % NXCD, off = wgid / NXCD; wgid = (xcd < r ? xcd * (q + 1) : r * (q + 1) + (xcd - r) * q) + off; }
        const int nig = WGM * nN, gid = wgid / nig, fm = gid * WGM, gsz = (nM - fm) < WGM ? (nM - fm) : WGM;
        u.pm = fm + ((wgid % nig) % gsz); u.pn = (wgid % nig) / gsz; u.e = 0; u.row0 = 0; u.cnt = BM; u.slot0 = u.pm * BM; u.qm = 15; return true;
    }
    __device__ __forceinline__ int a_row(const Unit& u, int r) const { return u.pm * BM + r; }
    __device__ __forceinline__ size_t b_off(const Unit& u) const { return (size_t)u.pn * BM * K; }
};
#ifndef MOE_QUARTERS
#define MOE_QUARTERS 1
#endif
struct MoeOrder {
    const PG8_LAS int* tab; int G, c, total, K; const int* dest; size_t wstride; bool gather; const PG8_LAS int* rows;
    __device__ bool next(int i, Unit& u) const {
        const int nfr = total / G, rem = total - nfr * G; int L, qm = 15;
        if (i < nfr) L = i * G + c;
        else if (i > nfr || rem == 0) return false;
        else if (MOE_QUARTERS && 4 * rem <= G) { if ((c >> 2) >= rem) return false; L = nfr * G + (c >> 2); qm = 1 << (c & 3); }
        else if (MOE_QUARTERS && 2 * rem <= G) { if ((c >> 1) >= rem) return false; L = nfr * G + (c >> 1); qm = (c & 1) ? 12 : 3; }
        else { L = nfr * G + c; if (L >= total) return false; }
        const int rt = L >> 2; int e = 0;
#pragma unroll
        for (int j = 1; j < 16; ++j) e += (rt >= tab[j]) ? 1 : 0;
        u.e = e; u.row0 = (rt - tab[e]) * BM; u.cnt = tab[34 + e]; u.slot0 = tab[17 + e] + u.row0; u.pm = i  ; u.pn = L & 3; u.qm = qm;
        if (qm != 15) { const int q0 = (qm & 3) ? ((qm & 1) ? 0 : 64) : ((qm & 4) ? 128 : 192); if (u.row0 + q0 >= u.cnt) return false; }
        return true;
    }
    __device__ __forceinline__ int a_row(const Unit& u, int r) const {
        if (!gather) return u.slot0 + r;
        return rows[(u.pm & 7) * BM + r];
    }
    __device__ __forceinline__ void fill_rows(PG8_LAS int* rows_w) const {
        for (int q = threadIdx.x; q < 8 * BM; q += 512) { Unit u; int v = 0;
            if (next(q >> 8, u)) { const int idx = u.row0 + (q & 255); v = idx < u.cnt ? (dest[u.e * 32768 + idx] >> 1) : 0; }
            rows_w[q] = v; }
        __syncthreads();
    }
    __device__ __forceinline__ void fill_dest(PG8_LAS int* dg_w, const float* gate) const {
        for (int q = threadIdx.x; q < 5 * BM; q += 512) { Unit u; int d = -1, gb = 0;
            if (next(q >> 8, u)) { const int idx = u.row0 + (q & 255); if (idx < u.cnt) { d = dest[u.e * 32768 + idx]; gb = __float_as_int(gate[u.e * 32768 + idx]); } }
            dg_w[2 * q] = d; dg_w[2 * q + 1] = gb; }
        __syncthreads();
    }
    __device__ __forceinline__ size_t b_off(const Unit& u) const { return (size_t)u.e * wstride + (size_t)u.pn * BM * K; }
};

__device__ __forceinline__ unsigned cvt_pk_bf16(float lo, float hi) { unsigned r; asm volatile("v_cvt_pk_bf16_f32 %0, %1, %2" : "=v"(r) : "v"(lo), "v"(hi)); return r; }
__device__ __forceinline__ float bf_lo(unsigned u) { return __uint_as_float(u << 16); }
__device__ __forceinline__ float bf_hi(unsigned u) { return __uint_as_float(u & 0xffff0000u); }
__device__ __forceinline__ float sigmoidf_(float x) { return __builtin_amdgcn_rcpf(1.0f + __expf(-x)); }
__device__ __forceinline__ unsigned cvt_pk_f16(float lo, float hi) { typedef __fp16 h2 __attribute__((ext_vector_type(2))); h2 v = __builtin_amdgcn_cvt_pkrtz(lo, hi); return __builtin_bit_cast(unsigned, v); }

#ifndef EPI_NT
#define EPI_NT 0
#endif
template <class V> __device__ __forceinline__ void epi_st(V* p, const V v) {
    if (EPI_NT == 1) __builtin_nontemporal_store(v, p);
    else if (EPI_NT == 2) { if constexpr (sizeof(V) == 16) asm volatile("global_store_dwordx4 %0, %1, off sc1\n\ts_nop 0" :: "v"(p), "v"(v) : "memory"); else asm volatile("global_store_dwordx2 %0, %1, off sc1\n\ts_nop 0" :: "v"(p), "v"(v) : "memory"); }
    else if (EPI_NT == 3) { if constexpr (sizeof(V) == 16) asm volatile("global_store_dwordx4 %0, %1, off sc0 sc1\n\ts_nop 0" :: "v"(p), "v"(v) : "memory"); else asm volatile("global_store_dwordx2 %0, %1, off sc0 sc1\n\ts_nop 0" :: "v"(p), "v"(v) : "memory"); }
    else *p = v; }
struct EpiBf16 {
    static constexpr int NST = 16; static constexpr bool PERM = true;
    bf16_t* O; int ldc; int split_cols; size_t split_stride; float scale0;
    __device__ __forceinline__ void operator()(const f32x4 (&acc)[2][2][4][2], const Unit& u, int wr, int wc, int fr, int fq) const {
        const int row0 = u.pm * BM + wr * 64 + fr; int colt = u.pn * BM; bf16_t* base = O;
        float sc = 1.f; if (split_cols) { const int t = colt / split_cols; base += (size_t)t * split_stride; colt -= t * split_cols; if (t == 0) sc = scale0; }
        const int col0 = colt + wc * 32 + 8 * fq;
#pragma unroll
        for (int ai = 0; ai < 2; ++ai)
#pragma unroll
            for (int m = 0; m < 4; ++m) { bf16_t* rowp = base + (size_t)(row0 + ai * HALF + m * 16) * ldc + col0;
#pragma unroll
                for (int bj = 0; bj < 2; ++bj) { const f32x4 v0 = acc[ai][bj][m][0] * sc, v1 = acc[ai][bj][m][1] * sc;
                    u32x4 w; w.x = cvt_pk_bf16(v0[0], v0[1]); w.y = cvt_pk_bf16(v0[2], v0[3]); w.z = cvt_pk_bf16(v1[0], v1[1]); w.w = cvt_pk_bf16(v1[2], v1[3]);
                    epi_st((u32x4*)(rowp + bj * HALF), w); } }
    }
};
struct EpiProj {
    static constexpr int NST = 16; static constexpr bool PERM = true;
    bf16_t *Q, *LF, *V, *G; const float* lb; int gmap;
    __device__ __forceinline__ void operator()(const f32x4 (&acc)[2][2][4][2], const Unit& u, int wr, int wc, int fr, int fq) const {
        const int grp = (gmap >> (4 * (u.pn >> 2))) & 15, row0 = u.pm * BM + wr * 64 + fr, col0 = (u.pn & 3) * BM + wc * 32 + 8 * fq;
        bf16_t* base = grp == 0 ? Q : grp == 1 ? LF : grp == 2 ? V : G;
        f32x4 lbv[2][2];
#pragma unroll
        for (int bj = 0; bj < 2; ++bj)
#pragma unroll
            for (int n = 0; n < 2; ++n) lbv[bj][n] = *(const f32x4*)(lb + col0 + bj * HALF + 4 * n);
#pragma unroll
        for (int ai = 0; ai < 2; ++ai)
#pragma unroll
            for (int m = 0; m < 4; ++m) { bf16_t* rowp = base + (size_t)(row0 + ai * HALF + m * 16) * 1024 + col0;
#pragma unroll
                for (int bj = 0; bj < 2; ++bj) { f32x4 v[2] = {acc[ai][bj][m][0], acc[ai][bj][m][1]}; u32x4 w;
                    if (grp == 1) {
#pragma unroll
                        for (int n = 0; n < 2; ++n)
#pragma unroll
                            for (int j = 0; j < 4; ++j) { const float l = lbv[bj][n][j]; v[n][j] = l + (1.0f - l) * sigmoidf_(v[n][j]); }
                        w.x = cvt_pk_f16(v[0][0], v[0][1]); w.y = cvt_pk_f16(v[0][2], v[0][3]); w.z = cvt_pk_f16(v[1][0], v[1][1]); w.w = cvt_pk_f16(v[1][2], v[1][3]);
                    } else {
                        w.x = cvt_pk_bf16(v[0][0], v[0][1]); w.y = cvt_pk_bf16(v[0][2], v[0][3]); w.z = cvt_pk_bf16(v[1][0], v[1][1]); w.w = cvt_pk_bf16(v[1][2], v[1][3]);
                    }
                    epi_st((u32x4*)(rowp + bj * HALF), w); } }
    }
};
template <bool RES_BF16, bool OUT_BF16 = false> struct EpiResid {
    static constexpr int NST = 8; static constexpr bool PERM = false;
    const void* res; float* R; float alpha;
    __device__ __forceinline__ void operator()(const f32x4 (&acc)[2][2][4][2], const Unit& u, int wr, int wc, int fr, int fq) const {
        const int row0 = u.pm * BM + wr * 64 + fr, col0 = u.pn * BM + wc * 32 + 4 * fq;
#pragma unroll
        for (int ai = 0; ai < 2; ++ai)
#pragma unroll
          for (int mp = 0; mp < 2; ++mp) {
            f32x4 rv[2][2][2];
#pragma unroll
            for (int mm = 0; mm < 2; ++mm) { const size_t off = (size_t)(row0 + ai * HALF + (2 * mp + mm) * 16) * 1024 + col0;
#pragma unroll
                for (int bj = 0; bj < 2; ++bj)
#pragma unroll
                    for (int n = 0; n < 2; ++n) { const size_t o = off + bj * HALF + n * 16;
                        if (RES_BF16) { const u32x2 p = *(const u32x2*)((const bf16_t*)res + o); rv[mm][bj][n] = (f32x4){bf_lo(p.x), bf_hi(p.x), bf_lo(p.y), bf_hi(p.y)}; }
                        else rv[mm][bj][n] = *(const f32x4*)((const float*)res + o); } }
            asm volatile("" ::: "memory");
#pragma unroll
            for (int mm = 0; mm < 2; ++mm) { const int m = 2 * mp + mm; const size_t off = (size_t)(row0 + ai * HALF + m * 16) * 1024 + col0;
#pragma unroll
                for (int bj = 0; bj < 2; ++bj)
#pragma unroll
                    for (int n = 0; n < 2; ++n) { const size_t o = off + bj * HALF + n * 16;
                        const f32x4 ov = rv[mm][bj][n] * alpha + acc[ai][bj][m][n];
                        if (OUT_BF16) *(u32x2*)((bf16_t*)R + o) = (u32x2){cvt_pk_bf16(ov[0], ov[1]), cvt_pk_bf16(ov[2], ov[3])}; else *(f32x4*)(R + o) = ov; } }
            asm volatile("" ::: "memory"); }
    }
};
struct EpiGateUp {
    static constexpr int NST = 8; static constexpr bool PERM = true;
    bf16_t* H;
    __device__ __forceinline__ void operator()(const f32x4 (&acc)[2][2][4][2], const Unit& u, int wr, int wc, int fr, int fq) const {
        const int row0 = u.slot0 + wr * 64 + fr, col0 = u.pn * HALF + wc * 32 + 8 * fq;
#pragma unroll
        for (int ai = 0; ai < 2; ++ai)
#pragma unroll
            for (int m = 0; m < 4; ++m) { f32x4 h[2];
#pragma unroll
                for (int n = 0; n < 2; ++n)
#pragma unroll
                    for (int j = 0; j < 4; ++j) { const float g = acc[ai][0][m][n][j]; h[n][j] = g * sigmoidf_(g) * acc[ai][1][m][n][j]; }
                u32x4 w; w.x = cvt_pk_bf16(h[0][0], h[0][1]); w.y = cvt_pk_bf16(h[0][2], h[0][3]); w.z = cvt_pk_bf16(h[1][0], h[1][1]); w.w = cvt_pk_bf16(h[1][2], h[1][3]);
                *(u32x4*)(H + (size_t)(row0 + ai * HALF + m * 16) * 512 + col0) = w; }
    }
};
struct EpiGateUp8 {
    static constexpr int NST = 8; static constexpr bool PERM = true;
    unsigned char* H;
    __device__ __forceinline__ void operator()(const f32x4 (&acc)[2][2][4][2], const Unit& u, int wr, int wc, int fr, int fq) const {
        const int row0 = u.slot0 + wr * 64 + fr, col0 = u.pn * HALF + wc * 32 + 8 * fq;
#pragma unroll
        for (int ai = 0; ai < 2; ++ai) { if (!((u.qm >> (2 * ai + wr)) & 1)) continue;
#pragma unroll
            for (int m = 0; m < 4; ++m) { f32x4 h[2];
#pragma unroll
                for (int n = 0; n < 2; ++n)
#pragma unroll
                    for (int j = 0; j < 4; ++j) { const float g = acc[ai][0][m][n][j]; h[n][j] = g * sigmoidf_(g) * acc[ai][1][m][n][j]; }
                int w0 = 0, w1 = 0;
                w0 = __builtin_amdgcn_cvt_pk_fp8_f32(h[0][0], h[0][1], w0, false); w0 = __builtin_amdgcn_cvt_pk_fp8_f32(h[0][2], h[0][3], w0, true);
                w1 = __builtin_amdgcn_cvt_pk_fp8_f32(h[1][0], h[1][1], w1, false); w1 = __builtin_amdgcn_cvt_pk_fp8_f32(h[1][2], h[1][3], w1, true);
                epi_st((u32x2*)(H + (size_t)(row0 + ai * HALF + m * 16) * 512 + col0), (u32x2){(unsigned)w0, (unsigned)w1}); } }
    }
};
template <bool OUT8 = false> struct EpiDown {
    static constexpr int NST = 0; static constexpr bool PERM = true;
    bf16_t* Y2; const int* dest; const float* gate; const PG8_LAS int* dg;
    __device__ __forceinline__ void operator()(const f32x4 (&acc)[2][2][4][2], const Unit& u, int wr, int wc, int fr, int fq) const {
        const int col0 = u.pn * BM + wc * 32 + 8 * fq;
        int dd[2][4]; float gg[2][4];
#pragma unroll
        for (int ai = 0; ai < 2; ++ai)
#pragma unroll
            for (int m = 0; m < 4; ++m) { const int tr = ai * HALF + wr * 64 + m * 16 + fr, idx = u.row0 + tr; const bool ok = idx < u.cnt;
                if (!((u.qm >> (2 * ai + wr)) & 1)) { dd[ai][m] = -1; gg[ai][m] = 0.f; continue; }
                if (dg) { const u32x2 t = *(const PG8_LAS u32x2*)(dg + 2 * ((u.pm % 5) * BM + tr)); dd[ai][m] = (int)t.x; gg[ai][m] = __uint_as_float(t.y); }
                else { dd[ai][m] = ok ? dest[u.e * 32768 + idx] : -1; gg[ai][m] = ok ? gate[u.e * 32768 + idx] : 0.f; } }
        asm volatile("" ::: "memory");
#pragma unroll
        for (int ai = 0; ai < 2; ++ai)
#pragma unroll
            for (int m = 0; m < 4; ++m) { const int d = dd[ai][m];
                if (d >= 0) { const float gt = gg[ai][m]; bf16_t* rowp = Y2 + (size_t)d * 1024 + col0;
#pragma unroll
                    for (int bj = 0; bj < 2; ++bj) { const f32x4 v0 = acc[ai][bj][m][0] * gt, v1 = acc[ai][bj][m][1] * gt;
                        if (OUT8) { int w0 = 0, w1 = 0; w0 = __builtin_amdgcn_cvt_pk_fp8_f32(v0[0], v0[1], w0, false); w0 = __builtin_amdgcn_cvt_pk_fp8_f32(v0[2], v0[3], w0, true);
                            w1 = __builtin_amdgcn_cvt_pk_fp8_f32(v1[0], v1[1], w1, false); w1 = __builtin_amdgcn_cvt_pk_fp8_f32(v1[2], v1[3], w1, true);
                            *(u32x2*)((unsigned char*)Y2 + (size_t)d * 1024 + col0 + bj * HALF) = (u32x2){(unsigned)w0, (unsigned)w1}; continue; }
                        u32x4 w; w.x = cvt_pk_bf16(v0[0], v0[1]); w.y = cvt_pk_bf16(v0[2], v0[3]); w.z = cvt_pk_bf16(v1[0], v1[1]); w.w = cvt_pk_bf16(v1[2], v1[3]);
                        *(u32x4*)(rowp + bj * HALF) = w; } } }
    }
};

#ifndef RELAX_EPI
#define RELAX_EPI 0
#endif
template <class Epi, class Sched, bool ALIGN_EPI, bool F8 = false, int KREP = 1, bool QSKIP = false>
__device__ __forceinline__ void gemm_phase(PG8_LAS unsigned char* lds, const Gemm g, const Sched& S, const Epi& E) {
    const int tid = threadIdx.x, wid = __builtin_amdgcn_readfirstlane(tid >> 6), lane = tid & 63, wr = wid >> 2, wc = wid & 3, fr = lane & 15, fq = lane >> 4;
    const int K = g.K, PB = F8 ? K : 2 * K  , nt = PB / 128;
    int sR[2]; unsigned sC2[2], voffB[2];
#pragma unroll
    for (int i = 0; i < 2; ++i) { int R, C; stage_rc(tid * 16 + i * 8192, R, C); const int Rb = Epi::PERM ? ((R & ~31) + perm32(R & 31)) : R;
        sR[i] = R; sC2[i] = (unsigned)C * 2u; voffB[i] = (unsigned)(Rb * PB) + (unsigned)C * 2u; }
#define PG8_MKA(dst, u) do { _Pragma("unroll") for (int _h = 0; _h < 2; ++_h) _Pragma("unroll") for (int _i = 0; _i < 2; ++_i) \
        dst[_h][_i] = (unsigned)S.a_row(u, sR[_i] + HALF * _h) * (unsigned)PB + sC2[_i]; } while (0)
    const size_t kstep = (size_t)(BK * 2);
    const size_t hstep = (size_t)HALF * PB;
    const unsigned ldsw = (unsigned)wid * 1024u;
    const int aoff = lds_byte(wr * 64 + fr, fq * 8), boff = lds_byte(wc * 32 + fr, fq * 8);
#define PG8_SA(b, h) (((b) * 2 + (h)) * HTB)
#define PG8_SB(b, h) ((4 + (b) * 2 + (h)) * HTB)
#define PG8_STAGE(bufoff, gbase, voff) do { _Pragma("unroll") for (int _i = 0; _i < 2; ++_i) \
        __builtin_amdgcn_global_load_lds((const unsigned*)((const char*)(gbase) + (voff)[_i]), (PG8_LAS unsigned*)(lds + (bufoff) + ldsw + _i * 8192), 16, 0, 0); } while (0)
#define PG8_LDA(dst, b, h) do { _Pragma("unroll") for (int m = 0; m < 4; ++m) { if constexpr (F8) { dst##8[m].lo = *(const PG8_LAS v4i_t*)(lds + PG8_SA(b, h) + aoff + m * 2048); dst##8[m].hi = *(const PG8_LAS v4i_t*)(lds + PG8_SA(b, h) + aoff + m * 2048 + 1024); } \
        else { _Pragma("unroll") for (int k = 0; k < 2; ++k) dst[m][k] = *(const PG8_LAS bf16x8*)(lds + PG8_SA(b, h) + aoff + m * 2048 + k * 1024); } } } while (0)
#define PG8_LDB(dst, b, h) do { _Pragma("unroll") for (int n = 0; n < 2; ++n) { if constexpr (F8) { dst##8[n].lo = *(const PG8_LAS v4i_t*)(lds + PG8_SB(b, h) + boff + n * 2048); dst##8[n].hi = *(const PG8_LAS v4i_t*)(lds + PG8_SB(b, h) + boff + n * 2048 + 1024); } \
        else { _Pragma("unroll") for (int k = 0; k < 2; ++k) dst[n][k] = *(const PG8_LAS bf16x8*)(lds + PG8_SB(b, h) + boff + n * 2048 + k * 1024); } } } while (0)
#define PG8_MMA(ai, bj, At, Bt) do { __builtin_amdgcn_s_setprio(1); _Pragma("unroll") for (int m = 0; m < 4; ++m) _Pragma("unroll") for (int n = 0; n < 2; ++n) { \
        if constexpr (F8) asm volatile("v_mfma_scale_f32_16x16x128_f8f6f4 %0, %1, %2, %0, %3, %4 op_sel_hi:[0,0,0]" : "+v"(acc[ai][bj][m][n]) : "v"(Bt##8[n]), "v"(At##8[m]), "v"(sc_w), "v"(sc_a)); \
        else { _Pragma("unroll") for (int k = 0; k < 2; ++k) acc[ai][bj][m][n] = __builtin_amdgcn_mfma_f32_16x16x32_bf16(Bt[n][k], At[m][k], acc[ai][bj][m][n], 0, 0, 0); } } __builtin_amdgcn_s_setprio(0); } while (0)
#define PG8_WAIT_V(n) asm volatile("s_waitcnt vmcnt(" #n ")" ::: "memory")
#define PG8_WAIT_L(n) asm volatile("s_waitcnt lgkmcnt(" #n ")" ::: "memory")
#define PG8_WAIT_VF do { if constexpr (RELAX_EPI && Epi::NST > 0) asm volatile("s_cmp_lg_u32 %0, 0\n\ts_cbranch_scc1 1f\n\ts_waitcnt vmcnt(8)\n\ts_branch 2f\n1:\ts_waitcnt vmcnt(%1)\n2:" :: "s"(fresh), "n"(8 + Epi::NST) : "scc", "memory"); else PG8_WAIT_V(8); } while (0)
#define PG8_BAR __builtin_amdgcn_s_barrier()
#define PG8_SCHED __builtin_amdgcn_sched_barrier(0)
    Unit cur, nxt; int ui = 0;
    if (!S.next(0, cur)) return;
    int qa0 = 1, qa1 = 1;
#define PG8_QSET(u) do { if constexpr (QSKIP) { const int q_ = __builtin_amdgcn_readfirstlane((u).qm); qa0 = (q_ >> wr) & 1; qa1 = (q_ >> (2 + wr)) & 1; } } while (0)
    PG8_QSET(cur);
    f32x4 acc[2][2][4][2];
#pragma unroll
    for (int a = 0; a < 2; ++a)
#pragma unroll
        for (int b = 0; b < 2; ++b)
#pragma unroll
            for (int m = 0; m < 4; ++m)
#pragma unroll
                for (int n = 0; n < 2; ++n) acc[a][b][m][n] = (f32x4){0.f, 0.f, 0.f, 0.f};
    bf16x8 At[4][2], B0[2][2], B1[2][2];
    v8i_t At8[4], B08[2], B18[2];
    const int sc_w = 0x79797979, sc_a = 0x7F7F7F7F;
    unsigned cVA[2][2], nVA[2][2];
    PG8_MKA(cVA, cur);
    const char* const gA = (const char*)g.A;
    const char* cB = (const char*)g.Bt + S.b_off(cur) * (F8 ? 1 : 2);
    PG8_STAGE(PG8_SB(0, 0), cB, voffB); PG8_STAGE(PG8_SB(0, 1), cB + hstep, voffB); PG8_STAGE(PG8_SA(0, 0), gA, cVA[0]); PG8_STAGE(PG8_SA(0, 1), gA, cVA[1]);
    if (wr == 1) PG8_BAR;
    PG8_WAIT_V(2); PG8_BAR;
    PG8_STAGE(PG8_SB(1, 0), cB + kstep, voffB); PG8_STAGE(PG8_SA(1, 0), gA + kstep, cVA[0]); PG8_STAGE(PG8_SB(1, 1), cB + hstep + kstep, voffB);
    PG8_WAIT_V(6); PG8_BAR;
    for (;;) {
        const bool has_next = S.next(ui + 1, nxt);
        const char* nB = cB;
        if (has_next) { PG8_MKA(nVA, nxt); nB = (const char*)g.Bt + S.b_off(nxt) * (F8 ? 1 : 2); }
        else {
#pragma unroll
            for (int _h = 0; _h < 2; ++_h)
#pragma unroll
                for (int _i = 0; _i < 2; ++_i) nVA[_h][_i] = cVA[_h][_i]; }
        for (int tt = 0; tt < nt * KREP; tt += 2) {
            const int t = KREP > 1 ? tt % nt : tt, t2 = KREP > 1 ? (tt + 2) % nt : tt + 2;
            const bool last = (tt == nt * KREP - 2); const int fresh = __builtin_amdgcn_readfirstlane((RELAX_EPI && Epi::NST > 0 && (tt == 0) && (ui > 0)) ? 1 : 0);
            const char* a1 = gA + (size_t)(t + 1) * kstep;
            const char* a2 = last ? gA : gA + (size_t)t2 * kstep; const char* b2 = last ? nB : cB + (size_t)t2 * kstep;
            const char* a3 = a2 + kstep; const char* b3 = b2 + kstep;
            unsigned xA0[2], xA1[2];
#pragma unroll
            for (int _i = 0; _i < 2; ++_i) { xA0[_i] = last ? nVA[0][_i] : cVA[0][_i]; xA1[_i] = last ? nVA[1][_i] : cVA[1][_i]; }
            PG8_LDB(B0, 0, 0); PG8_LDB(B1, 0, 1); PG8_SCHED; PG8_LDA(At, 0, 0); PG8_STAGE(PG8_SA(1, 1), a1, cVA[1]);
            PG8_WAIT_VF;
            PG8_WAIT_L(0); PG8_BAR; if (!QSKIP || qa0) { PG8_MMA(0, 0, At, B0); PG8_MMA(0, 1, At, B1); } PG8_BAR; PG8_SCHED;
            PG8_LDA(At, 0, 1); PG8_STAGE(PG8_SB(0, 0), b2, voffB); PG8_STAGE(PG8_SB(0, 1), b2 + hstep, voffB); PG8_STAGE(PG8_SA(0, 0), a2, xA0);
            PG8_WAIT_VF;
            PG8_WAIT_L(0); PG8_BAR; if (!QSKIP || qa1) { PG8_MMA(1, 0, At, B0); PG8_MMA(1, 1, At, B1); } PG8_BAR; PG8_SCHED;
            PG8_LDB(B0, 1, 0); PG8_LDB(B1, 1, 1); PG8_SCHED; PG8_LDA(At, 1, 0); PG8_STAGE(PG8_SA(0, 1), a2, xA1);
            PG8_WAIT_V(8); PG8_WAIT_L(0); PG8_BAR; if (!QSKIP || qa0) { PG8_MMA(0, 0, At, B0); PG8_MMA(0, 1, At, B1); } PG8_BAR; PG8_SCHED;
            PG8_LDA(At, 1, 1); PG8_STAGE(PG8_SB(1, 0), b3, voffB); PG8_STAGE(PG8_SB(1, 1), b3 + hstep, voffB); PG8_STAGE(PG8_SA(1, 0), a3, xA0);
            PG8_WAIT_V(8); PG8_WAIT_L(0); PG8_BAR; if (!QSKIP || qa1) { PG8_MMA(1, 0, At, B0); PG8_MMA(1, 1, At, B1); } PG8_BAR; PG8_SCHED;
        }
        if constexpr (ALIGN_EPI) { if (wr == 0) PG8_BAR; }
        if constexpr (F8) asm volatile("s_nop 15\n\ts_nop 15" ::: "memory");
        if constexpr (KREP > 1) {
#pragma unroll
            for (int a = 0; a < 2; ++a)
#pragma unroll
                for (int b = 0; b < 2; ++b)
#pragma unroll
                    for (int m = 0; m < 4; ++m)
#pragma unroll
                        for (int n = 0; n < 2; ++n) acc[a][b][m][n] = acc[a][b][m][n] * (1.0f / KREP); }
        E(acc, cur, wr, wc, fr, fq);
#ifdef PROBE_EPIREP
        if constexpr (KREP == 3) { asm volatile("" ::: "memory"); E(acc, cur, wr, wc, fr, fq); }
#endif
        if (!has_next) break;
#pragma unroll
        for (int a = 0; a < 2; ++a)
#pragma unroll
            for (int b = 0; b < 2; ++b)
#pragma unroll
                for (int m = 0; m < 4; ++m)
#pragma unroll
                    for (int n = 0; n < 2; ++n) acc[a][b][m][n] = (f32x4){0.f, 0.f, 0.f, 0.f};
        cur = nxt; cB = nB; ++ui; PG8_QSET(cur);
#pragma unroll
        for (int _h = 0; _h < 2; ++_h)
#pragma unroll
            for (int _i = 0; _i < 2; ++_i) cVA[_h][_i] = nVA[_h][_i];
        if constexpr (ALIGN_EPI) { if (wr == 1) PG8_BAR; }
    }
    PG8_WAIT_V(0);
    if constexpr (!ALIGN_EPI) { if (wr == 0) PG8_BAR; }
    PG8_BAR;
#undef PG8_MKA
#undef PG8_SA
#undef PG8_SB
#undef PG8_STAGE
#undef PG8_LDA
#undef PG8_LDB
#undef PG8_MMA
#undef PG8_WAIT_V
#undef PG8_WAIT_L
#undef PG8_BAR
#undef PG8_SCHED
}
}
#include <hip/hip_bf16.h>
#include <cmath>
namespace attn_body {
using bf16=__hip_bfloat16;
using bf16x8=__attribute__((ext_vector_type(8)))short;
using s16x4=__attribute__((ext_vector_type(4)))short;
using f32x16=__attribute__((ext_vector_type(16)))float;
using u32x4=__attribute__((ext_vector_type(4)))unsigned;
constexpr int SEQ=4096,D=64,DM=1024;
constexpr int NW=8,QBLK=32,QB=QBLK*NW,KVBLK=64,NQB=SEQ/QB;
constexpr int ATTN_PITCH=DM, ATTN_UNIT_ROWS=QB;
__device__ __forceinline__ int crow(int r,int hi){return (r&3)+8*(r>>2)+4*hi;}
#define SBAR() __builtin_amdgcn_sched_barrier(0)
__device__ __forceinline__ void cmask(f32x16&p0,f32x16&p1,int jb,int qrel,int hi){
  const float NEG=-INFINITY; const int dd=qrel-(64*jb+4*hi);
  #pragma unroll
  for(int r=0;r<16;++r){const int cc=(r&3)+8*(r>>2); if(cc>dd)p0[r]=NEG; if(cc+32>dd)p1[r]=NEG;}
}

constexpr int NSLOT=3, SLOTB=8192;
constexpr int LDS_K=0, LDS_V=NSLOT*SLOTB, LDS_WS=3*NSLOT*SLOTB  , LDS_OST=LDS_WS+NW*64*4, LDS_BYTES=LDS_OST+NW*8192  ;
constexpr float C2=0.125f*1.4426950408889634f;
__device__ __forceinline__ void glds16(const void*gsrc,unsigned lds_dst){unsigned keep;
  asm volatile("s_mov_b32 %0, m0\n\ts_mov_b32 m0, %2\n\ts_nop 0\n\tglobal_load_lds_dwordx4 %1, off\n\ts_mov_b32 m0, %0":"=&s"(keep):"v"(gsrc),"s"(lds_dst):"memory");}
template<int OFF> __device__ __forceinline__ void glds16s(const void*sbase,unsigned voff,unsigned lds_dst){unsigned keep;
  asm volatile("s_nop 4\n\ts_mov_b32 %0, m0\n\ts_mov_b32 m0, %2\n\ts_nop 0\n\tglobal_load_lds_dwordx4 %1, %3 offset:%c4\n\ts_mov_b32 m0, %0":"=&s"(keep):"v"(voff),"s"(lds_dst),"s"(sbase),"i"(OFF):"memory");}
__device__ __forceinline__ const void* uptr(const void*p){ const unsigned long long u=(unsigned long long)p; const unsigned lo=__builtin_amdgcn_readfirstlane((unsigned)u),hi=__builtin_amdgcn_readfirstlane((unsigned)(u>>32)); return (const void*)(((unsigned long long)hi<<32)|lo); }
__device__ __forceinline__ float max3f(float a,float b,float c){float r;asm("v_max3_f32 %0, %1, %2, %3":"=v"(r):"v"(a),"v"(b),"v"(c));return r;}
__device__ __forceinline__ float max2f(float a,float b){float r;asm("v_max_f32_e32 %0, %1, %2":"=v"(r):"v"(a),"v"(b));return r;}
__device__ __forceinline__ float fadd_s(float a,float b){float r;asm("v_add_f32_e32 %0, %1, %2":"=v"(r):"v"(a),"v"(b));return r;}
__device__ __forceinline__ float fsub_s(float a,float b){float r;asm("v_sub_f32_e32 %0, %1, %2":"=v"(r):"v"(a),"v"(b));return r;}
typedef float f32x2_t __attribute__((ext_vector_type(2))); typedef __bf16 bf16x2_t __attribute__((ext_vector_type(2)));
__device__ __forceinline__ unsigned cvtpk_s(float lo,float hi){f32x2_t v={lo,hi};bf16x2_t b=__builtin_convertvector(v,bf16x2_t);return __builtin_bit_cast(unsigned,b);}
#define WAIT_BAR(N) asm volatile("s_waitcnt vmcnt(" #N ") lgkmcnt(0)\n\ts_barrier":::"memory")

__device__ __forceinline__ void qkt(f32x16&p0,f32x16&p1,const char*Kslot,const bf16x8*qr,const f32x16&negm,int r32,int hi){
  const char*kb=Kslot+hi*1024+r32*16;
  #pragma unroll
  for(int d0=0;d0<4;++d0){
    const bf16x8 b0=*reinterpret_cast<const bf16x8*>(kb+d0*2048);
    const bf16x8 b1=*reinterpret_cast<const bf16x8*>(kb+d0*2048+512);
    if(d0==0){p0=__builtin_amdgcn_mfma_f32_32x32x16_bf16(b0,qr[0],negm,0,0,0);p1=__builtin_amdgcn_mfma_f32_32x32x16_bf16(b1,qr[0],negm,0,0,0);}
    else{p0=__builtin_amdgcn_mfma_f32_32x32x16_bf16(b0,qr[d0],p0,0,0,0);p1=__builtin_amdgcn_mfma_f32_32x32x16_bf16(b1,qr[d0],p1,0,0,0);}}
}
typedef __attribute__((address_space(3))) const char* lds_cptr;
typedef short v4i16_t __attribute__((ext_vector_type(4)));
__device__ __forceinline__ void kload8(bf16x8*kf,lds_cptr kp){
  kf[0]=*(const __attribute__((address_space(3))) bf16x8*)(kp);      kf[1]=*(const __attribute__((address_space(3))) bf16x8*)(kp+512);
  kf[2]=*(const __attribute__((address_space(3))) bf16x8*)(kp+2048); kf[3]=*(const __attribute__((address_space(3))) bf16x8*)(kp+2560);
  kf[4]=*(const __attribute__((address_space(3))) bf16x8*)(kp+4096); kf[5]=*(const __attribute__((address_space(3))) bf16x8*)(kp+4608);
  kf[6]=*(const __attribute__((address_space(3))) bf16x8*)(kp+6144); kf[7]=*(const __attribute__((address_space(3))) bf16x8*)(kp+6656);
}
__device__ __forceinline__ void kload2(bf16x8*kf,lds_cptr kp,int j){ kf[2*j]=*(const __attribute__((address_space(3))) bf16x8*)(kp+j*2048); kf[2*j+1]=*(const __attribute__((address_space(3))) bf16x8*)(kp+j*2048+512); }
__device__ __forceinline__ s16x4 vtr(lds_cptr p){ return __builtin_bit_cast(s16x4,__builtin_amdgcn_ds_read_tr16_b64_v4i16((__attribute__((address_space(3))) v4i16_t*)p)); }
__device__ __forceinline__ float rowmax(const f32x16&p0,const f32x16&p1){
  float a=max3f(p0[0],p0[1],p1[0]),b=max3f(p0[2],p0[3],p1[1]);a=max3f(a,p1[2],p1[3]);
  #pragma unroll
  for(int r=4;r<16;r+=4){a=max3f(a,p0[r],p0[r+1]);b=max3f(b,p0[r+2],p0[r+3]);a=max3f(a,p1[r],p1[r+1]);b=max3f(b,p1[r+2],p1[r+3]);}
  const float m=max2f(a,b);
  auto rr=__builtin_amdgcn_permlane32_swap(__float_as_uint(m),__float_as_uint(m),false,false);
  return max2f(__uint_as_float(rr[0]),__uint_as_float(rr[1]));
}
__device__ __forceinline__ void pv(f32x16*o,int vb,bf16x8 pa0,bf16x8 pa1,bf16x8 pa2,bf16x8 pa3){
  #pragma unroll
  for(int d0=0;d0<4;++d0){s16x4 lo[4],hi[4];
    #pragma unroll
    for(int ks=0;ks<4;++ks){
      asm volatile("ds_read_b64_tr_b16 %0,%1 offset:%c2":"=&v"(lo[ks]):"v"(vb),"i"(d0*4096+ks*1024):"memory");
      asm volatile("ds_read_b64_tr_b16 %0,%1 offset:%c2":"=&v"(hi[ks]):"v"(vb),"i"(d0*4096+ks*1024+512):"memory");}
    asm volatile("s_waitcnt lgkmcnt(0)":::"memory");SBAR();
    #define PK(k) (bf16x8){lo[k][0],lo[k][1],lo[k][2],lo[k][3],hi[k][0],hi[k][1],hi[k][2],hi[k][3]}
    o[d0]=__builtin_amdgcn_mfma_f32_32x32x16_bf16(pa0,PK(0),o[d0],0,0,0);
    o[d0]=__builtin_amdgcn_mfma_f32_32x32x16_bf16(pa1,PK(1),o[d0],0,0,0);
    o[d0]=__builtin_amdgcn_mfma_f32_32x32x16_bf16(pa2,PK(2),o[d0],0,0,0);
    o[d0]=__builtin_amdgcn_mfma_f32_32x32x16_bf16(pa3,PK(3),o[d0],0,0,0);
    #undef PK
  }
}

#ifndef ATTN_STORE16
#define ATTN_STORE16(p,v) (*(u32x4*)(p)=(v))
#endif
template<int THRL> __device__ __forceinline__ void attn_unit(int qb,int cmode,float lam,const float*gsub,const bf16*Qh,const bf16*__restrict__ Kh,const bf16*__restrict__ Vh,bf16*Oh,char*shm){
  const int tid=threadIdx.x,lane=tid&63,r32=lane&31,hi=lane>>5; const int wid=__builtin_amdgcn_readfirstlane(tid>>6);
  const int q0=qb*QB;
  const bf16*Qw=Qh+(long)(q0+wid*QBLK)*DM;
  const unsigned lds0=(unsigned)(uintptr_t)shm;
  float*wsf=(float*)(shm+LDS_WS)+wid*64;
  const unsigned kvo=(unsigned)(lane*DM+wid*8)*2u;
  const unsigned vvo=(unsigned)((16*(wid&3)+(lane>>2))*DM+(wid>>2)*32+(lane&3)*8)*2u;
  const unsigned kdst=lds0+LDS_K+wid*1024, vdst=lds0+LDS_V+wid*1024;
  #define DMA_K(t,slot) glds16s<0>(uptr(Kh+(long)(t)*KVBLK*DM),kvo,(unsigned)__builtin_amdgcn_readfirstlane(kdst+(slot)))
  #define DMA_V(t,slot) do{ const void*vb_=uptr(Vh+(long)(t)*KVBLK*DM); glds16s<0>(vb_,vvo,(unsigned)__builtin_amdgcn_readfirstlane(vdst+2*(slot))); glds16s<128>(vb_,vvo,(unsigned)__builtin_amdgcn_readfirstlane(vdst+2*(slot)+8192-128)); }while(0)
  const char*Kbase=shm+LDS_K; bf16x8 kf[8];
  const lds_cptr shm3=(lds_cptr)shm; const lds_cptr kp0=shm3+LDS_K+hi*1024+r32*16; const lds_cptr vp0=shm3+LDS_V+((lane>>4)&1)*32+(lane&3)*8+(4*hi+((lane&15)>>2))*64;
  const int NT=(q0+QB)/KVBLK;
  DMA_K(0,0);DMA_V(0,0);DMA_K(1,SLOTB);
  bf16x8 qr[4];
  #pragma unroll
  for(int d0=0;d0<4;++d0)qr[d0]=*reinterpret_cast<const bf16x8*>(&Qw[(long)r32*DM+d0*16+hi*8]);
  float mhat=0.f,l_reg=0.f;f32x16 o[4];o[0]=f32x16{};o[1]=f32x16{};o[2]=f32x16{};o[3]=f32x16{};f32x16 negm=f32x16{};
  const int qrel=wid*QBLK+r32;
  #define CMASK(P0,P1,t) do{int jb_=(t)-(NT-4); if(jb_>=0){ const int dj_=jb_-(wid>>1); if(dj_>=0)cmask(P0,P1,jb_,qrel,hi); } }while(0)
  bool resc=false;
  #define START(P0,P1) do{ const float rm=rowmax(P0,P1); resc=false; \
    { const float dl=rm; mhat=fadd_s(mhat,dl); \
      _Pragma("unroll") for(int r=0;r<16;++r){P0[r]=fsub_s(P0[r],dl);P1[r]=fsub_s(P1[r],dl);} \
      _Pragma("unroll") for(int r=0;r<16;++r)negm[r]=-mhat; \
      } \
    _Pragma("unroll") for(int r=0;r<16;++r)P0[r]=__builtin_amdgcn_exp2f(P0[r]); }while(0)
  #define RESC() do{ if(resc){ asm volatile("s_waitcnt lgkmcnt(0)":::"memory"); \
      _Pragma("unroll") for(int d_=0;d_<4;++d_) _Pragma("unroll") for(int r=0;r<16;++r)o[d_][r]*=wsf[crow(r,hi)]; } }while(0)
  f32x16 pA0,pA1,pB0,pB1;
  int sl_prev=0,sl_cur=0,sl_next=SLOTB;
  #define ROT() do{sl_prev=sl_cur;sl_cur=sl_next;sl_next=(sl_next==(NSLOT-1)*SLOTB)?0:sl_next+SLOTB;}while(0)
  DMA_K(2,2*SLOTB);
  WAIT_BAR(4);
  qkt(pA0,pA1,Kbase,qr,negm,r32,hi);asm volatile("s_nop 15\n\ts_nop 7":"+v"(pA0),"+v"(pA1));CMASK(pA0,pA1,0);
  START(pA0,pA1);
  _Pragma("unroll") for(int r=0;r<16;++r)pA1[r]=__builtin_amdgcn_exp2f(pA1[r]);
  WAIT_BAR(0);
  DMA_K(3,0);DMA_V(1,SLOTB);
  ROT();
  kload8(kf,kp0+sl_cur);
  WAIT_BAR(3);
  s16x4 vlo[4],vhi[4]; u32x4 pw0,pw1,pw2,pw3;
  #define PKW(P,B) cvtpk_s(P[B],P[B+1])
  #define PAF(k) __builtin_bit_cast(bf16x8,pw##k)
  #define VFR(i) (bf16x8){vlo[i][0],vlo[i][1],vlo[i][2],vlo[i][3],vhi[i][0],vhi[i][1],vhi[i][2],vhi[i][3]}
  #define PIN(x) asm volatile("":"+v"(x))
  #define MX3(a,b,c) __builtin_fmaxf(__builtin_fmaxf((a),(b)),(c))
  #define GAPA(MF,A0,A1,A2,A3,W0,W1,PW) do{ MF; sacc+=A0; sacc+=A1; sacc+=A2; sacc+=A3; PIN(sacc); W0; W1; PIN(PW); SBAR(); }while(0)
  #define EX(v) __builtin_amdgcn_exp2f(v)
  #define GAPB(MF,X,B) do{ MF; X[B]=EX(X[B]); X[B+1]=EX(X[B+1]); PIN(X); SBAR(); }while(0)
  #define VRD(s_,f) do{ vlo[s_]=vtr(vp_+(((f)>>2)*4096+((f)&3)*1024)); vhi[s_]=vtr(vp_+(((f)>>2)*4096+((f)&3)*1024+512)); SBAR(); }while(0)
  #define KRD(G,j) do{ if(G){ kload2(kf,kp0+sl_next,j); SBAR(); } }while(0)
  #define PVM(d0,k,s_) o[d0]=__builtin_amdgcn_mfma_f32_32x32x16_bf16(PAF(k),VFR(s_),o[d0],0,0,0)
  #define STEP(C0,C1,P0,P1,t,GK,GV,GL) do{ SBAR(); \
    const lds_cptr vp_=vp0+2*sl_prev; \
    float sacc=(P0[0]+P0[1]); \
    GAPA(C0=__builtin_amdgcn_mfma_f32_32x32x16_bf16(kf[0],qr[0],negm,0,0,0), P0[2],P0[3],P0[4],P0[5],     pw0[0]=PKW(P0,0), pw0[1]=PKW(P0,2), pw0); \
    GAPA(C1=__builtin_amdgcn_mfma_f32_32x32x16_bf16(kf[1],qr[0],negm,0,0,0), P0[6],P0[7],P0[8],P0[9],     pw0[2]=PKW(P0,4), pw0[3]=PKW(P0,6), pw0); \
    GAPA(C0=__builtin_amdgcn_mfma_f32_32x32x16_bf16(kf[2],qr[1],C0,0,0,0),   P0[10],P0[11],P0[12],P0[13], pw1[0]=PKW(P0,8), pw1[1]=PKW(P0,10), pw1); \
    GAPA(C1=__builtin_amdgcn_mfma_f32_32x32x16_bf16(kf[3],qr[1],C1,0,0,0),   P0[14],P0[15],P1[0],P1[1],   pw1[2]=PKW(P0,12),pw1[3]=PKW(P0,14), pw1); \
    GAPA(C0=__builtin_amdgcn_mfma_f32_32x32x16_bf16(kf[4],qr[2],C0,0,0,0),   P1[2],P1[3],P1[4],P1[5],     pw2[0]=PKW(P1,0), pw2[1]=PKW(P1,2), pw2); \
    GAPA(C1=__builtin_amdgcn_mfma_f32_32x32x16_bf16(kf[5],qr[2],C1,0,0,0),   P1[6],P1[7],P1[8],P1[9],     pw2[2]=PKW(P1,4), pw2[3]=PKW(P1,6), pw2); \
    GAPA(C0=__builtin_amdgcn_mfma_f32_32x32x16_bf16(kf[6],qr[3],C0,0,0,0),   P1[10],P1[11],P1[12],P1[13], pw3[0]=PKW(P1,8), pw3[1]=PKW(P1,10), pw3); \
    GAPA(C1=__builtin_amdgcn_mfma_f32_32x32x16_bf16(kf[7],qr[3],C1,0,0,0),   P1[14],P1[15],0.f,0.f,       pw3[2]=PKW(P1,12),pw3[3]=PKW(P1,14), pw3); \
    l_reg+=sacc; \
    VRD(0,0); VRD(1,4); VRD(2,8); \
    if(GK){DMA_K((t)+3,sl_cur);} if(GV){DMA_V((t)+1,sl_next);} \
    CMASK(C0,C1,t); float a_,b_; \
    PVM(0,0,0); a_=MX3(C0[0],C0[1],C1[0]); b_=MX3(C0[2],C0[3],C1[1]); a_=MX3(a_,C1[2],C1[3]); PIN(a_); PIN(b_); SBAR();   VRD(3,12); \
    PVM(1,0,1); a_=MX3(a_,C0[4],C0[5]); b_=MX3(b_,C0[6],C0[7]); a_=MX3(a_,C1[4],C1[5]); b_=MX3(b_,C1[6],C1[7]); PIN(a_); PIN(b_); SBAR();   VRD(0,1); \
    PVM(2,0,2); a_=MX3(a_,C0[8],C0[9]); b_=MX3(b_,C0[10],C0[11]); a_=MX3(a_,C1[8],C1[9]); b_=MX3(b_,C1[10],C1[11]); PIN(a_); PIN(b_); SBAR();   VRD(1,5); \
    PVM(3,0,3); a_=MX3(a_,C0[12],C0[13]); b_=MX3(b_,C0[14],C0[15]); a_=MX3(a_,C1[12],C1[13]); b_=MX3(b_,C1[14],C1[15]); PIN(a_); PIN(b_); SBAR();   VRD(2,9); \
    { float rm=__builtin_fmaxf(a_,b_); { auto rr=__builtin_amdgcn_permlane32_swap(__float_as_uint(rm),__float_as_uint(rm),false,false); rm=__builtin_fmaxf(__uint_as_float(rr[0]),__uint_as_float(rr[1])); } \
      resc=false; \
      if(__builtin_expect(__any(rm>(float)THRL),0)){ const float dl=__builtin_fmaxf(rm,0.f); mhat+=dl; \
        _Pragma("unroll") for(int r=0;r<16;++r){C0[r]-=dl;C1[r]-=dl;negm[r]-=dl;} \
        const float f=__builtin_amdgcn_exp2f(-dl); l_reg*=f; if(hi==0)wsf[r32]=f; resc=true; } } \
    SBAR(); \
    PVM(0,1,0); C0[0]=EX(C0[0]); C0[1]=EX(C0[1]); C0[2]=EX(C0[2]); PIN(C0); SBAR();   VRD(3,13); \
    KRD(GL,0); PVM(1,1,1); C0[3]=EX(C0[3]); C0[4]=EX(C0[4]); PIN(C0); SBAR();   VRD(0,2); \
    PVM(2,1,2); C0[5]=EX(C0[5]); C0[6]=EX(C0[6]); C0[7]=EX(C0[7]); PIN(C0); SBAR();   VRD(1,6); \
    KRD(GL,1); PVM(3,1,3); C0[8]=EX(C0[8]); C0[9]=EX(C0[9]); PIN(C0); SBAR();   VRD(2,10); \
    PVM(0,2,0); C0[10]=EX(C0[10]); C0[11]=EX(C0[11]); C0[12]=EX(C0[12]); PIN(C0); SBAR();   VRD(3,14); \
    KRD(GL,2); PVM(1,2,1); C0[13]=EX(C0[13]); C0[14]=EX(C0[14]); PIN(C0); SBAR();   VRD(0,3); \
    PVM(2,2,2); C0[15]=EX(C0[15]); C1[0]=EX(C1[0]); C1[1]=EX(C1[1]); PIN(C0); PIN(C1); SBAR();   VRD(1,7); \
    KRD(GL,3); PVM(3,2,3); C1[2]=EX(C1[2]); C1[3]=EX(C1[3]); PIN(C1); SBAR();   VRD(2,11); \
    PVM(0,3,0); C1[4]=EX(C1[4]); C1[5]=EX(C1[5]); C1[6]=EX(C1[6]); PIN(C1); SBAR();   VRD(3,15); \
    PVM(1,3,1); C1[7]=EX(C1[7]); C1[8]=EX(C1[8]); C1[9]=EX(C1[9]); PIN(C1); SBAR(); \
    PVM(2,3,2); C1[10]=EX(C1[10]); C1[11]=EX(C1[11]); C1[12]=EX(C1[12]); PIN(C1); SBAR(); \
    PVM(3,3,3); C1[13]=EX(C1[13]); C1[14]=EX(C1[14]); C1[15]=EX(C1[15]); PIN(C1); SBAR(); \
    }while(0)
  int t=1;
  #undef CMASK
  #define CMASK(P0,P1,t) do{}while(0)
  for(;t+5<NT;t+=2){
    STEP(pB0,pB1,pA0,pA1,t,true,true,true);     WAIT_BAR(3); RESC(); ROT();
    STEP(pA0,pA1,pB0,pB1,t+1,true,true,true);   WAIT_BAR(3); RESC(); ROT();
  }
  #undef CMASK
  #define CMASK(P0,P1,t) do{int jb_=(t)-(NT-4); if(jb_>=0){ const int dj_=jb_-(wid>>1); if(dj_>=0)cmask(P0,P1,jb_,qrel,hi); } }while(0)
  #define ENDW(tt) do{ if((tt)+3<NT){WAIT_BAR(3);} else if((tt)+2<NT){WAIT_BAR(2);} else {WAIT_BAR(0);} }while(0)
  for(;t+1<NT;t+=2){
    STEP(pB0,pB1,pA0,pA1,t,(t+3<NT),(t+1<NT),(t+1<NT));       ENDW(t);   RESC(); ROT();
    STEP(pA0,pA1,pB0,pB1,t+1,(t+4<NT),(t+2<NT),(t+2<NT));     ENDW(t+1); RESC(); ROT();
  }
  STEP(pB0,pB1,pA0,pA1,NT-1,false,false,false); RESC();
  if((wid>>1)==3){ float sacc=pB0[0]+pB0[1]; _Pragma("unroll") for(int r=2;r<16;++r)sacc+=pB0[r]; _Pragma("unroll") for(int r=0;r<16;++r)sacc+=pB1[r]; l_reg+=sacc;
    pw0=(u32x4){PKW(pB0,0),PKW(pB0,2),PKW(pB0,4),PKW(pB0,6)};pw1=(u32x4){PKW(pB0,8),PKW(pB0,10),PKW(pB0,12),PKW(pB0,14)};pw2=(u32x4){PKW(pB1,0),PKW(pB1,2),PKW(pB1,4),PKW(pB1,6)};pw3=(u32x4){PKW(pB1,8),PKW(pB1,10),PKW(pB1,12),PKW(pB1,14)};
    int ln_=lane; asm volatile("":"+v"(ln_)); const int vb0=(int)(lds0+LDS_V)+((ln_>>4)&1)*32+(ln_&3)*8+(4*(ln_>>5)+((ln_&15)>>2))*64;
    SBAR(); pv(o,vb0+2*sl_cur,PAF(0),PAF(1),PAF(2),PAF(3)); }
  #undef PKW
  #undef PAF
  #undef VFR
  #undef PIN
  #undef MX3
  #undef GAPA
  #undef GAPB
  #undef EX
  #undef VRD
  #undef KRD
  #undef PVM
  #undef STEP
  #undef ENDW
  {auto rr=__builtin_amdgcn_permlane32_swap(__float_as_uint(l_reg),__float_as_uint(l_reg),false,false);l_reg=__uint_as_float(rr[0])+__uint_as_float(rr[1]);}
  if(hi==0)wsf[32+r32]=l_reg;asm volatile("s_waitcnt lgkmcnt(0)":::"memory");
  float rli[16];
  #pragma unroll
  for(int r=0;r<16;++r)rli[r]=__builtin_amdgcn_rcpf(wsf[32+crow(r,hi)]);
  bf16*Ow=Oh+(long)(q0+wid*QBLK)*DM;
  { int r32e=r32,hie=hi; asm volatile("":"+v"(r32e),"+v"(hie));
    bf16*stash=(bf16*)(shm+LDS_OST)+wid*4096;
    if(cmode==0){
      #pragma unroll
      for(int r=0;r<16;++r){const int orow=crow(r,hie);
        #pragma unroll
        for(int d0=0;d0<4;++d0)stash[orow*128+d0*32+r32e]=__float2bfloat16(o[d0][r]*rli[r]);}
    } else {
      float ss[16];
      #pragma unroll
      for(int r=0;r<16;++r){const int orow=crow(r,hie); float q=0.f;
        #pragma unroll
        for(int d0=0;d0<4;++d0){const float v=__bfloat162float(stash[orow*128+d0*32+r32e])-lam*(o[d0][r]*rli[r]); o[d0][r]=v; q+=v*v;}
        ss[r]=q;}
      #pragma unroll
      for(int st=0;st<4;++st){const int m=16>>st,n=16>>st; const bool up=(r32e&m)!=0;
        #pragma unroll
        for(int i=0;i<n/2;++i){const float a=ss[i],b2=ss[i+n/2]; const float keep=up?b2:a,send=up?a:b2; ss[i]=keep+__shfl_xor(send,m);} }
      ss[0]+=__shfl_xor(ss[0],1);
      asm volatile("s_waitcnt lgkmcnt(0)":::"memory");
      if((r32e&1)==0)wsf[crow(r32e>>1,hie)]=__builtin_amdgcn_rsqf(ss[0]*(1.0f/128.0f)+1e-6f);
      asm volatile("s_waitcnt lgkmcnt(0)":::"memory");
      float gs[4];
      #pragma unroll
      for(int d0=0;d0<4;++d0)gs[d0]=gsub[d0*32+r32e];
      #pragma unroll
      for(int r=0;r<16;++r){const float rs=wsf[crow(r,hie)];
        #pragma unroll
        for(int d0=0;d0<4;++d0)o[d0][r]*=rs*gs[d0];}
      bf16*stg=stash;
      #pragma unroll
      for(int ps=0;ps<2;++ps){
        #pragma unroll
        for(int r=0;r<16;++r){const int orow=crow(r,hie);
          #pragma unroll
          for(int d0=0;d0<2;++d0)stg[orow*64+d0*32+r32e]=__float2bfloat16(o[2*ps+d0][r]);}
        asm volatile("s_waitcnt lgkmcnt(0)":::"memory");
        int lane_e=lane; asm volatile("":"+v"(lane_e));
        #pragma unroll
        for(int i=0;i<4;++i){const int row=i*8+(lane_e>>3),ch=lane_e&7; const u32x4 v=*(const u32x4*)(stg+row*64+ch*8); ATTN_STORE16(Ow+(long)row*DM+ps*64+ch*8,v);}
        asm volatile("s_waitcnt lgkmcnt(0)":::"memory"); } } }
  asm volatile("s_waitcnt lgkmcnt(0)\n\ts_barrier":::"memory");
  #undef DMA_K
  #undef DMA_V
  #undef CMASK
  #undef START
  #undef RESC
  #undef ROT
}
constexpr int ATTN_LDS_BYTES=LDS_BYTES;
struct DiffTensors { const bf16* Q; const bf16* K; const bf16* V; bf16* OA; const float* gsub; float lam; };
template<int THRL=8> __device__ __forceinline__ void attn_phase(char*lds,const DiffTensors&T,int vcu,int G){
  const int ngrp=G>>4, grp=vcu>>4, j=vcu&15;
  #pragma unroll 1
  for(int p=0;p*ngrp+grp<64&&grp<ngrp;++p){
    const int bh=p*ngrp+grp,b=bh>>3,h=bh&7,qb=(p&1)?NQB-1-j:j; const long rb=(long)b*SEQ*DM;
    #pragma unroll 1
    for(int c=0;c<2;++c){
      const bf16*Qh=T.Q+rb+(2*h+c)*64,*Kh=T.K+rb+(2*h+c)*64,*Vh=T.V+rb+h*128; bf16*Oh=T.OA+rb+h*128;
      attn_unit<THRL>(qb,c,T.lam,T.gsub,Qh,Kh,Vh,Oh,lds); }
  }
}
#undef SBAR
#undef WAIT_BAR
}

constexpr int NWAVES = 8;
constexpr int BATCH = 8, SEQ = 4096, D = 1024, M = BATCH * SEQ;
constexpr int NEXP = 16, DEXP = 512, ECAP = 32768;
constexpr float LN_EPS = 1e-5f, RMS_EPS = 1e-6f;
constexpr float DN_ALPHA = 1.41421356237309515f;
constexpr float LAMBDA_INIT = 0.35550906759096926f;
#ifndef N_LAUNCH_MODE
#define N_LAUNCH_MODE 1
#endif
constexpr int N_PHASES = 16;

constexpr size_t MiB = 1u << 20;
constexpr size_t WS_CTL = 0, CTL_ZERO_BYTES = 1 * MiB;
constexpr size_t WS_TAB = 1 * MiB;
constexpr size_t WS_WIN = 2 * MiB;
constexpr size_t WS_WOUT = 10 * MiB;
constexpr size_t WS_WQKV = 12 * MiB;
constexpr size_t WS_WBO = 18 * MiB;
constexpr size_t WS_WGU = 20 * MiB;
constexpr size_t WS_WD = 84 * MiB;
constexpr size_t WS_BUF = 120 * MiB, BUFSZ = 64 * MiB;
constexpr size_t WS_A = WS_BUF, WS_B = WS_BUF + BUFSZ, WS_C = WS_BUF + 2 * BUFSZ, WS_D = WS_BUF + 3 * BUFSZ, WS_E = WS_BUF + 4 * BUFSZ, WS_F = WS_BUF + 5 * BUFSZ;
constexpr size_t WS_DEST = 504 * MiB, WS_GATE = 506 * MiB;
constexpr size_t WS_END = 508 * MiB;
constexpr int CW_CNT = 1024;
constexpr int CW_BAR = 4096;

constexpr int RING_OFF = 0, RING_BYTES = 143360;
constexpr int LDSCTL_OFF = RING_BYTES, MISC_OFF = LDSCTL_OFF + 320;
constexpr int MOETAB_OFF = LDSCTL_OFF + 1024;
constexpr int LDS_BYTES = 147456;
static_assert(MOETAB_OFF + 256 <= LDS_BYTES && MISC_OFF + 128 <= MOETAB_OFF, "LDS map");

#define GAS __attribute__((address_space(1)))
#define LAS __attribute__((address_space(3)))
typedef unsigned short bf16;
typedef unsigned v4u __attribute__((ext_vector_type(4)));
typedef unsigned v2u __attribute__((ext_vector_type(2)));
typedef float f32x4 __attribute__((ext_vector_type(4)));
typedef float f32x2 __attribute__((ext_vector_type(2)));
typedef short bf16x8 __attribute__((ext_vector_type(8)));
typedef short s16x4 __attribute__((ext_vector_type(4)));
typedef GAS unsigned gu32;
typedef GAS unsigned long long gu64;
#define RLX_AGENT __ATOMIC_RELAXED, __HIP_MEMORY_SCOPE_AGENT
#define LDS_WAIT() asm volatile("s_waitcnt lgkmcnt(0)" ::: "memory")
#define VM_WAIT() asm volatile("s_waitcnt vmcnt(0)" ::: "memory")
__device__ __forceinline__ unsigned f2bf(float f) { unsigned u = __builtin_bit_cast(unsigned, f); return (u + 0x7fffu + ((u >> 16) & 1u)) >> 16; }
__device__ __forceinline__ unsigned pk2(float lo, float hi) { return f2bf(lo) | (f2bf(hi) << 16); }
__device__ __forceinline__ float bflo(unsigned u) { return __uint_as_float(u << 16); }
__device__ __forceinline__ float bfhi(unsigned u) { return __uint_as_float(u & 0xffff0000u); }

#define XB_TMO      128
#define XB_XCNT(j)  (256  + 64 * (j))
#define XB_XSUB(j)  (1280 + 64 * (j))
#define XB_XGEN(j)  (2304 + 64 * (j))
#define XB_TOP      3328
#define XB_TOPGEN   3392
#define XCD_BAR_WORDS 3456
#define XB_SPIN_CAP (1u << 18)

__device__ __forceinline__ unsigned xb_ld(unsigned* p)              { return __hip_atomic_load(p, __ATOMIC_RELAXED, __HIP_MEMORY_SCOPE_AGENT); }
__device__ __forceinline__ unsigned xb_add(unsigned* p, unsigned v) { return __hip_atomic_fetch_add(p, v, __ATOMIC_RELAXED, __HIP_MEMORY_SCOPE_AGENT); }
__device__ __forceinline__ unsigned xb_xcc_id() { return (unsigned)__builtin_amdgcn_s_getreg((3 << 11) | 20) & 0xFu; }
#define XB_SPIN(cond, bar) do { unsigned _sp = 0; while (cond) { __builtin_amdgcn_s_sleep(1); \
    if ((++_sp & 255u) == 0u) { if (xb_ld(&(bar)[XB_TMO])) break; if (_sp > XB_SPIN_CAP) { atomicAdd(&(bar)[XB_TMO], 1u); break; } } } } while (0)

struct XcdBarrier {
    unsigned* bar; unsigned x;
    volatile LAS unsigned* st;
};

__device__ __forceinline__ XcdBarrier xcd_barrier_post(unsigned* bar, volatile LAS unsigned* st) {
    XcdBarrier b; b.bar = bar; b.x = xb_xcc_id(); b.st = st;
    if (threadIdx.x == 0) (void)xb_add(&bar[XB_XCNT(b.x)], 1u);
    return b;
}
__device__ __forceinline__ void xcd_barrier_complete(unsigned* bar, unsigned x, unsigned& nloc, unsigned& nx) {
    const unsigned G = gridDim.x * gridDim.y * gridDim.z;
    unsigned sum, cnt, mine, sp = 0u;
    for (;;) {
        sum = 0u; cnt = 0u; mine = 0u;
#pragma unroll
        for (unsigned j = 0; j < 16; ++j) { const unsigned c = xb_ld(&bar[XB_XCNT(j)]); sum += c; cnt += (c > 0u) ? 1u : 0u; mine = (j == x) ? c : mine; }
        if (sum == G) break;
        __builtin_amdgcn_s_sleep(1);
        if ((++sp & 255u) == 0u) { if (xb_ld(&bar[XB_TMO])) break; if (sp > XB_SPIN_CAP) { atomicAdd(&bar[XB_TMO], 1u); break; } }
    }
    nloc = mine > 0u ? mine : 1u; nx = cnt > 0u ? cnt : 1u;
}

__device__ __forceinline__ void xcd_barrier(const XcdBarrier& b) {
    asm volatile("s_waitcnt vmcnt(0)" ::: "memory");
    __syncthreads();
    if (threadIdx.x == 0) {
        unsigned* bar = b.bar;
        __builtin_amdgcn_s_waitcnt(0);
        unsigned nloc = b.st[0], nx = b.st[1];
        if (nloc == 0u) { xcd_barrier_complete(bar, b.x, nloc, nx); b.st[0] = nloc; b.st[1] = nx; }
        const unsigned old = xb_add(&bar[XB_XSUB(b.x)], 1u);
        const unsigned gen = old / nloc;
        if (old + 1u == (gen + 1u) * nloc) {
            __builtin_amdgcn_fence(__ATOMIC_RELEASE, "agent");
            asm volatile("s_waitcnt vmcnt(0)" ::: "memory");
            const unsigned og = xb_add(&bar[XB_TOP], 1u);
            const unsigned tg = og / nx;
            if (og + 1u == (tg + 1u) * nx) xb_add(&bar[XB_TOPGEN], 1u);
            else XB_SPIN(xb_ld(&bar[XB_TOPGEN]) == tg, bar);
            __builtin_amdgcn_fence(__ATOMIC_ACQUIRE, "agent");
            xb_add(&bar[XB_XGEN(b.x)], 1u);
            asm volatile("s_waitcnt vmcnt(0)" ::: "memory");
        } else {
            XB_SPIN(xb_ld(&bar[XB_XGEN(b.x)]) == gen, bar);
            __builtin_amdgcn_fence(__ATOMIC_ACQUIRE, "agent");
            asm volatile("s_waitcnt vmcnt(0)" ::: "memory");
        }
    }
    __syncthreads();
}

struct Frame {
    LAS unsigned char* lds;
    gu32* ctl;
    int tid, lane, wave;
    int vcu, G;
};
__device__ __forceinline__ float wave_sum(float v) {
#pragma unroll
    for (int o = 1; o < 64; o <<= 1) v += __shfl_xor(v, o);
    return v;
}
__device__ __forceinline__ void transpose_item(const float* W, int ldw, int k0, int n0, bf16* WT, int ldk, int dst_row0, float scale, LAS float* scr, int lane) {
#pragma unroll
    for (int i = 0; i < 32; ++i) { const int kk = 2 * i + (lane >> 5); scr[kk * 33 + (lane & 31)] = __builtin_nontemporal_load(W + (size_t)(k0 + kk) * ldw + n0 + (lane & 31)); }
    LDS_WAIT(); asm volatile("" ::: "memory");
    const int c = lane & 7;
#pragma unroll
    for (int j = 0; j < 4; ++j) { const int n = (lane >> 3) + 8 * j; const LAS float* s = scr + (8 * c) * 33 + n;
        v4u o; o.x = pk2(s[0 * 33] * scale, s[1 * 33] * scale); o.y = pk2(s[2 * 33] * scale, s[3 * 33] * scale); o.z = pk2(s[4 * 33] * scale, s[5 * 33] * scale); o.w = pk2(s[6 * 33] * scale, s[7 * 33] * scale);
        *(GAS v4u*)(WT + (size_t)(dst_row0 + n) * ldk + k0 + 8 * c) = o; }
    LDS_WAIT(); asm volatile("" ::: "memory");
}
__device__ __forceinline__ void transpose_item8(const float* W, int ldw, int k0, int n0, unsigned char* WT8, int ldk, int dst_row0, float scale, LAS float* scr, int lane) {
#pragma unroll
    for (int i = 0; i < 32; ++i) { const int kk = 2 * i + (lane >> 5); scr[kk * 33 + (lane & 31)] = __builtin_nontemporal_load(W + (size_t)(k0 + kk) * ldw + n0 + (lane & 31)); }
    LDS_WAIT(); asm volatile("" ::: "memory");
    const int c = lane & 7;
#pragma unroll
    for (int j = 0; j < 4; ++j) { const int n = (lane >> 3) + 8 * j; const LAS float* sp = scr + (8 * c) * 33 + n;
        int w0 = 0, w1 = 0;
        w0 = __builtin_amdgcn_cvt_pk_fp8_f32(sp[0 * 33] * scale, sp[1 * 33] * scale, w0, false); w0 = __builtin_amdgcn_cvt_pk_fp8_f32(sp[2 * 33] * scale, sp[3 * 33] * scale, w0, true);
        w1 = __builtin_amdgcn_cvt_pk_fp8_f32(sp[4 * 33] * scale, sp[5 * 33] * scale, w1, false); w1 = __builtin_amdgcn_cvt_pk_fp8_f32(sp[6 * 33] * scale, sp[7 * 33] * scale, w1, true);
        *(GAS v2u*)(WT8 + (size_t)(dst_row0 + n) * ldk + k0 + 8 * c) = (v2u){(unsigned)w0, (unsigned)w1}; }
    LDS_WAIT(); asm volatile("" ::: "memory");
}
__device__ __forceinline__ void transpose_plain(const float* W, int K, int N, bf16* WT, int row_off, float scale, LAS float* scr, int item, int lane) {
    const int nblk = N / 32, kb = item / nblk, nb = item % nblk;
    transpose_item(W, N, 64 * kb, 32 * nb, WT, K, row_off + 32 * nb, scale, scr, lane);
}

__device__ __forceinline__ void transpose_plain8(const float* W, int K, int N, unsigned char* WT8, int row_off, float scale, LAS float* scr, int item, int lane) {
    const int nblk = N / 32, kb = item / nblk, nb = item % nblk;
    transpose_item8(W, N, 64 * kb, 32 * nb, WT8, K, row_off + 32 * nb, scale, scr, lane);
}
constexpr float W8_SCALE = 64.0f;
#ifndef MIX_SPLIT
#define MIX_SPLIT 0
#endif
#ifndef ALIGN_P3
#define ALIGN_P3 true
#endif
#ifndef R_BF16
#define R_BF16 1
#endif
#ifndef FP8_PROJ
#define FP8_PROJ 13
#endif
__host__ __device__ constexpr int proj_rank(int grp, bool f8) { int r = 0; for (int g2 = 0; g2 < grp; ++g2) if ((((FP8_PROJ) >> g2) & 1) == (f8 ? 1 : 0)) ++r; return r; }
__host__ __device__ constexpr int proj_count(bool f8) { return proj_rank(4, f8); }
__host__ __device__ constexpr int proj_gmap(bool f8) { int m = 0, r = 0; for (int g2 = 0; g2 < 4; ++g2) if ((((FP8_PROJ) >> g2) & 1) == (f8 ? 1 : 0)) { m |= g2 << (4 * r); ++r; } return m; }
constexpr size_t WS_WIN8 = WS_WIN + (size_t)proj_count(false) * 2 * MiB;
#ifndef FP8_QKV
#define FP8_QKV 1
#endif
struct Inputs { const float *x, *a_w_in, *a_lb, *a_norm_g, *a_w_out, *kv_w, *b_w_q, *b_lam, *b_subln_g, *b_w_out, *ln1_g, *ln1_b, *ln2_g, *ln2_b, *router_w, *router_b, *moe_w_gate, *moe_w_up, *moe_w_down; };

constexpr int DN_IN = 16 * 128, DN_SQ = 16 * 32, DN_KV = 16 * 64, DN_ALL = DN_IN + DN_SQ + DN_KV + DN_SQ + DN_SQ;
__device__ __forceinline__ void dense_weight_convert(Frame& F, const Inputs& in, unsigned char* ws, int it_lo, int it_hi, int w0, int nw) {
    LAS float* scr = (LAS float*)(F.lds + RING_OFF + F.wave * 16384);
    constexpr int I_IN = DN_IN, I_SQ = DN_SQ, I_KV = DN_KV;
    for (int it = it_lo + w0; it < it_hi; it += nw) {
        int r = it;
        if (r < I_IN) { const int nb_ = r % 128, kb_ = r / 128, grp_ = nb_ >> 5;
            if ((FP8_PROJ >> grp_) & 1) transpose_item8(in.a_w_in, 4 * D, 64 * kb_, 32 * nb_, ws + WS_WIN8, D, proj_rank(grp_, true) * 1024 + 32 * (nb_ & 31), W8_SCALE, scr, F.lane);
            else transpose_item(in.a_w_in, 4 * D, 64 * kb_, 32 * nb_, (bf16*)(ws + WS_WIN), D, proj_rank(grp_, false) * 1024 + 32 * (nb_ & 31), 1.f, scr, F.lane);
            continue; } r -= I_IN;
        if (r < I_SQ) { transpose_plain(in.a_w_out, D, D, (bf16*)(ws + WS_WOUT), 0, 1.f, scr, r, F.lane); continue; } r -= I_SQ;
        if (r < I_KV) { if (FP8_QKV) transpose_plain8(in.kv_w, D, 2 * D, ws + WS_WQKV, D, W8_SCALE, scr, r, F.lane); else transpose_plain(in.kv_w, D, 2 * D, (bf16*)(ws + WS_WQKV), D, 1.f, scr, r, F.lane); continue; } r -= I_KV;
        if (r < I_SQ) { if (FP8_QKV) transpose_plain8(in.b_w_q, D, D, ws + WS_WQKV, 0, attn_body::C2 * W8_SCALE, scr, r, F.lane); else transpose_plain(in.b_w_q, D, D, (bf16*)(ws + WS_WQKV), 0, attn_body::C2, scr, r, F.lane); continue; } r -= I_SQ;
        transpose_plain(in.b_w_out, D, D, (bf16*)(ws + WS_WBO), 0, 1.f, scr, r, F.lane);
    }
}
#ifndef SHADOW_CONV
#define SHADOW_CONV 1
#endif
#ifndef SHADOW_DENSE
#define SHADOW_DENSE 1
#endif
__device__ __forceinline__ void p0_prologue(Frame& F, const Inputs& in, unsigned char* ws) {
    const int gw = F.vcu * NWAVES + F.wave, NGW = F.G * NWAVES;
    dense_weight_convert(F, in, ws, 0, (SHADOW_DENSE && SHADOW_CONV && N_LAUNCH_MODE == 1) ? DN_IN : DN_ALL, gw, NGW);
    bf16* XB = (bf16*)(ws + WS_A);
    for (int m0 = gw; m0 < M; m0 += 4 * NGW) {
        f32x4 xv[4][4];
#pragma unroll
        for (int q = 0; q < 4; ++q) { const int m = m0 + q * NGW; if (m < M) { const GAS f32x4* xr = (const GAS f32x4*)(in.x + (size_t)m * D) + F.lane;
#pragma unroll
            for (int j = 0; j < 4; ++j) xv[q][j] = __builtin_nontemporal_load(xr + 64 * j); } }
        asm volatile("" ::: "memory");
#pragma unroll
        for (int q = 0; q < 4; ++q) { const int m = m0 + q * NGW; if (m < M) { GAS v2u* o8 = (GAS v2u*)(XB + (size_t)m * D) + F.lane;
#pragma unroll
            for (int j = 0; j < 4; ++j) { const f32x4 v = xv[q][j]; v2u o; o.x = pk2(v.x, v.y); o.y = pk2(v.z, v.w); o8[64 * j] = o;
                if (FP8_PROJ) { int w8 = 0; w8 = __builtin_amdgcn_cvt_pk_fp8_f32(v.x, v.y, w8, false); w8 = __builtin_amdgcn_cvt_pk_fp8_f32(v.z, v.w, w8, true); *(GAS unsigned*)(ws + WS_F + (size_t)m * D + 4 * F.lane + 256 * j) = (unsigned)w8; } } } }
    }
    if (blockIdx.x == 0) {
        float* tab = (float*)(ws + WS_TAB);
        for (int d = F.tid; d < D; d += NWAVES * 64) { const float a0 = in.a_lb[d], a1 = in.a_lb[D + d]; tab[d] = 1.0f / (1.0f + __expf(a1 - a0)); }
        if (F.wave == 0) { const float p = wave_sum(in.b_lam[F.lane] * in.b_lam[64 + F.lane]), q = wave_sum(in.b_lam[128 + F.lane] * in.b_lam[192 + F.lane]);
            if (F.lane == 0) tab[1024] = __expf(p) - __expf(q) + LAMBDA_INIT; }
    }
}
#ifndef FP8_L0
#define FP8_L0 1
#endif
#ifndef FP8_L1
#define FP8_L1 1
#endif
constexpr int MOE_PER = 768, MOE_NIT = 2 * NEXP * MOE_PER;
__device__ __forceinline__ void moe_weight_convert(Frame& F, const Inputs& in, unsigned char* ws, int it_lo, int it_hi, int w0, int nw) {
    LAS float* scr = (LAS float*)(F.lds + RING_OFF + F.wave * 16384);
    constexpr int PER = MOE_PER;
    for (int it = it_lo + w0; it < it_hi; it += nw) {
        const int le = it / PER, r = it % PER, kind = r >> 8, q = r & 255, l = le >> 4, e = le & 15;
        const bool f8 = l ? (FP8_L1 != 0) : (FP8_L0 != 0);
        unsigned char* gu = ws + WS_WGU + (size_t)l * (32 * MiB) + (size_t)e * D * D * (f8 ? 1 : 2);
        unsigned char* dn = ws + WS_WD + (size_t)l * (16 * MiB) + (size_t)e * D * DEXP * (f8 ? 1 : 2);
        if (kind < 2) { const int kb = q >> 4, nb = q & 15, n0 = 32 * nb; const float* W = (kind == 0 ? in.moe_w_gate : in.moe_w_up) + (size_t)le * D * DEXP;
            const int drow = (n0 >> 7) * 256 + kind * 128 + (n0 & 127);
            if (f8) transpose_item8(W, DEXP, 64 * kb, n0, gu, D, drow, W8_SCALE, scr, F.lane); else transpose_item(W, DEXP, 64 * kb, n0, (bf16*)gu, D, drow, 1.f, scr, F.lane); }
        else { const int kb = q >> 5, nb = q & 31; const float* W = in.moe_w_down + (size_t)le * DEXP * D;
            if (f8) transpose_item8(W, D, 64 * kb, 32 * nb, dn, DEXP, 32 * nb, W8_SCALE, scr, F.lane); else transpose_item(W, D, 64 * kb, 32 * nb, (bf16*)dn, DEXP, 32 * nb, 1.f, scr, F.lane); }
    }
}

#ifndef SHADOW_CONV
#define SHADOW_CONV 1
#endif
template <class W> __device__ __forceinline__ void xcd_barrier_w(const XcdBarrier& b, const W& work) {
    asm volatile("s_waitcnt vmcnt(0)" ::: "memory");
    __syncthreads();
    if (__builtin_amdgcn_readfirstlane((int)threadIdx.x >> 6) != 0) work();
    if (threadIdx.x == 0) {
        unsigned* bar = b.bar;
        __builtin_amdgcn_s_waitcnt(0);
        unsigned nloc = b.st[0], nx = b.st[1];
        if (nloc == 0u) { xcd_barrier_complete(bar, b.x, nloc, nx); b.st[0] = nloc; b.st[1] = nx; }
        const unsigned old = xb_add(&bar[XB_XSUB(b.x)], 1u);
        const unsigned gen = old / nloc;
        if (old + 1u == (gen + 1u) * nloc) {
            __builtin_amdgcn_fence(__ATOMIC_RELEASE, "agent");
            asm volatile("s_waitcnt vmcnt(0)" ::: "memory");
            const unsigned og = xb_add(&bar[XB_TOP], 1u);
            const unsigned tg = og / nx;
            if (og + 1u == (tg + 1u) * nx) xb_add(&bar[XB_TOPGEN], 1u);
            else XB_SPIN(xb_ld(&bar[XB_TOPGEN]) == tg, bar);
            __builtin_amdgcn_fence(__ATOMIC_ACQUIRE, "agent");
            xb_add(&bar[XB_XGEN(b.x)], 1u);
            asm volatile("s_waitcnt vmcnt(0)" ::: "memory");
        } else {
            XB_SPIN(xb_ld(&bar[XB_XGEN(b.x)]) == gen, bar);
            __builtin_amdgcn_fence(__ATOMIC_ACQUIRE, "agent");
            asm volatile("s_waitcnt vmcnt(0)" ::: "memory");
        }
    }
    asm volatile("s_waitcnt lgkmcnt(0)\n\ts_barrier" ::: "memory");
}
#ifndef SH_DOUBLE
#define SH_DOUBLE 2
#endif
constexpr int SH_PER = 7 * 256, SH_P0 = (MOE_NIT / 2 - (5 + SH_DOUBLE) * SH_PER) > 0 ? (MOE_NIT / 2 - (5 + SH_DOUBLE) * SH_PER) : 0;
static_assert(SH_P0 >= 0 && 7 * SH_PER >= MOE_NIT / 2, "shadow conversion schedule");
__device__ __forceinline__ void shadow_convert(Frame& F, const Inputs& in, unsigned char* ws, int j) {
    int lo, hi;
    if (j < 5) { lo = SH_P0 + (j + (j < SH_DOUBLE ? j : SH_DOUBLE)) * SH_PER; hi = lo + (j < SH_DOUBLE ? 2 : 1) * SH_PER; if (hi > MOE_NIT / 2) hi = MOE_NIT / 2; if (lo > hi) lo = hi; }
    else if (j < 12) { lo = MOE_NIT / 2 + (j - 5) * SH_PER; hi = lo + SH_PER < MOE_NIT ? lo + SH_PER : MOE_NIT; }
    else { lo = 0; hi = 0; }
    moe_weight_convert(F, in, ws, lo, hi, F.vcu * 7 + (F.wave - 1), F.G * 7);
    if (SHADOW_DENSE) {
        if (j == 2) dense_weight_convert(F, in, ws, DN_IN, DN_IN + DN_SQ, F.vcu * 7 + (F.wave - 1), F.G * 7);
        else if (j == 3) dense_weight_convert(F, in, ws, DN_IN + DN_SQ, DN_IN + DN_SQ + DN_KV + DN_SQ, F.vcu * 7 + (F.wave - 1), F.G * 7);
        else if (j == 4) dense_weight_convert(F, in, ws, DN_IN + DN_SQ + DN_KV + DN_SQ, DN_ALL, F.vcu * 7 + (F.wave - 1), F.G * 7);
    }
}

constexpr int SC_TOT = 0, SC_DEC = 4096, SC_SS = SC_DEC + 512, SC_QT = SC_SS + 2048, SC_KT = SC_QT + 17408, SC_QH = SC_KT + 17408,
              SC_KHT = SC_QH + 17408, SC_VT = SC_KHT + 18432, SC_P = SC_VT + 18432, SC_END = SC_P + 9216, SC_OUT = SC_QT;
static_assert(SC_END <= RING_BYTES && 64 * 528 <= 2 * 17408, "scan LDS map");
__device__ __forceinline__ float h2f(unsigned short h) { return (float)__builtin_bit_cast(__fp16, h); }
__device__ __forceinline__ unsigned cvtpk(float lo, float hi) { typedef float f2_t __attribute__((ext_vector_type(2))); typedef __bf16 b2_t __attribute__((ext_vector_type(2)));
    f2_t v = {lo, hi}; b2_t b = __builtin_convertvector(v, b2_t); return __builtin_bit_cast(unsigned, b); }
__device__ __forceinline__ float row16_sum(float v) {
    v += __builtin_bit_cast(float, __builtin_amdgcn_update_dpp(0, __builtin_bit_cast(int, v), 0xB1, 0xF, 0xF, true));
    v += __builtin_bit_cast(float, __builtin_amdgcn_update_dpp(0, __builtin_bit_cast(int, v), 0x4E, 0xF, 0xF, true));
    v += __builtin_bit_cast(float, __builtin_amdgcn_update_dpp(0, __builtin_bit_cast(int, v), 0x141, 0xF, 0xF, true));
    v += __builtin_bit_cast(float, __builtin_amdgcn_update_dpp(0, __builtin_bit_cast(int, v), 0x140, 0xF, 0xF, true));
    return v;
}
__device__ __forceinline__ void store16_sc1(void* p, v4u v) { *(GAS v4u*)p = v; }
#ifndef Y2L0_FP8
#define Y2L0_FP8 1
#endif
#ifndef Y2L1_FP8
#define Y2L1_FP8 1
#endif
#ifndef OI_FP8
#define OI_FP8 0
#endif
#ifndef QH_FP8
#define QH_FP8 1
#endif
#ifndef US_FP8
#define US_FP8 1
#endif
constexpr int US_CH = US_FP8 ? 16384 : 32768, US_W = US_CH / 8, US_KS = US_W / 4, US_LN = US_KS / 64;
__device__ __forceinline__ unsigned pk4_fp8(float a, float b, float c, float d) { int w = 0; w = __builtin_amdgcn_cvt_pk_fp8_f32(a, b, w, false); w = __builtin_amdgcn_cvt_pk_fp8_f32(c, d, w, true); return (unsigned)w; }
__device__ __forceinline__ void un4_fp8(unsigned w, float (&o)[4]) { const f32x2 lo = __builtin_amdgcn_cvt_pk_f32_fp8((int)w, false), hi = __builtin_amdgcn_cvt_pk_f32_fp8((int)w, true); o[0] = lo.x; o[1] = lo.y; o[2] = hi.x; o[3] = hi.y; }
__device__ __forceinline__ size_t tile_off(int b, int h, int c, int x) { return ((size_t)b * SEQ + c * 64 + (x >> 8)) * (D * 2) + (size_t)h * 256 + (x & 255); }

#define LDS_BAR() asm volatile("s_waitcnt lgkmcnt(0)\n\ts_barrier" ::: "memory")
__device__ __forceinline__ void scan2a_range(Frame& F, int u_lo, int u_hi, const bf16* Q0, const bf16* LF, const bf16* V0, unsigned char* UD, unsigned char* QHF, unsigned char* OI, float* DECG) {
    LAS unsigned char* L = F.lds + RING_OFF;
    LAS float* TOT = (LAS float*)(L + SC_TOT); LAS float* DEC = (LAS float*)(L + SC_DEC);
    const int lane = F.lane, w = F.wave, row16 = lane & 15, quad = lane >> 4;
    if (u_lo >= u_hi) return;
    unsigned pq[8], pl[8], pv[8];
    f32x4 sloc[4][2]; float cum0 = 1.f, cum1 = 1.f;
#pragma unroll
    for (int kp = 0; kp < 4; ++kp) { sloc[kp][0] = (f32x4){0.f, 0.f, 0.f, 0.f}; sloc[kp][1] = (f32x4){0.f, 0.f, 0.f, 0.f}; }
#define SC2A_LOAD(u_) do { const int b_ = (u_) >> 9, h_ = ((u_) >> 6) & 7, c_ = (u_) & 63; const size_t o = ((size_t)b_ * SEQ + c_ * 64 + 8 * w) * D + (size_t)h_ * 128 + 2 * lane; \
        _Pragma("unroll") for (int j = 0; j < 8; ++j) { pq[j] = *(const GAS unsigned*)(Q0 + o + (size_t)j * D); pl[j] = *(const GAS unsigned*)(LF + o + (size_t)j * D); pv[j] = *(const GAS unsigned*)(V0 + o + (size_t)j * D); } } while (0)
    SC2A_LOAD(u_lo);
    for (int u = u_lo; u < u_hi; ++u) {
    const int b = u >> 9, h = (u >> 6) & 7, c = u & 63, ch = u;
    unsigned cq[8], cl[8], cv[8];
#pragma unroll
    for (int j = 0; j < 8; ++j) { cq[j] = pq[j]; cl[j] = pl[j]; cv[j] = pv[j]; }
    if (u + 1 < u_hi) SC2A_LOAD(u + 1);
    float lf0[8], lf1[8], pre0[8], pre1[8], kk0[8], kk1[8];
#pragma unroll
    for (int j = 0; j < 8; ++j) { const float f0 = h2f((unsigned short)(cl[j] & 0xffffu)), f1 = h2f((unsigned short)(cl[j] >> 16));
        kk0[j] = 1.0f - f0; kk1[j] = 1.0f - f1; lf0[j] = __logf(f0); lf1[j] = __logf(f1); pre0[j] = lf0[j] + (j ? pre0[j - 1] : 0.f); pre1[j] = lf1[j] + (j ? pre1[j - 1] : 0.f); }
    *(LAS f32x2*)(TOT + w * 128 + 2 * lane) = (f32x2){pre0[7], pre1[7]};
    LDS_BAR();
    { float off0 = 0.f, off1 = 0.f, bref0 = 0.f, bref1 = 0.f, bl0 = 0.f, bl1 = 0.f;
#pragma unroll
      for (int ww = 0; ww < 8; ++ww) { const f32x2 t = *(const LAS f32x2*)(TOT + ww * 128 + 2 * lane);
          if (ww < w) { off0 += t.x; off1 += t.y; } if (ww < 4) { bref0 += t.x; bref1 += t.y; } bl0 += t.x; bl1 += t.y; }
      const float E10 = __expf(bref0), E11 = __expf(bref1), E20 = __expf(bl0 - bref0), E21 = __expf(bl1 - bref1);
      unsigned kh0[4], kh1[4], vt0[4], vt1[4]; float pk0 = 0.f, pk1 = 0.f;
#pragma unroll
      for (int j = 0; j < 8; ++j) { const int r = 8 * w + j;
          const float q0 = bflo(cq[j]), q1 = bfhi(cq[j]);
          const float e0 = __expf(pre0[j] + off0 - bref0), e1 = __expf(pre1[j] + off1 - bref1);
          const float k0 = kk0[j], k1 = kk1[j];
          const float qt0 = q0 * e0, qt1 = q1 * e1, kt0 = k0 * __builtin_amdgcn_rcpf(e0), kt1 = k1 * __builtin_amdgcn_rcpf(e1);
          *(LAS unsigned*)(L + SC_QT + r * 272 + 4 * lane) = cvtpk(qt0, qt1);
          *(LAS unsigned*)(L + SC_KT + r * 272 + 4 * lane) = cvtpk(kt0, kt1);
          *(LAS unsigned*)(L + SC_QH + r * 272 + 4 * lane) = cvtpk(qt0 * E10, qt1 * E11);
          const float kh0f = kt0 * E20, kh1f = kt1 * E21;
          if (j & 1) { kh0[j >> 1] = cvtpk(pk0, kh0f); kh1[j >> 1] = cvtpk(pk1, kh1f); vt0[j >> 1] = (cv[j - 1] & 0xffffu) | (cv[j] << 16); vt1[j >> 1] = (cv[j - 1] >> 16) | (cv[j] & 0xffff0000u); }
          else { pk0 = kh0f; pk1 = kh1f; } }
      *(LAS v4u*)(L + SC_KHT + (2 * lane) * 144 + 16 * w) = (v4u){kh0[0], kh0[1], kh0[2], kh0[3]};
      *(LAS v4u*)(L + SC_KHT + (2 * lane + 1) * 144 + 16 * w) = (v4u){kh1[0], kh1[1], kh1[2], kh1[3]};
      *(LAS v4u*)(L + SC_VT + (2 * lane) * 144 + 16 * w) = (v4u){vt0[0], vt0[1], vt0[2], vt0[3]};
      *(LAS v4u*)(L + SC_VT + (2 * lane + 1) * 144 + 16 * w) = (v4u){vt1[0], vt1[1], vt1[2], vt1[3]};
      if (w == 0) { const float d0_ = __expf(bl0), d1_ = __expf(bl1); cum0 *= d0_; cum1 *= d1_;
          *(LAS f32x2*)(DEC + 2 * lane) = (f32x2){d0_, d1_};
          *(GAS f32x2*)(DECG + (size_t)ch * 128 + 2 * lane) = (f32x2){cum0, cum1}; } }
    LDS_BAR();
    { const int ti = w >> 1;
#pragma unroll
      for (int jj = 0; jj < 2; ++jj) { const int tj = 2 * (w & 1) + jj; f32x4 a = (f32x4){0.f, 0.f, 0.f, 0.f};
          if (tj <= ti) {
#pragma unroll
              for (int ks = 0; ks < 4; ++ks) { const bf16x8 af = *(const LAS bf16x8*)(L + SC_QT + (16 * ti + row16) * 272 + (32 * ks + 8 * quad) * 2);
                  const bf16x8 bfr = *(const LAS bf16x8*)(L + SC_KT + (16 * tj + row16) * 272 + (32 * ks + 8 * quad) * 2);
                  a = __builtin_amdgcn_mfma_f32_16x16x32_bf16(af, bfr, a, 0, 0, 0); } }
          unsigned short pv4[4];
#pragma unroll
          for (int j = 0; j < 4; ++j) { const int t = 16 * ti + 4 * quad + j, s2 = 16 * tj + row16; pv4[j] = (unsigned short)f2bf((s2 <= t) ? a[j] : 0.f); }
#pragma unroll
          for (int j = 0; j < 4; ++j) *(LAS unsigned short*)(L + SC_P + (16 * ti + 4 * quad + j) * 144 + (16 * tj + row16) * 2) = pv4[j]; } }
#pragma unroll
    for (int ff = 0; ff < 2; ++ff) { const int f = 2 * w + ff, mi = f >> 2, ks = f & 3;
        const v2u a0 = *(const LAS v2u*)(L + SC_QH + (16 * mi + row16) * 272 + (32 * ks + 4 * quad) * 2), a1 = *(const LAS v2u*)(L + SC_QH + (16 * mi + row16) * 272 + (32 * ks + 16 + 4 * quad) * 2);
        if (QH_FP8) *(GAS v2u*)(QHF + (size_t)ch * 8192 + f * 512 + lane * 8) = (v2u){pk4_fp8(bflo(a0.x), bfhi(a0.x), bflo(a0.y), bfhi(a0.y)), pk4_fp8(bflo(a1.x), bfhi(a1.x), bflo(a1.y), bfhi(a1.y))};
        else *(GAS v4u*)(QHF + (size_t)ch * 16384 + f * 1024 + lane * 16) = (v4u){a0.x, a0.y, a1.x, a1.y}; }
    bf16x8 vfr[2];
#pragma unroll
    for (int ks = 0; ks < 2; ++ks) vfr[ks] = *(const LAS bf16x8*)(L + SC_VT + (16 * w + row16) * 144 + (32 * ks + 8 * quad) * 2);
#pragma unroll
    for (int kp = 0; kp < 4; ++kp) { f32x4 u2[2];
#pragma unroll
        for (int hh = 0; hh < 2; ++hh) { const int i2 = 2 * kp + hh; f32x4 s = (f32x4){0.f, 0.f, 0.f, 0.f};
#pragma unroll
            for (int ks = 0; ks < 2; ++ks) { const bf16x8 af = *(const LAS bf16x8*)(L + SC_KHT + (16 * i2 + row16) * 144 + (32 * ks + 8 * quad) * 2);
                s = __builtin_amdgcn_mfma_f32_16x16x32_bf16(af, vfr[ks], s, 0, 0, 0); }
            const f32x4 dv_ = *(const LAS f32x4*)(DEC + 32 * kp + 16 * hh + 4 * quad);
            sloc[kp][hh] = dv_ * sloc[kp][hh] + s; u2[hh] = sloc[kp][hh]; }
        if (US_FP8) *(GAS v2u*)(UD + (size_t)ch * US_CH + w * US_W + kp * US_KS + lane * US_LN) = (v2u){pk4_fp8(u2[0][0], u2[0][1], u2[0][2], u2[0][3]), pk4_fp8(u2[1][0], u2[1][1], u2[1][2], u2[1][3])};
        else store16_sc1(UD + (size_t)ch * 32768 + w * 4096 + kp * 1024 + lane * 16, (v4u){cvtpk(u2[0][0], u2[0][1]), cvtpk(u2[0][2], u2[0][3]), cvtpk(u2[1][0], u2[1][1]), cvtpk(u2[1][2], u2[1][3])}); }
    LDS_BAR();
    { f32x4 oacc[4];
#pragma unroll
      for (int mi = 0; mi < 4; ++mi) { oacc[mi] = (f32x4){0.f, 0.f, 0.f, 0.f};
#pragma unroll
          for (int ks = 0; ks < 2; ++ks) { const bf16x8 af = *(const LAS bf16x8*)(L + SC_P + (16 * mi + row16) * 144 + (32 * ks + 8 * quad) * 2);
              oacc[mi] = __builtin_amdgcn_mfma_f32_16x16x32_bf16(af, vfr[ks], oacc[mi], 0, 0, 0); } }
#pragma unroll
      for (int hh = 0; hh < 2; ++hh) { if (OI_FP8) { if (hh == 0) *(GAS v4u*)(OI + tile_off(b, h, c, w * 1024 + lane * 16)) = (v4u){pk4_fp8(oacc[0][0], oacc[0][1], oacc[0][2], oacc[0][3]), pk4_fp8(oacc[1][0], oacc[1][1], oacc[1][2], oacc[1][3]), pk4_fp8(oacc[2][0], oacc[2][1], oacc[2][2], oacc[2][3]), pk4_fp8(oacc[3][0], oacc[3][1], oacc[3][2], oacc[3][3])}; }
          else *(GAS v4u*)(OI + tile_off(b, h, c, w * 2048 + hh * 1024 + lane * 16)) =
          (v4u){cvtpk(oacc[2 * hh][0], oacc[2 * hh][1]), cvtpk(oacc[2 * hh][2], oacc[2 * hh][3]), cvtpk(oacc[2 * hh + 1][0], oacc[2 * hh + 1][1]), cvtpk(oacc[2 * hh + 1][2], oacc[2 * hh + 1][3])}; } }
    }
#undef SC2A_LOAD
}
__device__ __forceinline__ void scan2c_range(Frame& F, int u_lo, int u_hi, const unsigned char* UD, const unsigned char* QHF, const bf16* G0, const float* norm_g, bf16* O0, const float* DECG) {
    if (u_lo >= u_hi) return;
    LAS unsigned char* L = F.lds + RING_OFF;
    LAS float* SS = (LAS float*)(L + SC_SS);
    const int lane = F.lane, w = F.wave, row16 = lane & 15, quad = lane >> 4;
    unsigned pg[8]; v4u poi[2], psf[4], pqh[16]; f32x4 pdc[4][2];
    f32x4 carry[4][2];
#pragma unroll
    for (int ks = 0; ks < 4; ++ks) { carry[ks][0] = (f32x4){0.f, 0.f, 0.f, 0.f}; carry[ks][1] = (f32x4){0.f, 0.f, 0.f, 0.f}; }
    { const int glen = u_hi - u_lo, c_lo = u_lo & 63, ngrp = c_lo / glen, ubh = u_lo - c_lo;
      for (int gq = 0; gq < ngrp; ++gq) { const int ul = ubh + (gq + 1) * glen - 1;
#pragma unroll
          for (int ks = 0; ks < 4; ++ks) { float a4[4], b4[4];
              if (US_FP8) { const v2u t_ = *(const GAS v2u*)(UD + (size_t)ul * US_CH + w * US_W + ks * US_KS + lane * US_LN); un4_fp8(t_.x, a4); un4_fp8(t_.y, b4); }
              else { const v4u t_ = *(const GAS v4u*)(UD + (size_t)ul * 32768 + w * 4096 + ks * 1024 + lane * 16); a4[0] = bflo(t_.x); a4[1] = bfhi(t_.x); a4[2] = bflo(t_.y); a4[3] = bfhi(t_.y); b4[0] = bflo(t_.z); b4[1] = bfhi(t_.z); b4[2] = bflo(t_.w); b4[3] = bfhi(t_.w); }
              const f32x4 da = *(const GAS f32x4*)(DECG + (size_t)ul * 128 + 32 * ks + 4 * quad), db = *(const GAS f32x4*)(DECG + (size_t)ul * 128 + 32 * ks + 16 + 4 * quad);
              carry[ks][0] = da * carry[ks][0] + (f32x4){a4[0], a4[1], a4[2], a4[3]}; carry[ks][1] = db * carry[ks][1] + (f32x4){b4[0], b4[1], b4[2], b4[3]}; } } }
#define SC2C_LOAD(u_) do { const int b_ = (u_) >> 9, h_ = ((u_) >> 6) & 7, c_ = (u_) & 63; \
        _Pragma("unroll") for (int j = 0; j < 8; ++j) pg[j] = *(const GAS unsigned*)(G0 + ((size_t)b_ * SEQ + c_ * 64 + 8 * w + j) * D + (size_t)h_ * 128 + 2 * lane); \
        _Pragma("unroll") for (int hh = 0; hh < 2; ++hh) { if (OI_FP8) { if (hh == 0) poi[0] = *(const GAS v4u*)((const unsigned char*)O0 + tile_off(b_, h_, c_, w * 1024 + lane * 16)); } else poi[hh] = *(const GAS v4u*)((const unsigned char*)O0 + tile_off(b_, h_, c_, w * 2048 + hh * 1024 + lane * 16)); } \
        _Pragma("unroll") for (int ks = 0; ks < 4; ++ks) { const bool in_ = (u_) > u_lo;     \
            if (US_FP8) { const v2u t_ = in_ ? *(const GAS v2u*)(UD + (size_t)((u_) - 1) * US_CH + w * US_W + ks * US_KS + lane * US_LN) : (v2u){0u, 0u}; psf[ks] = (v4u){t_.x, t_.y, 0u, 0u}; } \
            else psf[ks] = in_ ? *(const GAS v4u*)(UD + (size_t)((u_) - 1) * 32768 + w * 4096 + ks * 1024 + lane * 16) : (v4u){0u, 0u, 0u, 0u}; \
            pdc[ks][0] = in_ ? *(const GAS f32x4*)(DECG + (size_t)((u_) - 1) * 128 + 32 * ks + 4 * quad) : (f32x4){1.f, 1.f, 1.f, 1.f}; \
            pdc[ks][1] = in_ ? *(const GAS f32x4*)(DECG + (size_t)((u_) - 1) * 128 + 32 * ks + 16 + 4 * quad) : (f32x4){1.f, 1.f, 1.f, 1.f}; } \
        _Pragma("unroll") for (int f = 0; f < 16; ++f) { if (QH_FP8) { const v2u t_ = *(const GAS v2u*)(QHF + (size_t)(u_) * 8192 + f * 512 + lane * 8); pqh[f] = (v4u){t_.x, t_.y, 0u, 0u}; } else pqh[f] = *(const GAS v4u*)(QHF + (size_t)(u_) * 16384 + f * 1024 + lane * 16); } } while (0)
    SC2C_LOAD(u_lo);
    for (int u = u_lo; u < u_hi; ++u) {
        const int b = u >> 9, h = (u >> 6) & 7, c = u & 63;
        const size_t gcol = (size_t)h * 128 + 2 * lane;
        unsigned cg[8];
#pragma unroll
        for (int j = 0; j < 8; ++j) cg[j] = pg[j];
        v4u sfb[4];
#pragma unroll
        for (int ks = 0; ks < 4; ++ks) { float a4[4], b4[4];
            if (US_FP8) { un4_fp8(psf[ks].x, a4); un4_fp8(psf[ks].y, b4); }
            else { a4[0] = bflo(psf[ks].x); a4[1] = bfhi(psf[ks].x); a4[2] = bflo(psf[ks].y); a4[3] = bfhi(psf[ks].y); b4[0] = bflo(psf[ks].z); b4[1] = bfhi(psf[ks].z); b4[2] = bflo(psf[ks].w); b4[3] = bfhi(psf[ks].w); }
#pragma unroll
            for (int e = 0; e < 4; ++e) { a4[e] += pdc[ks][0][e] * carry[ks][0][e]; b4[e] += pdc[ks][1][e] * carry[ks][1][e]; }
            sfb[ks] = (v4u){cvtpk(a4[0], a4[1]), cvtpk(a4[2], a4[3]), cvtpk(b4[0], b4[1]), cvtpk(b4[2], b4[3])}; }
        f32x4 oacc[4];
#pragma unroll
        for (int mi = 0; mi < 4; ++mi) { if (OI_FP8) { float t4[4]; un4_fp8(mi == 0 ? poi[0].x : mi == 1 ? poi[0].y : mi == 2 ? poi[0].z : poi[0].w, t4); oacc[mi] = (f32x4){t4[0], t4[1], t4[2], t4[3]}; }
            else { const unsigned lo = mi & 1 ? poi[mi >> 1].z : poi[mi >> 1].x, hi2 = mi & 1 ? poi[mi >> 1].w : poi[mi >> 1].y; oacc[mi] = (f32x4){bflo(lo), bfhi(lo), bflo(hi2), bfhi(hi2)}; } }
#pragma unroll
        for (int mi = 0; mi < 4; ++mi)
#pragma unroll
            for (int ks = 0; ks < 4; ++ks) { v4u qa = pqh[mi * 4 + ks];
                if (QH_FP8) { float a4[4], b4[4]; un4_fp8(qa.x, a4); un4_fp8(qa.y, b4); qa = (v4u){cvtpk(a4[0], a4[1]), cvtpk(a4[2], a4[3]), cvtpk(b4[0], b4[1]), cvtpk(b4[2], b4[3])}; }
                oacc[mi] = __builtin_amdgcn_mfma_f32_16x16x32_bf16(__builtin_bit_cast(bf16x8, qa), __builtin_bit_cast(bf16x8, sfb[ks]), oacc[mi], 0, 0, 0); }
        if (u + 1 < u_hi) SC2C_LOAD(u + 1);
#pragma unroll
        for (int mi = 0; mi < 4; ++mi)
#pragma unroll
            for (int j = 0; j < 4; ++j) { const float v = oacc[mi][j]; const float q = row16_sum(v * v);
                const int t = 16 * mi + 4 * quad + j;
                if (row16 == 0) SS[t * 8 + w] = q;
                *(LAS float*)(L + SC_OUT + t * 528 + (16 * w + row16) * 4) = v; }
        LDS_BAR();
        const float ng0 = norm_g[h * 128 + 2 * lane], ng1 = norm_g[h * 128 + 2 * lane + 1];
#pragma unroll
        for (int j = 0; j < 8; ++j) { const int r = 8 * w + j;
            const f32x4 sa = *(const LAS f32x4*)(SS + r * 8), sb = *(const LAS f32x4*)(SS + r * 8 + 4);
            const float rstd = __builtin_amdgcn_rsqf((((sa.x + sa.y) + (sa.z + sa.w)) + ((sb.x + sb.y) + (sb.z + sb.w))) * (1.0f / 128.0f) + RMS_EPS);
            const f32x2 v = *(const LAS f32x2*)(L + SC_OUT + r * 528 + 8 * lane);
            *(GAS unsigned*)(O0 + ((size_t)b * SEQ + c * 64 + r) * D + gcol) = cvtpk(v.x * rstd * ng0 * pg8::sigmoidf_(bflo(cg[j])), v.y * rstd * ng1 * pg8::sigmoidf_(bfhi(cg[j]))); }
        LDS_BAR();
    }
#undef SC2C_LOAD
}

constexpr int RT_WT = 0, RT_LCNT = 65536, RT_LBASE = RT_LCNT + 64, RT_INFO = RT_LBASE + 64, RT_LG = RT_INFO + 3072;
static_assert(RT_LG + 8192 <= RING_BYTES, "router LDS map");
template <bool RB16, int RESMODE> __device__ __forceinline__ void ln_router_phase(Frame& F, const float* R, const void* res, const float* lng, const float* lnb, const float* router_w, const float* router_b,
                                                bf16* X1B, unsigned char* X18, gu32* cnt, int* DEST, float* GATE) {
    LAS unsigned char* L = F.lds + RING_OFF;
    LAS float* WT = (LAS float*)(L + RT_WT); LAS int* lcnt = (LAS int*)(L + RT_LCNT); LAS int* lbase = (LAS int*)(L + RT_LBASE); LAS int* info = (LAS int*)(L + RT_INFO); LAS float* LG = (LAS float*)(L + RT_LG);
    for (int idx = F.tid; idx < 16 * D; idx += NWAVES * 64) { const int col = idx >> 4, e = idx & 15; WT[e * D + col] = router_w[idx]; }
    if (F.tid < 16) lcnt[F.tid] = 0;
    f32x4 gv[4], bv[4];
#pragma unroll
    for (int j = 0; j < 4; ++j) { gv[j] = *(const f32x4*)(lng + 4 * F.lane + 256 * j); bv[j] = *(const f32x4*)(lnb + 4 * F.lane + 256 * j); }
    __syncthreads();
    const int lane = F.lane;
    for (int base = F.vcu * 128; base < M; base += F.G * 128) {
        f32x4 v[4][4];
#define LNR_LOAD(it_) do { const int lr0_ = F.wave * 16 + (it_) * 4; \
            _Pragma("unroll") for (int r = 0; r < 4; ++r) { \
                if (RB16 || RESMODE) { const GAS v2u* xr = (const GAS v2u*)((const bf16*)R + (size_t)(base + lr0_ + r) * D) + lane; \
                    _Pragma("unroll") for (int j = 0; j < 4; ++j) { const v2u t = xr[64 * j]; v[r][j] = (f32x4){bflo(t.x), bfhi(t.x), bflo(t.y), bfhi(t.y)}; } } \
                else { const GAS f32x4* xr = (const GAS f32x4*)(R + (size_t)(base + lr0_ + r) * D) + lane; \
                    _Pragma("unroll") for (int j = 0; j < 4; ++j) v[r][j] = xr[64 * j]; } \
                if (RESMODE == 1) { const GAS f32x4* rr = (const GAS f32x4*)((const float*)res + (size_t)(base + lr0_ + r) * D) + lane;     \
                    _Pragma("unroll") for (int j = 0; j < 4; ++j) v[r][j] = rr[64 * j] * DN_ALPHA + v[r][j]; } \
                if (RESMODE == 2) { const GAS v2u* rr = (const GAS v2u*)((const bf16*)res + (size_t)(base + lr0_ + r) * D) + lane; \
                    _Pragma("unroll") for (int j = 0; j < 4; ++j) { const v2u t = rr[64 * j]; v[r][j] = (f32x4){bflo(t.x), bfhi(t.x), bflo(t.y), bfhi(t.y)} * DN_ALPHA + v[r][j]; } } } \
        } while (0)
        LNR_LOAD(0);
#pragma unroll 1
        for (int it = 0; it < 4; ++it) {
            const int lr0 = F.wave * 16 + it * 4;
#pragma unroll
            for (int r = 0; r < 4; ++r) { float s = 0.f;
#pragma unroll
                for (int j = 0; j < 4; ++j) s += (v[r][j].x + v[r][j].y) + (v[r][j].z + v[r][j].w);
                const float mean = wave_sum(s) * (1.f / D); float s2 = 0.f;
#pragma unroll
                for (int j = 0; j < 4; ++j) { v[r][j] = v[r][j] - mean; s2 += (v[r][j].x * v[r][j].x + v[r][j].y * v[r][j].y) + (v[r][j].z * v[r][j].z + v[r][j].w * v[r][j].w); }
                const float rstd = 1.f / sqrtf(wave_sum(s2) * (1.f / D) + LN_EPS);
                GAS v2u* o8 = (GAS v2u*)(X1B + (size_t)(base + lr0 + r) * D) + lane;
#pragma unroll
                for (int j = 0; j < 4; ++j) { v[r][j] = v[r][j] * rstd * gv[j] + bv[j]; v2u o; o.x = pk2(v[r][j].x, v[r][j].y); o.y = pk2(v[r][j].z, v[r][j].w); o8[64 * j] = o;
                    if (X18) { int w8 = 0; w8 = __builtin_amdgcn_cvt_pk_fp8_f32(v[r][j].x, v[r][j].y, w8, false); w8 = __builtin_amdgcn_cvt_pk_fp8_f32(v[r][j].z, v[r][j].w, w8, true);
                        *(GAS unsigned*)(X18 + (size_t)(base + lr0 + r) * D + 4 * lane + 256 * j) = (unsigned)w8; } } }
            float val[64];
#pragma unroll
            for (int e = 0; e < 16; ++e) { f32x4 wv[4];
#pragma unroll
                for (int j = 0; j < 4; ++j) wv[j] = *(const LAS f32x4*)(WT + e * D + 4 * lane + 256 * j);
#pragma unroll
                for (int r = 0; r < 4; ++r) { float p = 0.f;
#pragma unroll
                    for (int j = 0; j < 4; ++j) p += (v[r][j].x * wv[j].x + v[r][j].y * wv[j].y) + (v[r][j].z * wv[j].z + v[r][j].w * wv[j].w);
                    val[r * 16 + e] = p; } }
#pragma unroll
            for (int st = 0; st < 6; ++st) { const int m = 32 >> st, n = 64 >> st; const bool up = (lane & m) != 0;
                if (st == 2) { if (it + 1 < 4) LNR_LOAD(it + 1); }
#pragma unroll
                for (int i = 0; i < n / 2; ++i) { const float a = val[i], b2 = val[i + n / 2]; const float keep = up ? b2 : a, send = up ? a : b2; val[i] = keep + __shfl_xor(send, m); } }
            LG[(lr0 + (lane >> 4)) * 16 + (lane & 15)] = val[0];
        }
#undef LNR_LOAD
        LDS_WAIT(); asm volatile("" ::: "memory");
        if (lane < 16) {
            const int lr = F.wave * 16 + lane;
            float lg[16];
#pragma unroll
            for (int q = 0; q < 4; ++q) { const f32x4 t = *(const LAS f32x4*)(LG + lr * 16 + 4 * q); lg[4 * q] = t.x; lg[4 * q + 1] = t.y; lg[4 * q + 2] = t.z; lg[4 * q + 3] = t.w; }
            float mx = lg[0];
#pragma unroll
            for (int e = 1; e < 16; ++e) mx = fmaxf(mx, lg[e]);
            float pe[16], sum = 0.f;
#pragma unroll
            for (int e = 0; e < 16; ++e) { pe[e] = __expf(lg[e] - mx); sum += pe[e]; }
            const float inv = 1.0f / sum; float sel[16];
#pragma unroll
            for (int e = 0; e < 16; ++e) { pe[e] *= inv; sel[e] = pe[e] + router_b[e]; }
            float gs[4];
#pragma unroll
            for (int g = 0; g < 4; ++g) { const float a = sel[4 * g], b2 = sel[4 * g + 1], c2 = sel[4 * g + 2], d2 = sel[4 * g + 3];
                const float hi1 = fmaxf(a, b2), lo1 = fminf(a, b2), hi2 = fmaxf(c2, d2), lo2 = fminf(c2, d2);
                gs[g] = fmaxf(hi1, hi2) + fmaxf(fminf(hi1, hi2), fmaxf(lo1, lo2)); }
            int gb = 0; float gbv = gs[0];
#pragma unroll
            for (int g = 1; g < 4; ++g) if (gs[g] > gbv) { gbv = gs[g]; gb = g; }
            float s4[4], p4[4];
#pragma unroll
            for (int k = 0; k < 4; ++k) { s4[k] = gb == 0 ? sel[k] : gb == 1 ? sel[4 + k] : gb == 2 ? sel[8 + k] : sel[12 + k]; p4[k] = gb == 0 ? pe[k] : gb == 1 ? pe[4 + k] : gb == 2 ? pe[8 + k] : pe[12 + k]; }
            int i0 = 0; float b0 = s4[0];
#pragma unroll
            for (int k = 1; k < 4; ++k) if (s4[k] > b0) { b0 = s4[k]; i0 = k; }
            int i1 = -1; float b1 = -INFINITY;
#pragma unroll
            for (int k = 0; k < 4; ++k) if (k != i0 && (i1 < 0 || s4[k] > b1)) { b1 = s4[k]; i1 = k; }
            const float q0 = i0 == 0 ? p4[0] : i0 == 1 ? p4[1] : i0 == 2 ? p4[2] : p4[3], q1 = i1 == 0 ? p4[0] : i1 == 1 ? p4[1] : i1 == 2 ? p4[2] : p4[3];
            const float den = 1.0f / (q0 + q1);
            const int e0 = gb * 4 + i0, e1 = gb * 4 + i1;
            const int p0 = __hip_atomic_fetch_add(lcnt + e0, 1, __ATOMIC_RELAXED, __HIP_MEMORY_SCOPE_WORKGROUP), p1 = __hip_atomic_fetch_add(lcnt + e1, 1, __ATOMIC_RELAXED, __HIP_MEMORY_SCOPE_WORKGROUP);
            info[lr] = e0; info[128 + lr] = e1; info[256 + lr] = p0; info[384 + lr] = p1; info[512 + lr] = __float_as_int(q0 * den); info[640 + lr] = __float_as_int(q1 * den);
        }
        __syncthreads();
        if (F.tid < 16) { const int n = lcnt[F.tid]; lbase[F.tid] = n ? (int)__hip_atomic_fetch_add(cnt + 64 * F.tid, (unsigned)n, RLX_AGENT) : 0; }
        __syncthreads();
        if (F.tid < 128) { const int lr = F.tid, row = base + lr; const int e0 = info[lr], e1 = info[128 + lr];
            const int d0 = e0 * ECAP + lbase[e0] + info[256 + lr], d1 = e1 * ECAP + lbase[e1] + info[384 + lr];
            DEST[d0] = row * 2; GATE[d0] = __int_as_float(info[512 + lr]); DEST[d1] = row * 2 + 1; GATE[d1] = __int_as_float(info[640 + lr]); }
        __syncthreads();
        if (F.tid < 16) lcnt[F.tid] = 0;
        __syncthreads();
    }
}
__device__ __forceinline__ int moe_table(Frame& F, gu32* cnt) {
    LAS int* tab = (LAS int*)(F.lds + MOETAB_OFF);
    __syncthreads();
    if (F.wave == 0) {
        const int e = F.lane & 15; const int n = (int)__hip_atomic_load(cnt + 64 * e, RLX_AGENT); const int nt = (n + 255) >> 8;
        int incl = nt;
#pragma unroll
        for (int d = 1; d < 16; d <<= 1) { const int t = __shfl_up(incl, d, 16); if (e >= d) incl += t; }
        if (F.lane < 16) { tab[e] = incl - nt; tab[17 + e] = (incl - nt) * 256; tab[34 + e] = n; if (e == 15) { tab[16] = incl; tab[33] = incl * 256; } }
    }
    __syncthreads();
    return tab[16] * 4;
}
struct Ln2Raw { v4u a[2], y0[2], y1[2]; };
template <bool Y8> __device__ __forceinline__ void ln2_load(Ln2Raw& r, const bf16* X1B, const bf16* Y2, int m, int lane) {
#pragma unroll
    for (int j = 0; j < 2; ++j) { const size_t c = 8 * lane + 512 * j;
        r.a[j] = *(const GAS v4u*)(X1B + (size_t)m * D + c);
        if (Y8) { const v2u t0 = *(const GAS v2u*)((const unsigned char*)Y2 + (size_t)(2 * m) * D + c), t1 = *(const GAS v2u*)((const unsigned char*)Y2 + (size_t)(2 * m + 1) * D + c);
            r.y0[j] = (v4u){t0.x, t0.y, 0u, 0u}; r.y1[j] = (v4u){t1.x, t1.y, 0u, 0u}; }
        else { r.y0[j] = *(const GAS v4u*)(Y2 + (size_t)(2 * m) * D + c); r.y1[j] = *(const GAS v4u*)(Y2 + (size_t)(2 * m + 1) * D + c); } }
}
template <bool FINAL, bool Y8 = false> __device__ __forceinline__ void ln2_phase(Frame& F, const bf16* X1B, const bf16* Y2, const float* lng, const float* lnb, bf16* XOUT, float* out, unsigned char* X8 = nullptr) {
    float gv[16], bv[16];
#pragma unroll
    for (int j = 0; j < 2; ++j)
#pragma unroll
        for (int i = 0; i < 8; ++i) { gv[8 * j + i] = lng[8 * F.lane + 512 * j + i]; bv[8 * j + i] = lnb[8 * F.lane + 512 * j + i]; }
    const int gw = F.vcu * NWAVES + F.wave, NGW = F.G * NWAVES;
    Ln2Raw cur, nxt;
    if (gw < M) ln2_load<Y8>(cur, X1B, Y2, gw, F.lane);
    for (int m = gw; m < M; m += NGW) {
        if (m + NGW < M) ln2_load<Y8>(nxt, X1B, Y2, m + NGW, F.lane);
        float v[16]; float s = 0.f;
#pragma unroll
        for (int j = 0; j < 2; ++j) { const v4u a = cur.a[j];
            if (Y8) { float p0[4], p1[4], q0[4], q1[4]; un4_fp8(cur.y0[j].x, p0); un4_fp8(cur.y0[j].y, p1); un4_fp8(cur.y1[j].x, q0); un4_fp8(cur.y1[j].y, q1);
#pragma unroll
                for (int i = 0; i < 4; ++i) { const float ya = i < 2 ? (p0[2 * i] + q0[2 * i]) : (p1[2 * i - 4] + q1[2 * i - 4]), yb = i < 2 ? (p0[2 * i + 1] + q0[2 * i + 1]) : (p1[2 * i - 3] + q1[2 * i - 3]);
                    v[8 * j + 2 * i] = DN_ALPHA * bflo(a[i]) + ya; v[8 * j + 2 * i + 1] = DN_ALPHA * bfhi(a[i]) + yb; } }
            else { const v4u y0 = cur.y0[j], y1 = cur.y1[j];
#pragma unroll
                for (int i = 0; i < 4; ++i) { v[8 * j + 2 * i] = DN_ALPHA * bflo(a[i]) + (bflo(y0[i]) + bflo(y1[i])); v[8 * j + 2 * i + 1] = DN_ALPHA * bfhi(a[i]) + (bfhi(y0[i]) + bfhi(y1[i])); } } }
#pragma unroll
        for (int i = 0; i < 16; ++i) s += v[i];
        const float mean = wave_sum(s) * (1.f / D); float s2 = 0.f;
#pragma unroll
        for (int i = 0; i < 16; ++i) { v[i] -= mean; s2 += v[i] * v[i]; }
        const float rstd = 1.f / sqrtf(wave_sum(s2) * (1.f / D) + LN_EPS);
#pragma unroll
        for (int i = 0; i < 16; ++i) v[i] = v[i] * rstd * gv[i] + bv[i];
#pragma unroll
        for (int j = 0; j < 2; ++j) { const size_t c = (size_t)m * D + 8 * F.lane + 512 * j;
            if (FINAL) { *(GAS f32x4*)(out + c) = (f32x4){v[8 * j], v[8 * j + 1], v[8 * j + 2], v[8 * j + 3]}; *(GAS f32x4*)(out + c + 4) = (f32x4){v[8 * j + 4], v[8 * j + 5], v[8 * j + 6], v[8 * j + 7]}; }
            else { *(GAS v4u*)(XOUT + c) = (v4u){pk2(v[8 * j], v[8 * j + 1]), pk2(v[8 * j + 2], v[8 * j + 3]), pk2(v[8 * j + 4], v[8 * j + 5]), pk2(v[8 * j + 6], v[8 * j + 7])};
                if (X8) { int w0 = 0, w1 = 0; w0 = __builtin_amdgcn_cvt_pk_fp8_f32(v[8 * j], v[8 * j + 1], w0, false); w0 = __builtin_amdgcn_cvt_pk_fp8_f32(v[8 * j + 2], v[8 * j + 3], w0, true);
                    w1 = __builtin_amdgcn_cvt_pk_fp8_f32(v[8 * j + 4], v[8 * j + 5], w1, false); w1 = __builtin_amdgcn_cvt_pk_fp8_f32(v[8 * j + 6], v[8 * j + 7], w1, true); *(GAS v2u*)(X8 + c) = (v2u){(unsigned)w0, (unsigned)w1}; } } }
        cur = nxt;
    }
}
__device__ __forceinline__ void combine_phase(Frame& F, const bf16* O1, const bf16* O2, const float* subln_g, const float* tab, bf16* OA) {
    const float lam = tab[1024];
    float gv[8];
#pragma unroll
    for (int i = 0; i < 8; ++i) gv[i] = subln_g[8 * (F.lane & 15) + i] * (1.0f - LAMBDA_INIT);
    const int gw = F.vcu * NWAVES + F.wave, NGW = F.G * NWAVES;
    for (int m = gw; m < M; m += NGW) {
#pragma unroll
        for (int j = 0; j < 2; ++j) { const size_t c = (size_t)m * D + 8 * F.lane + 512 * j;
            const v4u a = *(const GAS v4u*)(O1 + c), b2 = *(const GAS v4u*)(O2 + c); float v[8]; float q = 0.f;
#pragma unroll
            for (int i = 0; i < 4; ++i) { v[2 * i] = bflo(a[i]) - lam * bflo(b2[i]); v[2 * i + 1] = bfhi(a[i]) - lam * bfhi(b2[i]); q += v[2 * i] * v[2 * i] + v[2 * i + 1] * v[2 * i + 1]; }
            q += __shfl_xor(q, 1); q += __shfl_xor(q, 2); q += __shfl_xor(q, 4); q += __shfl_xor(q, 8);
            const float rstd = 1.0f / sqrtf(q * (1.0f / 128.0f) + RMS_EPS);
            *(GAS v4u*)(OA + c) = (v4u){pk2(v[0] * rstd * gv[0], v[1] * rstd * gv[1]), pk2(v[2] * rstd * gv[2], v[3] * rstd * gv[3]), pk2(v[4] * rstd * gv[4], v[5] * rstd * gv[5]), pk2(v[6] * rstd * gv[6], v[7] * rstd * gv[7])}; }
    }
}

struct Args { const float* in[19]; float* out; unsigned char* ws; int ph_lo, ph_hi, li, pad; };
__global__ void __launch_bounds__(NWAVES * 64, 2) yoco_fwd(Args args) {
    extern __shared__ __attribute__((aligned(16))) unsigned char lds[];
    Frame F;
    F.lds = (LAS unsigned char*)lds;
    F.tid = threadIdx.x; F.lane = F.tid & 63; F.wave = __builtin_amdgcn_readfirstlane(F.tid >> 6);
    F.G = gridDim.x; { const int bx = blockIdx.x; F.vcu = (F.G % 8 == 0) ? (bx % 8) * (F.G / 8) + bx / 8 : bx; }
    unsigned char* ws = args.ws;
    F.ctl = (gu32*)(ws + WS_CTL);
    Inputs in;
    in.x = args.in[0]; in.a_w_in = args.in[1]; in.a_lb = args.in[2]; in.a_norm_g = args.in[3]; in.a_w_out = args.in[4]; in.kv_w = args.in[5]; in.b_w_q = args.in[6]; in.b_lam = args.in[7];
    in.b_subln_g = args.in[8]; in.b_w_out = args.in[9]; in.ln1_g = args.in[10]; in.ln1_b = args.in[11]; in.ln2_g = args.in[12]; in.ln2_b = args.in[13]; in.router_w = args.in[14]; in.router_b = args.in[15];
    in.moe_w_gate = args.in[16]; in.moe_w_up = args.in[17]; in.moe_w_down = args.in[18];
    for (int u = F.tid; u < (LDS_BYTES - LDSCTL_OFF) / 4; u += NWAVES * 64) ((LAS unsigned*)(F.lds + LDSCTL_OFF))[u] = 0u;
    __syncthreads();
    XcdBarrier bar; bar.bar = (unsigned*)(F.ctl + CW_BAR) + args.li * XCD_BAR_WORDS; bar.x = 0; bar.st = nullptr;
    if (N_LAUNCH_MODE == 1) bar = xcd_barrier_post((unsigned*)(F.ctl + CW_BAR) + args.li * XCD_BAR_WORDS, (volatile LAS unsigned*)(F.lds + MISC_OFF) + 8);
    const int lo = args.ph_lo, hi = args.ph_hi;
#ifndef PHASE_MASK
#define PHASE_MASK 0xffff
#endif
#define IN(k) (((PHASE_MASK >> (k)) & 1) && lo <= (k) && (k) < hi)
#define RETID() do { int t_ = threadIdx.x; asm volatile("" : "+v"(t_)); F.tid = t_; F.lane = t_ & 63; } while (0)
#ifndef REPEAT_MASK
#define REPEAT_MASK 0
#endif
#define NREP(k) (((REPEAT_MASK >> (k)) & 1) ? 2 : 1)
#define REP(k) for (int rep_ = 0; rep_ < NREP(k); ++rep_, (rep_ < NREP(k) ? xcd_barrier(bar) : (void)0))
#ifdef DIAG_PHASE
#define SEAM(k) do { if (IN(k) && IN((k) + 1)) xcd_barrier(bar); if (blockIdx.x == 0 && F.tid == 0) ((unsigned long long*)(ws + WS_TAB + 8192))[(k) + 1] = __builtin_amdgcn_s_memrealtime(); } while (0)
#else
#define BARW(j) do { if (SHADOW_CONV && N_LAUNCH_MODE == 1) xcd_barrier_w(bar, [&]() { shadow_convert(F, in, ws, (j)); }); else xcd_barrier(bar); } while (0)
#define SEAM_ORD(k) ((k) <= 1 ? (k) : (k) <= 9 ? (k) + 1 : (k))
#define SEAM(k) do { if (IN(k) && IN((k) + 1)) BARW(SEAM_ORD(k)); } while (0)
#endif
    bf16* const bA = (bf16*)(ws + WS_A); bf16* const bB = (bf16*)(ws + WS_B); bf16* const bC = (bf16*)(ws + WS_C); bf16* const bD = (bf16*)(ws + WS_D); bf16* const bE = (bf16*)(ws + WS_E); bf16* const bF = (bf16*)(ws + WS_F);
    const float* const tab = (const float*)(ws + WS_TAB);
    int* const DEST = (int*)(ws + WS_DEST); float* const GATE = (float*)(ws + WS_GATE);

#ifdef DIAG_PHASE
    if (blockIdx.x == 0 && F.tid == 0) ((unsigned long long*)(ws + WS_TAB + 8192))[0] = __builtin_amdgcn_s_memrealtime();
#endif
    if (IN(0)) REP(0) { RETID(); p0_prologue(F, in, ws); moe_weight_convert(F, in, ws, 0, (SHADOW_CONV && N_LAUNCH_MODE == 1) ? SH_P0 : MOE_NIT, F.vcu * NWAVES + F.wave, F.G * NWAVES); } SEAM(0);
    if (IN(1)) REP(1) { RETID();
        { pg8::Gemm g{bA, (const bf16*)(ws + WS_WIN), D}; pg8::StaticOrder S; S.init(M, proj_count(false) * D, D, F.G, (int)blockIdx.x);
          pg8::EpiProj E{bB, bC, bD, bE, tab, proj_gmap(false)};
          pg8::gemm_phase<pg8::EpiProj, pg8::StaticOrder, true>(F.lds + RING_OFF, g, S, E); }
        if constexpr (FP8_PROJ != 0) {
            __syncthreads();
            pg8::Gemm g{bF, ws + WS_WIN8, D}; pg8::StaticOrder S; S.init(M, proj_count(true) * D, D, F.G, (int)blockIdx.x);
            pg8::EpiProj E{bB, bC, bD, bE, tab, proj_gmap(true)};
            pg8::gemm_phase<pg8::EpiProj, pg8::StaticOrder, true, true>(F.lds + RING_OFF, g, S, E); }
    } SEAM(1);
    if (IN(2)) REP(2) { RETID();
        unsigned char* UD = (unsigned char*)args.out; unsigned char* QHF = (US_FP8 && QH_FP8) ? (unsigned char*)args.out + 64 * MiB : (unsigned char*)bA; float* DECG = (float*)(ws + WS_DEST);
        const int upw = (4096 + F.G - 1) / F.G;
        { const int u0 = F.vcu * upw, u1 = (F.vcu + 1) * upw < 4096 ? (F.vcu + 1) * upw : 4096; scan2a_range(F, u0, u1, bB, bC, bD, UD, QHF, (unsigned char*)bF, DECG); }
#ifdef PROBE_2A
        xcd_barrier(bar);
        { const int u0 = F.vcu * upw, u1 = (F.vcu + 1) * upw < 4096 ? (F.vcu + 1) * upw : 4096; scan2a_range(F, u0, u1, bB, bC, bD, UD, QHF, (unsigned char*)bF, DECG); }
#endif
        BARW(2);
        { const int u0 = F.vcu * upw, u1 = (F.vcu + 1) * upw < 4096 ? (F.vcu + 1) * upw : 4096; scan2c_range(F, u0, u1, UD, QHF, bE, in.a_norm_g, bF, DECG); }
    } SEAM(2);
    if (IN(3)) REP(3) { RETID();
        pg8::Gemm g{bF, (const bf16*)(ws + WS_WOUT), D}; pg8::StaticOrder S; S.init(M, D, D, F.G, (int)blockIdx.x);
        if constexpr (MIX_SPLIT) { pg8::EpiBf16 E{bB, D, 0, 0, 1.0f}; pg8::gemm_phase<pg8::EpiBf16, pg8::StaticOrder, true>(F.lds + RING_OFF, g, S, E); }
#ifndef XRES_BF16
#define XRES_BF16 1
#endif
        else if constexpr (XRES_BF16) { pg8::EpiResid<true, R_BF16 != 0> E{bA, (float*)bB, DN_ALPHA}; pg8::gemm_phase<pg8::EpiResid<true, R_BF16 != 0>, pg8::StaticOrder, ALIGN_P3>(F.lds + RING_OFF, g, S, E); }
        else { pg8::EpiResid<false, R_BF16 != 0> E{in.x, (float*)bB, DN_ALPHA}; pg8::gemm_phase<pg8::EpiResid<false, R_BF16 != 0>, pg8::StaticOrder, ALIGN_P3>(F.lds + RING_OFF, g, S, E); }
    } SEAM(3);
#ifdef PROBE_P4
    if (IN(4)) { ln_router_phase<R_BF16 != 0, MIX_SPLIT ? 1 : 0>(F, (const float*)bB, in.x, in.ln1_g, in.ln1_b, in.router_w, in.router_b, bA, nullptr, F.ctl + CW_CNT + 2048, (int*)args.out, (float*)args.out + 16 * ECAP); xcd_barrier(bar); }
#endif
    if (IN(4)) REP(4) { RETID(); ln_router_phase<R_BF16 != 0, MIX_SPLIT == 2 ? 2 : MIX_SPLIT ? 1 : 0>(F, (const float*)bB, MIX_SPLIT == 2 ? (const void*)bA : (const void*)in.x, in.ln1_g, in.ln1_b, in.router_w, in.router_b, bA, FP8_L0 ? (unsigned char*)bF : nullptr, F.ctl + CW_CNT, DEST, GATE); } SEAM(4);
    if (IN(5)) REP(5) { RETID();
        const int total = moe_table(F, F.ctl + CW_CNT);
        pg8::MoeOrder S{(const LAS int*)(F.lds + MOETAB_OFF), F.G, (int)blockIdx.x, total, D, DEST, (size_t)D * D, true, (const LAS int*)(F.lds + RING_OFF + pg8::STAGE_BYTES)};
        S.fill_rows((LAS int*)(F.lds + RING_OFF + pg8::STAGE_BYTES));
        if constexpr (FP8_L0) { pg8::Gemm g{bF, ws + WS_WGU, D}; pg8::EpiGateUp8 E{(unsigned char*)bD}; pg8::gemm_phase<pg8::EpiGateUp8, pg8::MoeOrder, true, true, 1, true>(F.lds + RING_OFF, g, S, E); }
        else { pg8::Gemm g{bA, ws + WS_WGU, D}; pg8::EpiGateUp E{bD}; pg8::gemm_phase<pg8::EpiGateUp, pg8::MoeOrder, true>(F.lds + RING_OFF, g, S, E); }
    } SEAM(5);
    if (IN(6)) REP(6) { RETID();
        const int total = (N_LAUNCH_MODE == 1 && IN(5)) ? ((const LAS int*)(F.lds + MOETAB_OFF))[16] * 4 : moe_table(F, F.ctl + CW_CNT);
        pg8::Gemm g{bD, ws + WS_WD, DEXP};
        pg8::MoeOrder S{(const LAS int*)(F.lds + MOETAB_OFF), F.G, (int)blockIdx.x, total, DEXP, DEST, (size_t)D * DEXP, false, nullptr};
        S.fill_dest((LAS int*)(F.lds + RING_OFF + pg8::STAGE_BYTES), GATE);
        pg8::EpiDown<Y2L0_FP8 != 0> E{bB, DEST, GATE, (const LAS int*)(F.lds + RING_OFF + pg8::STAGE_BYTES)};
        pg8::gemm_phase<pg8::EpiDown<Y2L0_FP8 != 0>, pg8::MoeOrder, true, FP8_L0 != 0, 1, true>(F.lds + RING_OFF, g, S, E);
    } SEAM(6);
    if (IN(7)) REP(7) { RETID(); ln2_phase<false, Y2L0_FP8 != 0>(F, bA, bB, in.ln2_g, in.ln2_b, bF, nullptr, FP8_QKV ? (unsigned char*)bD : nullptr); } SEAM(7);
#ifdef PROBE_BARS
    if (IN(7)) for (int xb = 0; xb < PROBE_BARS; ++xb) xcd_barrier(bar);
#endif
    if (IN(8)) REP(8) { RETID();
        pg8::Gemm g{FP8_QKV ? (const void*)bD : (const void*)bF, ws + WS_WQKV, D}; pg8::StaticOrder S; S.init(M, 3 * D, D, F.G, (int)blockIdx.x);
        pg8::EpiBf16 E{bA, D, D, (size_t)(BUFSZ / 2), 1.0f};
#ifdef PROBE_KREP_P8
        pg8::gemm_phase<pg8::EpiBf16, pg8::StaticOrder, true, FP8_QKV != 0, PROBE_KREP_P8>(F.lds + RING_OFF, g, S, E);
#else
        pg8::gemm_phase<pg8::EpiBf16, pg8::StaticOrder, true, FP8_QKV != 0>(F.lds + RING_OFF, g, S, E);
#endif
    } SEAM(8);
    if (IN(9)) REP(9) { RETID();
        LAS float* gs = (LAS float*)(F.lds + LDSCTL_OFF + 2048);
        { int t9 = F.tid; asm volatile("" : "+v"(t9));
          if (t9 < 128) gs[t9] = in.b_subln_g[t9] * (1.0f - LAMBDA_INIT); }
        __syncthreads();
        const attn_body::DiffTensors AT{(const attn_body::bf16*)bA, (const attn_body::bf16*)bB, (const attn_body::bf16*)bC, (attn_body::bf16*)bD, (const float*)(lds + LDSCTL_OFF + 2048), tab[1024]};
        attn_body::attn_phase<8>((char*)lds + RING_OFF, AT, F.vcu, F.G);
    } SEAM(9);
    if (IN(11)) REP(11) { RETID();
        pg8::Gemm g{bD, (const bf16*)(ws + WS_WBO), D}; pg8::StaticOrder S; S.init(M, D, D, F.G, (int)blockIdx.x);
        if constexpr (MIX_SPLIT) { pg8::EpiBf16 E{bA, D, 0, 0, 1.0f}; pg8::gemm_phase<pg8::EpiBf16, pg8::StaticOrder, true>(F.lds + RING_OFF, g, S, E); }
        else { pg8::EpiResid<true, R_BF16 != 0> E{bF, (float*)bA, DN_ALPHA}; pg8::gemm_phase<pg8::EpiResid<true, R_BF16 != 0>, pg8::StaticOrder, ALIGN_P3>(F.lds + RING_OFF, g, S, E); }
    } SEAM(11);
    if (IN(12)) REP(12) { RETID(); ln_router_phase<R_BF16 != 0, MIX_SPLIT ? 2 : 0>(F, (const float*)bA, bF, in.ln1_g + D, in.ln1_b + D, in.router_w, in.router_b, bC, FP8_L1 ? (unsigned char*)bE : nullptr, F.ctl + CW_CNT + 1024, DEST, GATE); } SEAM(12);
    if (IN(13)) REP(13) { RETID();
        const int total = moe_table(F, F.ctl + CW_CNT + 1024);
        pg8::MoeOrder S{(const LAS int*)(F.lds + MOETAB_OFF), F.G, (int)blockIdx.x, total, D, DEST, (size_t)D * D, true, (const LAS int*)(F.lds + RING_OFF + pg8::STAGE_BYTES)};
        S.fill_rows((LAS int*)(F.lds + RING_OFF + pg8::STAGE_BYTES));
        if constexpr (FP8_L1) { pg8::Gemm g{bE, ws + WS_WGU + 32 * MiB, D}; pg8::EpiGateUp8 E{(unsigned char*)bD}; pg8::gemm_phase<pg8::EpiGateUp8, pg8::MoeOrder, true, true, 1, true>(F.lds + RING_OFF, g, S, E); }
        else { pg8::Gemm g{bC, ws + WS_WGU + 32 * MiB, D}; pg8::EpiGateUp E{bD}; pg8::gemm_phase<pg8::EpiGateUp, pg8::MoeOrder, true>(F.lds + RING_OFF, g, S, E); }
    } SEAM(13);
    if (IN(14)) REP(14) { RETID();
        const int total = (N_LAUNCH_MODE == 1 && IN(13)) ? ((const LAS int*)(F.lds + MOETAB_OFF))[16] * 4 : moe_table(F, F.ctl + CW_CNT + 1024);
        pg8::Gemm g{bD, ws + WS_WD + 16 * MiB, DEXP};
        pg8::MoeOrder S{(const LAS int*)(F.lds + MOETAB_OFF), F.G, (int)blockIdx.x, total, DEXP, DEST, (size_t)D * DEXP, false, nullptr};
        S.fill_dest((LAS int*)(F.lds + RING_OFF + pg8::STAGE_BYTES), GATE);
        pg8::EpiDown<Y2L1_FP8 != 0> E{bA, DEST, GATE, (const LAS int*)(F.lds + RING_OFF + pg8::STAGE_BYTES)};
        pg8::gemm_phase<pg8::EpiDown<Y2L1_FP8 != 0>, pg8::MoeOrder, true, FP8_L1 != 0, 1, true>(F.lds + RING_OFF, g, S, E);
    } SEAM(14);
#ifdef DIAG_PHASE
    if (IN(15)) REP(15) { RETID();
        const unsigned long long* ts = (const unsigned long long*)(ws + WS_TAB + 8192);
        const float us = (float)(__hip_atomic_load(ts + DIAG_PHASE + 1, RLX_AGENT) - __hip_atomic_load(ts + DIAG_PHASE, RLX_AGENT)) * 0.01f, cval = sqrtf(us);
        const int gw = F.vcu * NWAVES + F.wave, NGW = F.G * NWAVES;
        for (int m = gw; m < M; m += NGW) { GAS f32x4* o = (GAS f32x4*)(args.out + (size_t)m * D) + F.lane;
#pragma unroll
            for (int j = 0; j < 4; ++j) o[64 * j] = (f32x4){cval, cval, cval, cval}; }
    }
#else
    if (IN(15)) REP(15) { RETID(); ln2_phase<true, Y2L1_FP8 != 0>(F, bC, bA, in.ln2_g + D, in.ln2_b + D, nullptr, args.out); }
#endif
#undef IN
#undef SEAM
}

extern "C" void kernel_launch(void* const* d_in, const int* in_sizes, int n_in, void* d_out, int out_size, void* d_ws, size_t ws_size, hipStream_t stream) {
    static int grid = 0;
    if (grid == 0) {
        if (n_in != 19 || in_sizes[0] != M * D || out_size != M * D || ws_size < WS_END) { fprintf(stderr, "kernel_launch: unexpected shapes (n_in %d, in0 %d, out %d, ws %zu); nothing launched\n", n_in, n_in > 0 ? in_sizes[0] : -1, out_size, ws_size); grid = -1; return; }
        int dev = 0, cus = 0, per_cu = 0;
        if (hipGetDevice(&dev) != hipSuccess || hipDeviceGetAttribute(&cus, hipDeviceAttributeMultiprocessorCount, dev) != hipSuccess) { grid = -1; return; }
        if (hipFuncSetAttribute((const void*)yoco_fwd, hipFuncAttributeMaxDynamicSharedMemorySize, LDS_BYTES) != hipSuccess) { fprintf(stderr, "kernel_launch: hipFuncSetAttribute failed\n"); grid = -1; return; }
        if (hipOccupancyMaxActiveBlocksPerMultiprocessor(&per_cu, (const void*)yoco_fwd, NWAVES * 64, LDS_BYTES) != hipSuccess || per_cu < 1) { fprintf(stderr, "kernel_launch: occupancy query reports %d workgroups per CU\n", per_cu); }
        (void)hipGetLastError();
        grid = cus;
    }
    if (grid < 0) return;
    if (hipMemsetAsync((char*)d_ws + WS_CTL, 0, CTL_ZERO_BYTES, stream) != hipSuccess) return;
    Args a{};
    for (int i = 0; i < 19; ++i) a.in[i] = (const float*)d_in[i];
    a.out = (float*)d_out; a.ws = (unsigned char*)d_ws;
#ifdef PROBE_REPEAT
    if (N_LAUNCH_MODE == 1) { const int cuts[4] = {0, PROBE_REPEAT + 1, PROBE_REPEAT + 1, N_PHASES};
        for (int l = 0; l < 3; ++l) { a.ph_lo = (l == 1) ? PROBE_REPEAT : cuts[l]; a.ph_hi = cuts[l + 1]; a.li = l; if (a.ph_lo < a.ph_hi) hipLaunchKernelGGL(yoco_fwd, dim3(grid), dim3(NWAVES * 64), LDS_BYTES, stream, a); } }
#else
    if (N_LAUNCH_MODE == 1) { a.ph_lo = 0; a.ph_hi = N_PHASES; hipLaunchKernelGGL(yoco_fwd, dim3(grid), dim3(NWAVES * 64), LDS_BYTES, stream, a); }
#endif
    else for (int p = 0; p < N_PHASES; ++p) { a.ph_lo = p; a.ph_hi = p + 1; hipLaunchKernelGGL(yoco_fwd, dim3(grid), dim3(NWAVES * 64), LDS_BYTES, stream, a); }
}
```

```cpp
#include <hip/hip_runtime.h>
#include <hip/hip_bf16.h>
#include <cstdio>
#include <cstdint>
#include <cmath>

namespace pg8 {
#define PG8_LAS __attribute__((address_space(3)))
typedef unsigned short bf16_t;
typedef short bf16x8 __attribute__((ext_vector_type(8)));
typedef float f32x4 __attribute__((ext_vector_type(4)));
typedef float f32x2 __attribute__((ext_vector_type(2)));
typedef unsigned u32x4 __attribute__((ext_vector_type(4)));
typedef unsigned u32x2 __attribute__((ext_vector_type(2)));
constexpr int BM = 256, BK = 64, HALF = 128, HTB = HALF * BK * 2  , STAGE_BYTES = 8 * HTB, NXCD = 8, WGM = 8;

__host__ __device__ __forceinline__ int lds_byte(int r, int c) { const int st = (r >> 4) * 2 + (c >> 5), rr = r & 15, cc = c & 31, ob = rr * 64 + cc * 2; return st * 1024 + (ob ^ (((ob >> 9) & 1) << 5)); }
__host__ __device__ __forceinline__ void stage_rc(int b, int& R, int& C) { const int st = b / 1024, sb = b % 1024, swz = sb ^ (((sb >> 9) & 1) << 5); R = (st >> 1) * 16 + swz / 64; C = (st & 1) * 32 + (swz % 64) / 2; }
__host__ __device__ __forceinline__ int perm32(int rho) { const int n = rho >> 4, i = rho & 15; return 8 * (i >> 2) + 4 * n + (i & 3); }

struct Unit { int pm, pn, e, row0, cnt, slot0, qm; };
struct Gemm { const void* A; const void* Bt; int K; };
typedef int v8i_t __attribute__((ext_vector_type(8)));
typedef int v4i_t __attribute__((ext_vector_type(4)));

struct StaticOrder {
    int nM, nN, nwg, G, c, K;
    __device__ void init(int M, int N, int K_, int G_, int c_) { nM = M / BM; nN = N / BM; nwg = nM * nN; G = G_; c = c_; K = K_; }
    __device__ bool next(int i, Unit& u) const {
        const long L = (long)i * G + c; if (L >= nwg) return false;
        int wgid = (int)L; { const int q = nwg / NXCD, r = nwg % NXCD, xcd = wgid % NXCD, off = wgid / NXCD; wgid = (xcd < r ? xcd * (q + 1) : r * (q + 1) + (xcd - r) * q) + off; }
        const int nig = WGM * nN, gid = wgid / nig, fm = gid * WGM, gsz = (nM - fm) < WGM ? (nM - fm) : WGM;
        u.pm = fm + ((wgid % nig) % gsz); u.pn = (wgid % nig) / gsz; u.e = 0; u.row0 = 0; u.cnt = BM; u.slot0 = u.pm * BM; u.qm = 15; return true;
    }
    __device__ __forceinline__ int a_row(const Unit& u, int r) const { return u.pm * BM + r; }
    __device__ __forceinline__ size_t b_off(const Unit& u) const { return (size_t)u.pn * BM * K; }
};
#ifndef MOE_QUARTERS
#define MOE_QUARTERS 1
#endif
struct MoeOrder {
    const PG8_LAS int* tab; int G, c, total, K; const int* dest; size_t wstride; bool gather; const PG8_LAS int* rows;
    __device__ bool next(int i, Unit& u) const {
        const int nfr = total / G, rem = total - nfr * G; int L, qm = 15;
        if (i < nfr) L = i * G + c;
        else if (i > nfr || rem == 0) return false;
        else if (MOE_QUARTERS && 4 * rem <= G) { if ((c >> 2) >= rem) return false; L = nfr * G + (c >> 2); qm = 1 << (c & 3); }
        else if (MOE_QUARTERS && 2 * rem <= G) { if ((c >> 1) >= rem) return false; L = nfr * G + (c >> 1); qm = (c & 1) ? 12 : 3; }
        else { L = nfr * G + c; if (L >= total) return false; }
        const int rt = L >> 2; int e = 0;
#pragma unroll
        for (int j = 1; j < 16; ++j) e += (rt >= tab[j]) ? 1 : 0;
        u.e = e; u.row0 = (rt - tab[e]) * BM; u.cnt = tab[34 + e]; u.slot0 = tab[17 + e] + u.row0; u.pm = i  ; u.pn = L & 3; u.qm = qm;
        if (qm != 15) { const int q0 = (qm & 3) ? ((qm & 1) ? 0 : 64) : ((qm & 4) ? 128 : 192); if (u.row0 + q0 >= u.cnt) return false; }
        return true;
    }
    __device__ __forceinline__ int a_row(const Unit& u, int r) const {
        if (!gather) return u.slot0 + r;
        return rows[(u.pm & 7) * BM + r];
    }
    __device__ __forceinline__ void fill_rows(PG8_LAS int* rows_w) const {
        for (int q = threadIdx.x; q < 8 * BM; q += 512) { Unit u; int v = 0;
            if (next(q >> 8, u)) { const int idx = u.row0 + (q & 255); v = idx < u.cnt ? (dest[u.e * 32768 + idx] >> 1) : 0; }
            rows_w[q] = v; }
        __syncthreads();
    }
    __device__ __forceinline__ void fill_dest(PG8_LAS int* dg_w, const float* gate) const {
        for (int q = threadIdx.x; q < 5 * BM; q += 512) { Unit u; int d = -1, gb = 0;
            if (next(q >> 8, u)) { const int idx = u.row0 + (q & 255); if (idx < u.cnt) { d = dest[u.e * 32768 + idx]; gb = __float_as_int(gate[u.e * 32768 + idx]); } }
            dg_w[2 * q] = d; dg_w[2 * q + 1] = gb; }
        __syncthreads();
    }
    __device__ __forceinline__ size_t b_off(const Unit& u) const { return (size_t)u.e * wstride + (size_t)u.pn * BM * K; }
};

__device__ __forceinline__ unsigned cvt_pk_bf16(float lo, float hi) { unsigned r; asm volatile("v_cvt_pk_bf16_f32 %0, %1, %2" : "=v"(r) : "v"(lo), "v"(hi)); return r; }
__device__ __forceinline__ float bf_lo(unsigned u) { return __uint_as_float(u << 16); }
__device__ __forceinline__ float bf_hi(unsigned u) { return __uint_as_float(u & 0xffff0000u); }
__device__ __forceinline__ float sigmoidf_(float x) { return __builtin_amdgcn_rcpf(1.0f + __expf(-x)); }
__device__ __forceinline__ unsigned cvt_pk_f16(float lo, float hi) { typedef __fp16 h2 __attribute__((ext_vector_type(2))); h2 v = __builtin_amdgcn_cvt_pkrtz(lo, hi); return __builtin_bit_cast(unsigned, v); }

#ifndef EPI_NT
#define EPI_NT 0
#endif
template <class V> __device__ __forceinline__ void epi_st(V* p, const V v) {
    if (EPI_NT == 1) __builtin_nontemporal_store(v, p);
    else if (EPI_NT == 2) { if constexpr (sizeof(V) == 16) asm volatile("global_store_dwordx4 %0, %1, off sc1\n\ts_nop 0" :: "v"(p), "v"(v) : "memory"); else asm volatile("global_store_dwordx2 %0, %1, off sc1\n\ts_nop 0" :: "v"(p), "v"(v) : "memory"); }
    else if (EPI_NT == 3) { if constexpr (sizeof(V) == 16) asm volatile("global_store_dwordx4 %0, %1, off sc0 sc1\n\ts_nop 0" :: "v"(p), "v"(v) : "memory"); else asm volatile("global_store_dwordx2 %0, %1, off sc0 sc1\n\ts_nop 0" :: "v"(p), "v"(v) : "memory"); }
    else *p = v; }
struct EpiBf16 {
    static constexpr int NST = 16; static constexpr bool PERM = true;
    bf16_t* O; int ldc; int split_cols; size_t split_stride; float scale0;
    __device__ __forceinline__ void operator()(const f32x4 (&acc)[2][2][4][2], const Unit& u, int wr, int wc, int fr, int fq) const {
        const int row0 = u.pm * BM + wr * 64 + fr; int colt = u.pn * BM; bf16_t* base = O;
        float sc = 1.f; if (split_cols) { const int t = colt / split_cols; base += (size_t)t * split_stride; colt -= t * split_cols; if (t == 0) sc = scale0; }
        const int col0 = colt + wc * 32 + 8 * fq;
#pragma unroll
        for (int ai = 0; ai < 2; ++ai)
#pragma unroll
            for (int m = 0; m < 4; ++m) { bf16_t* rowp = base + (size_t)(row0 + ai * HALF + m * 16) * ldc + col0;
#pragma unroll
                for (int bj = 0; bj < 2; ++bj) { const f32x4 v0 = acc[ai][bj][m][0] * sc, v1 = acc[ai][bj][m][1] * sc;
                    u32x4 w; w.x = cvt_pk_bf16(v0[0], v0[1]); w.y = cvt_pk_bf16(v0[2], v0[3]); w.z = cvt_pk_bf16(v1[0], v1[1]); w.w = cvt_pk_bf16(v1[2], v1[3]);
                    epi_st((u32x4*)(rowp + bj * HALF), w); } }
    }
};
struct EpiProj {
    static constexpr int NST = 16; static constexpr bool PERM = true;
    bf16_t *Q, *LF, *V, *G; const float* lb; int gmap;
    __device__ __forceinline__ void operator()(const f32x4 (&acc)[2][2][4][2], const Unit& u, int wr, int wc, int fr, int fq) const {
        const int grp = (gmap >> (4 * (u.pn >> 2))) & 15, row0 = u.pm * BM + wr * 64 + fr, col0 = (u.pn & 3) * BM + wc * 32 + 8 * fq;
        bf16_t* base = grp == 0 ? Q : grp == 1 ? LF : grp == 2 ? V : G;
        f32x4 lbv[2][2];
#pragma unroll
        for (int bj = 0; bj < 2; ++bj)
#pragma unroll
            for (int n = 0; n < 2; ++n) lbv[bj][n] = *(const f32x4*)(lb + col0 + bj * HALF + 4 * n);
#pragma unroll
        for (int ai = 0; ai < 2; ++ai)
#pragma unroll
            for (int m = 0; m < 4; ++m) { bf16_t* rowp = base + (size_t)(row0 + ai * HALF + m * 16) * 1024 + col0;
#pragma unroll
                for (int bj = 0; bj < 2; ++bj) { f32x4 v[2] = {acc[ai][bj][m][0], acc[ai][bj][m][1]}; u32x4 w;
                    if (grp == 1) {
#pragma unroll
                        for (int n = 0; n < 2; ++n)
#pragma unroll
                            for (int j = 0; j < 4; ++j) { const float l = lbv[bj][n][j]; v[n][j] = l + (1.0f - l) * sigmoidf_(v[n][j]); }
                        w.x = cvt_pk_f16(v[0][0], v[0][1]); w.y = cvt_pk_f16(v[0][2], v[0][3]); w.z = cvt_pk_f16(v[1][0], v[1][1]); w.w = cvt_pk_f16(v[1][2], v[1][3]);
                    } else {
                        w.x = cvt_pk_bf16(v[0][0], v[0][1]); w.y = cvt_pk_bf16(v[0][2], v[0][3]); w.z = cvt_pk_bf16(v[1][0], v[1][1]); w.w = cvt_pk_bf16(v[1][2], v[1][3]);
                    }
                    epi_st((u32x4*)(rowp + bj * HALF), w); } }
    }
};
template <bool RES_BF16, bool OUT_BF16 = false> struct EpiResid {
    static constexpr int NST = 8; static constexpr bool PERM = false;
    const void* res; float* R; float alpha;
    __device__ __forceinline__ void operator()(const f32x4 (&acc)[2][2][4][2], const Unit& u, int wr, int wc, int fr, int fq) const {
        const int row0 = u.pm * BM + wr * 64 + fr, col0 = u.pn * BM + wc * 32 + 4 * fq;
#pragma unroll
        for (int ai = 0; ai < 2; ++ai)
#pragma unroll
          for (int mp = 0; mp < 2; ++mp) {
            f32x4 rv[2][2][2];
#pragma unroll
            for (int mm = 0; mm < 2; ++mm) { const size_t off = (size_t)(row0 + ai * HALF + (2 * mp + mm) * 16) * 1024 + col0;
#pragma unroll
                for (int bj = 0; bj < 2; ++bj)
#pragma unroll
                    for (int n = 0; n < 2; ++n) { const size_t o = off + bj * HALF + n * 16;
                        if (RES_BF16) { const u32x2 p = *(const u32x2*)((const bf16_t*)res + o); rv[mm][bj][n] = (f32x4){bf_lo(p.x), bf_hi(p.x), bf_lo(p.y), bf_hi(p.y)}; }
                        else rv[mm][bj][n] = *(const f32x4*)((const float*)res + o); } }
            asm volatile("" ::: "memory");
#pragma unroll
            for (int mm = 0; mm < 2; ++mm) { const int m = 2 * mp + mm; const size_t off = (size_t)(row0 + ai * HALF + m * 16) * 1024 + col0;
#pragma unroll
                for (int bj = 0; bj < 2; ++bj)
#pragma unroll
                    for (int n = 0; n < 2; ++n) { const size_t o = off + bj * HALF + n * 16;
                        const f32x4 ov = rv[mm][bj][n] * alpha + acc[ai][bj][m][n];
                        if (OUT_BF16) *(u32x2*)((bf16_t*)R + o) = (u32x2){cvt_pk_bf16(ov[0], ov[1]), cvt_pk_bf16(ov[2], ov[3])}; else *(f32x4*)(R + o) = ov; } }
            asm volatile("" ::: "memory"); }
    }
};
struct EpiGateUp {
    static constexpr int NST = 8; static constexpr bool PERM = true;
    bf16_t* H;
    __device__ __forceinline__ void operator()(const f32x4 (&acc)[2][2][4][2], const Unit& u, int wr, int wc, int fr, int fq) const {
        const int row0 = u.slot0 + wr * 64 + fr, col0 = u.pn * HALF + wc * 32 + 8 * fq;
#pragma unroll
        for (int ai = 0; ai < 2; ++ai)
#pragma unroll
            for (int m = 0; m < 4; ++m) { f32x4 h[2];
#pragma unroll
                for (int n = 0; n < 2; ++n)
#pragma unroll
                    for (int j = 0; j < 4; ++j) { const float g = acc[ai][0][m][n][j]; h[n][j] = g * sigmoidf_(g) * acc[ai][1][m][n][j]; }
                u32x4 w; w.x = cvt_pk_bf16(h[0][0], h[0][1]); w.y = cvt_pk_bf16(h[0][2], h[0][3]); w.z = cvt_pk_bf16(h[1][0], h[1][1]); w.w = cvt_pk_bf16(h[1][2], h[1][3]);
                *(u32x4*)(H + (size_t)(row0 + ai * HALF + m * 16) * 512 + col0) = w; }
    }
};
struct EpiGateUp8 {
    static constexpr int NST = 8; static constexpr bool PERM = true;
    unsigned char* H;
    __device__ __forceinline__ void operator()(const f32x4 (&acc)[2][2][4][2], const Unit& u, int wr, int wc, int fr, int fq) const {
        const int row0 = u.slot0 + wr * 64 + fr, col0 = u.pn * HALF + wc * 32 + 8 * fq;
#pragma unroll
        for (int ai = 0; ai < 2; ++ai) { if (!((u.qm >> (2 * ai + wr)) & 1)) continue;
#pragma unroll
            for (int m = 0; m < 4; ++m) { f32x4 h[2];
#pragma unroll
                for (int n = 0; n < 2; ++n)
#pragma unroll
                    for (int j = 0; j < 4; ++j) { const float g = acc[ai][0][m][n][j]; h[n][j] = g * sigmoidf_(g) * acc[ai][1][m][n][j]; }
                int w0 = 0, w1 = 0;
                w0 = __builtin_amdgcn_cvt_pk_fp8_f32(h[0][0], h[0][1], w0, false); w0 = __builtin_amdgcn_cvt_pk_fp8_f32(h[0][2], h[0][3], w0, true);
                w1 = __builtin_amdgcn_cvt_pk_fp8_f32(h[1][0], h[1][1], w1, false); w1 = __builtin_amdgcn_cvt_pk_fp8_f32(h[1][2], h[1][3], w1, true);
                epi_st((u32x2*)(H + (size_t)(row0 + ai * HALF + m * 16) * 512 + col0), (u32x2){(unsigned)w0, (unsigned)w1}); } }
    }
};
template <bool OUT8 = false> struct EpiDown {
    static constexpr int NST = 0; static constexpr bool PERM = true;
    bf16_t* Y2; const int* dest; const float* gate; const PG8_LAS int* dg;
    __device__ __forceinline__ void operator()(const f32x4 (&acc)[2][2][4][2], const Unit& u, int wr, int wc, int fr, int fq) const {
        const int col0 = u.pn * BM + wc * 32 + 8 * fq;
        int dd[2][4]; float gg[2][4];
#pragma unroll
        for (int ai = 0; ai < 2; ++ai)
#pragma unroll
            for (int m = 0; m < 4; ++m) { const int tr = ai * HALF + wr * 64 + m * 16 + fr, idx = u.row0 + tr; const bool ok = idx < u.cnt;
                if (!((u.qm >> (2 * ai + wr)) & 1)) { dd[ai][m] = -1; gg[ai][m] = 0.f; continue; }
                if (dg) { const u32x2 t = *(const PG8_LAS u32x2*)(dg + 2 * ((u.pm % 5) * BM + tr)); dd[ai][m] = (int)t.x; gg[ai][m] = __uint_as_float(t.y); }
                else { dd[ai][m] = ok ? dest[u.e * 32768 + idx] : -1; gg[ai][m] = ok ? gate[u.e * 32768 + idx] : 0.f; } }
        asm volatile("" ::: "memory");
#pragma unroll
        for (int ai = 0; ai < 2; ++ai)
#pragma unroll
            for (int m = 0; m < 4; ++m) { const int d = dd[ai][m];
                if (d >= 0) { const float gt = gg[ai][m]; bf16_t* rowp = Y2 + (size_t)d * 1024 + col0;
#pragma unroll
                    for (int bj = 0; bj < 2; ++bj) { const f32x4 v0 = acc[ai][bj][m][0] * gt, v1 = acc[ai][bj][m][1] * gt;
                        if (OUT8) { int w0 = 0, w1 = 0; w0 = __builtin_amdgcn_cvt_pk_fp8_f32(v0[0], v0[1], w0, false); w0 = __builtin_amdgcn_cvt_pk_fp8_f32(v0[2], v0[3], w0, true);
                            w1 = __builtin_amdgcn_cvt_pk_fp8_f32(v1[0], v1[1], w1, false); w1 = __builtin_amdgcn_cvt_pk_fp8_f32(v1[2], v1[3], w1, true);
                            *(u32x2*)((unsigned char*)Y2 + (size_t)d * 1024 + col0 + bj * HALF) = (u32x2){(unsigned)w0, (unsigned)w1}; continue; }
                        u32x4 w; w.x = cvt_pk_bf16(v0[0], v0[1]); w.y = cvt_pk_bf16(v0[2], v0[3]); w.z = cvt_pk_bf16(v1[0], v1[1]); w.w = cvt_pk_bf16(v1[2], v1[3]);
                        *(u32x4*)(rowp + bj * HALF) = w; } } }
    }
};

#ifndef RELAX_EPI
#define RELAX_EPI 0
#endif
template <class Epi, class Sched, bool ALIGN_EPI, bool F8 = false, int KREP = 1, bool QSKIP = false>
__device__ __forceinline__ void gemm_phase(PG8_LAS unsigned char* lds, const Gemm g, const Sched& S, const Epi& E) {
    const int tid = threadIdx.x, wid = __builtin_amdgcn_readfirstlane(tid >> 6), lane = tid & 63, wr = wid >> 2, wc = wid & 3, fr = lane & 15, fq = lane >> 4;
    const int K = g.K, PB = F8 ? K : 2 * K  , nt = PB / 128;
    int sR[2]; unsigned sC2[2], voffB[2];
#pragma unroll
    for (int i = 0; i < 2; ++i) { int R, C; stage_rc(tid * 16 + i * 8192, R, C); const int Rb = Epi::PERM ? ((R & ~31) + perm32(R & 31)) : R;
        sR[i] = R; sC2[i] = (unsigned)C * 2u; voffB[i] = (unsigned)(Rb * PB) + (unsigned)C * 2u; }
#define PG8_MKA(dst, u) do { _Pragma("unroll") for (int _h = 0; _h < 2; ++_h) _Pragma("unroll") for (int _i = 0; _i < 2; ++_i) \
        dst[_h][_i] = (unsigned)S.a_row(u, sR[_i] + HALF * _h) * (unsigned)PB + sC2[_i]; } while (0)
    const size_t kstep = (size_t)(BK * 2);
    const size_t hstep = (size_t)HALF * PB;
    const unsigned ldsw = (unsigned)wid * 1024u;
    const int aoff = lds_byte(wr * 64 + fr, fq * 8), boff = lds_byte(wc * 32 + fr, fq * 8);
#define PG8_SA(b, h) (((b) * 2 + (h)) * HTB)
#define PG8_SB(b, h) ((4 + (b) * 2 + (h)) * HTB)
#define PG8_STAGE(bufoff, gbase, voff) do { _Pragma("unroll") for (int _i = 0; _i < 2; ++_i) \
        __builtin_amdgcn_global_load_lds((const unsigned*)((const char*)(gbase) + (voff)[_i]), (PG8_LAS unsigned*)(lds + (bufoff) + ldsw + _i * 8192), 16, 0, 0); } while (0)
#define PG8_LDA(dst, b, h) do { _Pragma("unroll") for (int m = 0; m < 4; ++m) { if constexpr (F8) { dst##8[m].lo = *(const PG8_LAS v4i_t*)(lds + PG8_SA(b, h) + aoff + m * 2048); dst##8[m].hi = *(const PG8_LAS v4i_t*)(lds + PG8_SA(b, h) + aoff + m * 2048 + 1024); } \
        else { _Pragma("unroll") for (int k = 0; k < 2; ++k) dst[m][k] = *(const PG8_LAS bf16x8*)(lds + PG8_SA(b, h) + aoff + m * 2048 + k * 1024); } } } while (0)
#define PG8_LDB(dst, b, h) do { _Pragma("unroll") for (int n = 0; n < 2; ++n) { if constexpr (F8) { dst##8[n].lo = *(const PG8_LAS v4i_t*)(lds + PG8_SB(b, h) + boff + n * 2048); dst##8[n].hi = *(const PG8_LAS v4i_t*)(lds + PG8_SB(b, h) + boff + n * 2048 + 1024); } \
        else { _Pragma("unroll") for (int k = 0; k < 2; ++k) dst[n][k] = *(const PG8_LAS bf16x8*)(lds + PG8_SB(b, h) + boff + n * 2048 + k * 1024); } } } while (0)
#define PG8_MMA(ai, bj, At, Bt) do { __builtin_amdgcn_s_setprio(1); _Pragma("unroll") for (int m = 0; m < 4; ++m) _Pragma("unroll") for (int n = 0; n < 2; ++n) { \
        if constexpr (F8) asm volatile("v_mfma_scale_f32_16x16x128_f8f6f4 %0, %1, %2, %0, %3, %4 op_sel_hi:[0,0,0]" : "+v"(acc[ai][bj][m][n]) : "v"(Bt##8[n]), "v"(At##8[m]), "v"(sc_w), "v"(sc_a)); \
        else { _Pragma("unroll") for (int k = 0; k < 2; ++k) acc[ai][bj][m][n] = __builtin_amdgcn_mfma_f32_16x16x32_bf16(Bt[n][k], At[m][k], acc[ai][bj][m][n], 0, 0, 0); } } __builtin_amdgcn_s_setprio(0); } while (0)
#define PG8_WAIT_V(n) asm volatile("s_waitcnt vmcnt(" #n ")" ::: "memory")
#define PG8_WAIT_L(n) asm volatile("s_waitcnt lgkmcnt(" #n ")" ::: "memory")
#define PG8_WAIT_VF do { if constexpr (RELAX_EPI && Epi::NST > 0) asm volatile("s_cmp_lg_u32 %0, 0\n\ts_cbranch_scc1 1f\n\ts_waitcnt vmcnt(8)\n\ts_branch 2f\n1:\ts_waitcnt vmcnt(%1)\n2:" :: "s"(fresh), "n"(8 + Epi::NST) : "scc", "memory"); else PG8_WAIT_V(8); } while (0)
#define PG8_BAR __builtin_amdgcn_s_barrier()
#define PG8_SCHED __builtin_amdgcn_sched_barrier(0)
    Unit cur, nxt; int ui = 0;
    if (!S.next(0, cur)) return;
    int qa0 = 1, qa1 = 1;
#define PG8_QSET(u) do { if constexpr (QSKIP) { const int q_ = __builtin_amdgcn_readfirstlane((u).qm); qa0 = (q_ >> wr) & 1; qa1 = (q_ >> (2 + wr)) & 1; } } while (0)
    PG8_QSET(cur);
    f32x4 acc[2][2][4][2];
#pragma unroll
    for (int a = 0; a < 2; ++a)
#pragma unroll
        for (int b = 0; b < 2; ++b)
#pragma unroll
            for (int m = 0; m < 4; ++m)
#pragma unroll
                for (int n = 0; n < 2; ++n) acc[a][b][m][n] = (f32x4){0.f, 0.f, 0.f, 0.f};
    bf16x8 At[4][2], B0[2][2], B1[2][2];
    v8i_t At8[4], B08[2], B18[2];
    const int sc_w = 0x79797979, sc_a = 0x7F7F7F7F;
    unsigned cVA[2][2], nVA[2][2];
    PG8_MKA(cVA, cur);
    const char* const gA = (const char*)g.A;
    const char* cB = (const char*)g.Bt + S.b_off(cur) * (F8 ? 1 : 2);
    PG8_STAGE(PG8_SB(0, 0), cB, voffB); PG8_STAGE(PG8_SB(0, 1), cB + hstep, voffB); PG8_STAGE(PG8_SA(0, 0), gA, cVA[0]); PG8_STAGE(PG8_SA(0, 1), gA, cVA[1]);
    if (wr == 1) PG8_BAR;
    PG8_WAIT_V(2); PG8_BAR;
    PG8_STAGE(PG8_SB(1, 0), cB + kstep, voffB); PG8_STAGE(PG8_SA(1, 0), gA + kstep, cVA[0]); PG8_STAGE(PG8_SB(1, 1), cB + hstep + kstep, voffB);
    PG8_WAIT_V(6); PG8_BAR;
    for (;;) {
        const bool has_next = S.next(ui + 1, nxt);
        const char* nB = cB;
        if (has_next) { PG8_MKA(nVA, nxt); nB = (const char*)g.Bt + S.b_off(nxt) * (F8 ? 1 : 2); }
        else {
#pragma unroll
            for (int _h = 0; _h < 2; ++_h)
#pragma unroll
                for (int _i = 0; _i < 2; ++_i) nVA[_h][_i] = cVA[_h][_i]; }
        for (int tt = 0; tt < nt * KREP; tt += 2) {
            const int t = KREP > 1 ? tt % nt : tt, t2 = KREP > 1 ? (tt + 2) % nt : tt + 2;
            const bool last = (tt == nt * KREP - 2); const int fresh = __builtin_amdgcn_readfirstlane((RELAX_EPI && Epi::NST > 0 && (tt == 0) && (ui > 0)) ? 1 : 0);
            const char* a1 = gA + (size_t)(t + 1) * kstep;
            const char* a2 = last ? gA : gA + (size_t)t2 * kstep; const char* b2 = last ? nB : cB + (size_t)t2 * kstep;
            const char* a3 = a2 + kstep; const char* b3 = b2 + kstep;
            unsigned xA0[2], xA1[2];
#pragma unroll
            for (int _i = 0; _i < 2; ++_i) { xA0[_i] = last ? nVA[0][_i] : cVA[0][_i]; xA1[_i] = last ? nVA[1][_i] : cVA[1][_i]; }
            PG8_LDB(B0, 0, 0); PG8_LDB(B1, 0, 1); PG8_SCHED; PG8_LDA(At, 0, 0); PG8_STAGE(PG8_SA(1, 1), a1, cVA[1]);
            PG8_WAIT_VF;
            PG8_WAIT_L(0); PG8_BAR; if (!QSKIP || qa0) { PG8_MMA(0, 0, At, B0); PG8_MMA(0, 1, At, B1); } PG8_BAR; PG8_SCHED;
            PG8_LDA(At, 0, 1); PG8_STAGE(PG8_SB(0, 0), b2, voffB); PG8_STAGE(PG8_SB(0, 1), b2 + hstep, voffB); PG8_STAGE(PG8_SA(0, 0), a2, xA0);
            PG8_WAIT_VF;
            PG8_WAIT_L(0); PG8_BAR; if (!QSKIP || qa1) { PG8_MMA(1, 0, At, B0); PG8_MMA(1, 1, At, B1); } PG8_BAR; PG8_SCHED;
            PG8_LDB(B0, 1, 0); PG8_LDB(B1, 1, 1); PG8_SCHED; PG8_LDA(At, 1, 0); PG8_STAGE(PG8_SA(0, 1), a2, xA1);
            PG8_WAIT_V(8); PG8_WAIT_L(0); PG8_BAR; if (!QSKIP || qa0) { PG8_MMA(0, 0, At, B0); PG8_MMA(0, 1, At, B1); } PG8_BAR; PG8_SCHED;
            PG8_LDA(At, 1, 1); PG8_STAGE(PG8_SB(1, 0), b3, voffB); PG8_STAGE(PG8_SB(1, 1), b3 + hstep, voffB); PG8_STAGE(PG8_SA(1, 0), a3, xA0);
            PG8_WAIT_V(8); PG8_WAIT_L(0); PG8_BAR; if (!QSKIP || qa1) { PG8_MMA(1, 0, At, B0); PG8_MMA(1, 1, At, B1); } PG8_BAR; PG8_SCHED;
        }
        if constexpr (ALIGN_EPI) { if (wr == 0) PG8_BAR; }
        if constexpr (F8) asm volatile("s_nop 15\n\ts_nop 15" ::: "memory");
        if constexpr (KREP > 1) {
#pragma unroll
            for (int a = 0; a < 2; ++a)
#pragma unroll
                for (int b = 0; b < 2; ++b)
#pragma unroll
                    for (int m = 0; m < 4; ++m)
#pragma unroll
                        for (int n = 0; n < 2; ++n) acc[a][b][m][n] = acc[a][b][m][n] * (1.0f / KREP); }
        E(acc, cur, wr, wc, fr, fq);
#ifdef PROBE_EPIREP
        if constexpr (KREP == 3) { asm volatile("" ::: "memory"); E(acc, cur, wr, wc, fr, fq); }
#endif
        if (!has_next) break;
#pragma unroll
        for (int a = 0; a < 2; ++a)
#pragma unroll
            for (int b = 0; b < 2; ++b)
#pragma unroll
                for (int m = 0; m < 4; ++m)
#pragma unroll
                    for (int n = 0; n < 2; ++n) acc[a][b][m][n] = (f32x4){0.f, 0.f, 0.f, 0.f};
        cur = nxt; cB = nB; ++ui; PG8_QSET(cur);
#pragma unroll
        for (int _h = 0; _h < 2; ++_h)
#pragma unroll
            for (int _i = 0; _i < 2; ++_i) cVA[_h][_i] = nVA[_h][_i];
        if constexpr (ALIGN_EPI) { if (wr == 1) PG8_BAR; }
    }
    PG8_WAIT_V(0);
    if constexpr (!ALIGN_EPI) { if (wr == 0) PG8_BAR; }
    PG8_BAR;
#undef PG8_MKA
#undef PG8_SA
#undef PG8_SB
#undef PG8_STAGE
#undef PG8_LDA
#undef PG8_LDB
#undef PG8_MMA
#undef PG8_WAIT_V
#undef PG8_WAIT_L
#undef PG8_BAR
#undef PG8_SCHED
}
}
#include <hip/hip_bf16.h>
#include <cmath>
namespace attn_body {
using bf16=__hip_bfloat16;
using bf16x8=__attribute__((ext_vector_type(8)))short;
using s16x4=__attribute__((ext_vector_type(4)))short;
using f32x16=__attribute__((ext_vector_type(16)))float;
using u32x4=__attribute__((ext_vector_type(4)))unsigned;
constexpr int SEQ=4096,D=64,DM=1024;
constexpr int NW=8,QBLK=32,QB=QBLK*NW,KVBLK=64,NQB=SEQ/QB;
constexpr int ATTN_PITCH=DM, ATTN_UNIT_ROWS=QB;
__device__ __forceinline__ int crow(int r,int hi){return (r&3)+8*(r>>2)+4*hi;}
#define SBAR() __builtin_amdgcn_sched_barrier(0)
__device__ __forceinline__ void cmask(f32x16&p0,f32x16&p1,int jb,int qrel,int hi){
  const float NEG=-INFINITY; const int dd=qrel-(64*jb+4*hi);
  #pragma unroll
  for(int r=0;r<16;++r){const int cc=(r&3)+8*(r>>2); if(cc>dd)p0[r]=NEG; if(cc+32>dd)p1[r]=NEG;}
}

constexpr int NSLOT=3, SLOTB=8192;
constexpr int LDS_K=0, LDS_V=NSLOT*SLOTB, LDS_WS=3*NSLOT*SLOTB  , LDS_OST=LDS_WS+NW*64*4, LDS_BYTES=LDS_OST+NW*8192  ;
constexpr float C2=0.125f*1.4426950408889634f;
__device__ __forceinline__ void glds16(const void*gsrc,unsigned lds_dst){unsigned keep;
  asm volatile("s_mov_b32 %0, m0\n\ts_mov_b32 m0, %2\n\ts_nop 0\n\tglobal_load_lds_dwordx4 %1, off\n\ts_mov_b32 m0, %0":"=&s"(keep):"v"(gsrc),"s"(lds_dst):"memory");}
template<int OFF> __device__ __forceinline__ void glds16s(const void*sbase,unsigned voff,unsigned lds_dst){unsigned keep;
  asm volatile("s_nop 4\n\ts_mov_b32 %0, m0\n\ts_mov_b32 m0, %2\n\ts_nop 0\n\tglobal_load_lds_dwordx4 %1, %3 offset:%c4\n\ts_mov_b32 m0, %0":"=&s"(keep):"v"(voff),"s"(lds_dst),"s"(sbase),"i"(OFF):"memory");}
__device__ __forceinline__ const void* uptr(const void*p){ const unsigned long long u=(unsigned long long)p; const unsigned lo=__builtin_amdgcn_readfirstlane((unsigned)u),hi=__builtin_amdgcn_readfirstlane((unsigned)(u>>32)); return (const void*)(((unsigned long long)hi<<32)|lo); }
__device__ __forceinline__ float max3f(float a,float b,float c){float r;asm("v_max3_f32 %0, %1, %2, %3":"=v"(r):"v"(a),"v"(b),"v"(c));return r;}
__device__ __forceinline__ float max2f(float a,float b){float r;asm("v_max_f32_e32 %0, %1, %2":"=v"(r):"v"(a),"v"(b));return r;}
__device__ __forceinline__ float fadd_s(float a,float b){float r;asm("v_add_f32_e32 %0, %1, %2":"=v"(r):"v"(a),"v"(b));return r;}
__device__ __forceinline__ float fsub_s(float a,float b){float r;asm("v_sub_f32_e32 %0, %1, %2":"=v"(r):"v"(a),"v"(b));return r;}
typedef float f32x2_t __attribute__((ext_vector_type(2))); typedef __bf16 bf16x2_t __attribute__((ext_vector_type(2)));
__device__ __forceinline__ unsigned cvtpk_s(float lo,float hi){f32x2_t v={lo,hi};bf16x2_t b=__builtin_convertvector(v,bf16x2_t);return __builtin_bit_cast(unsigned,b);}
#define WAIT_BAR(N) asm volatile("s_waitcnt vmcnt(" #N ") lgkmcnt(0)\n\ts_barrier":::"memory")

__device__ __forceinline__ void qkt(f32x16&p0,f32x16&p1,const char*Kslot,const bf16x8*qr,const f32x16&negm,int r32,int hi){
  const char*kb=Kslot+hi*1024+r32*16;
  #pragma unroll
  for(int d0=0;d0<4;++d0){
    const bf16x8 b0=*reinterpret_cast<const bf16x8*>(kb+d0*2048);
    const bf16x8 b1=*reinterpret_cast<const bf16x8*>(kb+d0*2048+512);
    if(d0==0){p0=__builtin_amdgcn_mfma_f32_32x32x16_bf16(b0,qr[0],negm,0,0,0);p1=__builtin_amdgcn_mfma_f32_32x32x16_bf16(b1,qr[0],negm,0,0,0);}
    else{p0=__builtin_amdgcn_mfma_f32_32x32x16_bf16(b0,qr[d0],p0,0,0,0);p1=__builtin_amdgcn_mfma_f32_32x32x16_bf16(b1,qr[d0],p1,0,0,0);}}
}
typedef __attribute__((address_space(3))) const char* lds_cptr;
typedef short v4i16_t __attribute__((ext_vector_type(4)));
__device__ __forceinline__ void kload8(bf16x8*kf,lds_cptr kp){
  kf[0]=*(const __attribute__((address_space(3))) bf16x8*)(kp);      kf[1]=*(const __attribute__((address_space(3))) bf16x8*)(kp+512);
  kf[2]=*(const __attribute__((address_space(3))) bf16x8*)(kp+2048); kf[3]=*(const __attribute__((address_space(3))) bf16x8*)(kp+2560);
  kf[4]=*(const __attribute__((address_space(3))) bf16x8*)(kp+4096); kf[5]=*(const __attribute__((address_space(3))) bf16x8*)(kp+4608);
  kf[6]=*(const __attribute__((address_space(3))) bf16x8*)(kp+6144); kf[7]=*(const __attribute__((address_space(3))) bf16x8*)(kp+6656);
}
__device__ __forceinline__ void kload2(bf16x8*kf,lds_cptr kp,int j){ kf[2*j]=*(const __attribute__((address_space(3))) bf16x8*)(kp+j*2048); kf[2*j+1]=*(const __attribute__((address_space(3))) bf16x8*)(kp+j*2048+512); }
__device__ __forceinline__ s16x4 vtr(lds_cptr p){ return __builtin_bit_cast(s16x4,__builtin_amdgcn_ds_read_tr16_b64_v4i16((__attribute__((address_space(3))) v4i16_t*)p)); }
__device__ __forceinline__ float rowmax(const f32x16&p0,const f32x16&p1){
  float a=max3f(p0[0],p0[1],p1[0]),b=max3f(p0[2],p0[3],p1[1]);a=max3f(a,p1[2],p1[3]);
  #pragma unroll
  for(int r=4;r<16;r+=4){a=max3f(a,p0[r],p0[r+1]);b=max3f(b,p0[r+2],p0[r+3]);a=max3f(a,p1[r],p1[r+1]);b=max3f(b,p1[r+2],p1[r+3]);}
  const float m=max2f(a,b);
  auto rr=__builtin_amdgcn_permlane32_swap(__float_as_uint(m),__float_as_uint(m),false,false);
  return max2f(__uint_as_float(rr[0]),__uint_as_float(rr[1]));
}
__device__ __forceinline__ void pv(f32x16*o,int vb,bf16x8 pa0,bf16x8 pa1,bf16x8 pa2,bf16x8 pa3){
  #pragma unroll
  for(int d0=0;d0<4;++d0){s16x4 lo[4],hi[4];
    #pragma unroll
    for(int ks=0;ks<4;++ks){
      asm volatile("ds_read_b64_tr_b16 %0,%1 offset:%c2":"=&v"(lo[ks]):"v"(vb),"i"(d0*4096+ks*1024):"memory");
      asm volatile("ds_read_b64_tr_b16 %0,%1 offset:%c2":"=&v"(hi[ks]):"v"(vb),"i"(d0*4096+ks*1024+512):"memory");}
    asm volatile("s_waitcnt lgkmcnt(0)":::"memory");SBAR();
    #define PK(k) (bf16x8){lo[k][0],lo[k][1],lo[k][2],lo[k][3],hi[k][0],hi[k][1],hi[k][2],hi[k][3]}
    o[d0]=__builtin_amdgcn_mfma_f32_32x32x16_bf16(pa0,PK(0),o[d0],0,0,0);
    o[d0]=__builtin_amdgcn_mfma_f32_32x32x16_bf16(pa1,PK(1),o[d0],0,0,0);
    o[d0]=__builtin_amdgcn_mfma_f32_32x32x16_bf16(pa2,PK(2),o[d0],0,0,0);
    o[d0]=__builtin_amdgcn_mfma_f32_32x32x16_bf16(pa3,PK(3),o[d0],0,0,0);
    #undef PK
  }
}

#ifndef ATTN_OUT_FP8
#define ATTN_OUT_FP8 1
#endif
#ifndef ATTN_STORE16
#define ATTN_STORE16(p,v) (*(u32x4*)(p)=(v))
#endif
template<int THRL> __device__ __forceinline__ void attn_unit(int qb,int cmode,float lam,const float*gsub,const bf16*Qh,const bf16*__restrict__ Kh,const bf16*__restrict__ Vh,bf16*Oh,char*shm){
  const int tid=threadIdx.x,lane=tid&63,r32=lane&31,hi=lane>>5; const int wid=__builtin_amdgcn_readfirstlane(tid>>6);
  const int q0=qb*QB;
  const bf16*Qw=Qh+(long)(q0+wid*QBLK)*DM;
  const unsigned lds0=(unsigned)(uintptr_t)shm;
  float*wsf=(float*)(shm+LDS_WS)+wid*64;
  const unsigned kvo=(unsigned)(lane*DM+wid*8)*2u;
  const unsigned vvo=(unsigned)((16*(wid&3)+(lane>>2))*DM+(wid>>2)*32+(lane&3)*8)*2u;
  const unsigned kdst=lds0+LDS_K+wid*1024, vdst=lds0+LDS_V+wid*1024;
  #define DMA_K(t,slot) glds16s<0>(uptr(Kh+(long)(t)*KVBLK*DM),kvo,(unsigned)__builtin_amdgcn_readfirstlane(kdst+(slot)))
  #define DMA_V(t,slot) do{ const void*vb_=uptr(Vh+(long)(t)*KVBLK*DM); glds16s<0>(vb_,vvo,(unsigned)__builtin_amdgcn_readfirstlane(vdst+2*(slot))); glds16s<128>(vb_,vvo,(unsigned)__builtin_amdgcn_readfirstlane(vdst+2*(slot)+8192-128)); }while(0)
  const char*Kbase=shm+LDS_K; bf16x8 kf[8];
  const lds_cptr shm3=(lds_cptr)shm; const lds_cptr kp0=shm3+LDS_K+hi*1024+r32*16; const lds_cptr vp0=shm3+LDS_V+((lane>>4)&1)*32+(lane&3)*8+(4*hi+((lane&15)>>2))*64;
  const int NT=(q0+QB)/KVBLK;
  DMA_K(0,0);DMA_V(0,0);DMA_K(1,SLOTB);
  bf16x8 qr[4];
  #pragma unroll
  for(int d0=0;d0<4;++d0)qr[d0]=*reinterpret_cast<const bf16x8*>(&Qw[(long)r32*DM+d0*16+hi*8]);
  float mhat=0.f,l_reg=0.f;f32x16 o[4];o[0]=f32x16{};o[1]=f32x16{};o[2]=f32x16{};o[3]=f32x16{};f32x16 negm=f32x16{};
  const int qrel=wid*QBLK+r32;
  #define CMASK(P0,P1,t) do{int jb_=(t)-(NT-4); if(jb_>=0){ const int dj_=jb_-(wid>>1); if(dj_>=0)cmask(P0,P1,jb_,qrel,hi); } }while(0)
  bool resc=false;
  #define START(P0,P1) do{ const float rm=rowmax(P0,P1); resc=false; \
    { const float dl=rm; mhat=fadd_s(mhat,dl); \
      _Pragma("unroll") for(int r=0;r<16;++r){P0[r]=fsub_s(P0[r],dl);P1[r]=fsub_s(P1[r],dl);} \
      _Pragma("unroll") for(int r=0;r<16;++r)negm[r]=-mhat; \
      } \
    _Pragma("unroll") for(int r=0;r<16;++r)P0[r]=__builtin_amdgcn_exp2f(P0[r]); }while(0)
  #define RESC() do{ if(resc){ asm volatile("s_waitcnt lgkmcnt(0)":::"memory"); \
      _Pragma("unroll") for(int d_=0;d_<4;++d_) _Pragma("unroll") for(int r=0;r<16;++r)o[d_][r]*=wsf[crow(r,hi)]; } }while(0)
  f32x16 pA0,pA1,pB0,pB1;
  int sl_prev=0,sl_cur=0,sl_next=SLOTB;
  #define ROT() do{sl_prev=sl_cur;sl_cur=sl_next;sl_next=(sl_next==(NSLOT-1)*SLOTB)?0:sl_next+SLOTB;}while(0)
  DMA_K(2,2*SLOTB);
  WAIT_BAR(4);
  qkt(pA0,pA1,Kbase,qr,negm,r32,hi);asm volatile("s_nop 15\n\ts_nop 7":"+v"(pA0),"+v"(pA1));CMASK(pA0,pA1,0);
  START(pA0,pA1);
  _Pragma("unroll") for(int r=0;r<16;++r)pA1[r]=__builtin_amdgcn_exp2f(pA1[r]);
  WAIT_BAR(0);
  DMA_K(3,0);DMA_V(1,SLOTB);
  ROT();
  kload8(kf,kp0+sl_cur);
  WAIT_BAR(3);
  s16x4 vlo[4],vhi[4]; u32x4 pw0,pw1,pw2,pw3;
  #define PKW(P,B) cvtpk_s(P[B],P[B+1])
  #define PAF(k) __builtin_bit_cast(bf16x8,pw##k)
  #define VFR(i) (bf16x8){vlo[i][0],vlo[i][1],vlo[i][2],vlo[i][3],vhi[i][0],vhi[i][1],vhi[i][2],vhi[i][3]}
  #define PIN(x) asm volatile("":"+v"(x))
  #define MX3(a,b,c) __builtin_fmaxf(__builtin_fmaxf((a),(b)),(c))
  #define GAPA(MF,A0,A1,A2,A3,W0,W1,PW) do{ MF; sacc+=A0; sacc+=A1; sacc+=A2; sacc+=A3; PIN(sacc); W0; W1; PIN(PW); SBAR(); }while(0)
  #define EX(v) __builtin_amdgcn_exp2f(v)
  #define GAPB(MF,X,B) do{ MF; X[B]=EX(X[B]); X[B+1]=EX(X[B+1]); PIN(X); SBAR(); }while(0)
  #define VRD(s_,f) do{ vlo[s_]=vtr(vp_+(((f)>>2)*4096+((f)&3)*1024)); vhi[s_]=vtr(vp_+(((f)>>2)*4096+((f)&3)*1024+512)); SBAR(); }while(0)
  #define KRD(G,j) do{ if(G){ kload2(kf,kp0+sl_next,j); SBAR(); } }while(0)
  #define PVM(d0,k,s_) o[d0]=__builtin_amdgcn_mfma_f32_32x32x16_bf16(PAF(k),VFR(s_),o[d0],0,0,0)
  #define STEP(C0,C1,P0,P1,t,GK,GV,GL) do{ SBAR(); \
    const lds_cptr vp_=vp0+2*sl_prev; \
    float sacc=(P0[0]+P0[1]); \
    GAPA(C0=__builtin_amdgcn_mfma_f32_32x32x16_bf16(kf[0],qr[0],negm,0,0,0), P0[2],P0[3],P0[4],P0[5],     pw0[0]=PKW(P0,0), pw0[1]=PKW(P0,2), pw0); \
    GAPA(C1=__builtin_amdgcn_mfma_f32_32x32x16_bf16(kf[1],qr[0],negm,0,0,0), P0[6],P0[7],P0[8],P0[9],     pw0[2]=PKW(P0,4), pw0[3]=PKW(P0,6), pw0); \
    GAPA(C0=__builtin_amdgcn_mfma_f32_32x32x16_bf16(kf[2],qr[1],C0,0,0,0),   P0[10],P0[11],P0[12],P0[13], pw1[0]=PKW(P0,8), pw1[1]=PKW(P0,10), pw1); \
    GAPA(C1=__builtin_amdgcn_mfma_f32_32x32x16_bf16(kf[3],qr[1],C1,0,0,0),   P0[14],P0[15],P1[0],P1[1],   pw1[2]=PKW(P0,12),pw1[3]=PKW(P0,14), pw1); \
    GAPA(C0=__builtin_amdgcn_mfma_f32_32x32x16_bf16(kf[4],qr[2],C0,0,0,0),   P1[2],P1[3],P1[4],P1[5],     pw2[0]=PKW(P1,0), pw2[1]=PKW(P1,2), pw2); \
    GAPA(C1=__builtin_amdgcn_mfma_f32_32x32x16_bf16(kf[5],qr[2],C1,0,0,0),   P1[6],P1[7],P1[8],P1[9],     pw2[2]=PKW(P1,4), pw2[3]=PKW(P1,6), pw2); \
    GAPA(C0=__builtin_amdgcn_mfma_f32_32x32x16_bf16(kf[6],qr[3],C0,0,0,0),   P1[10],P1[11],P1[12],P1[13], pw3[0]=PKW(P1,8), pw3[1]=PKW(P1,10), pw3); \
    GAPA(C1=__builtin_amdgcn_mfma_f32_32x32x16_bf16(kf[7],qr[3],C1,0,0,0),   P1[14],P1[15],0.f,0.f,       pw3[2]=PKW(P1,12),pw3[3]=PKW(P1,14), pw3); \
    l_reg+=sacc; \
    VRD(0,0); VRD(1,4); VRD(2,8); \
    if(GK){DMA_K((t)+3,sl_cur);} if(GV){DMA_V((t)+1,sl_next);} \
    CMASK(C0,C1,t); float a_,b_; \
    PVM(0,0,0); a_=MX3(C0[0],C0[1],C1[0]); b_=MX3(C0[2],C0[3],C1[1]); a_=MX3(a_,C1[2],C1[3]); PIN(a_); PIN(b_); SBAR();   VRD(3,12); \
    PVM(1,0,1); a_=MX3(a_,C0[4],C0[5]); b_=MX3(b_,C0[6],C0[7]); a_=MX3(a_,C1[4],C1[5]); b_=MX3(b_,C1[6],C1[7]); PIN(a_); PIN(b_); SBAR();   VRD(0,1); \
    PVM(2,0,2); a_=MX3(a_,C0[8],C0[9]); b_=MX3(b_,C0[10],C0[11]); a_=MX3(a_,C1[8],C1[9]); b_=MX3(b_,C1[10],C1[11]); PIN(a_); PIN(b_); SBAR();   VRD(1,5); \
    PVM(3,0,3); a_=MX3(a_,C0[12],C0[13]); b_=MX3(b_,C0[14],C0[15]); a_=MX3(a_,C1[12],C1[13]); b_=MX3(b_,C1[14],C1[15]); PIN(a_); PIN(b_); SBAR();   VRD(2,9); \
    { float rm=__builtin_fmaxf(a_,b_); { auto rr=__builtin_amdgcn_permlane32_swap(__float_as_uint(rm),__float_as_uint(rm),false,false); rm=__builtin_fmaxf(__uint_as_float(rr[0]),__uint_as_float(rr[1])); } \
      resc=false; \
      if(__builtin_expect(__any(rm>(float)THRL),0)){ const float dl=__builtin_fmaxf(rm,0.f); mhat+=dl; \
        _Pragma("unroll") for(int r=0;r<16;++r){C0[r]-=dl;C1[r]-=dl;negm[r]-=dl;} \
        const float f=__builtin_amdgcn_exp2f(-dl); l_reg*=f; if(hi==0)wsf[r32]=f; resc=true; } } \
    SBAR(); \
    PVM(0,1,0); C0[0]=EX(C0[0]); C0[1]=EX(C0[1]); C0[2]=EX(C0[2]); PIN(C0); SBAR();   VRD(3,13); \
    KRD(GL,0); PVM(1,1,1); C0[3]=EX(C0[3]); C0[4]=EX(C0[4]); PIN(C0); SBAR();   VRD(0,2); \
    PVM(2,1,2); C0[5]=EX(C0[5]); C0[6]=EX(C0[6]); C0[7]=EX(C0[7]); PIN(C0); SBAR();   VRD(1,6); \
    KRD(GL,1); PVM(3,1,3); C0[8]=EX(C0[8]); C0[9]=EX(C0[9]); PIN(C0); SBAR();   VRD(2,10); \
    PVM(0,2,0); C0[10]=EX(C0[10]); C0[11]=EX(C0[11]); C0[12]=EX(C0[12]); PIN(C0); SBAR();   VRD(3,14); \
    KRD(GL,2); PVM(1,2,1); C0[13]=EX(C0[13]); C0[14]=EX(C0[14]); PIN(C0); SBAR();   VRD(0,3); \
    PVM(2,2,2); C0[15]=EX(C0[15]); C1[0]=EX(C1[0]); C1[1]=EX(C1[1]); PIN(C0); PIN(C1); SBAR();   VRD(1,7); \
    KRD(GL,3); PVM(3,2,3); C1[2]=EX(C1[2]); C1[3]=EX(C1[3]); PIN(C1); SBAR();   VRD(2,11); \
    PVM(0,3,0); C1[4]=EX(C1[4]); C1[5]=EX(C1[5]); C1[6]=EX(C1[6]); PIN(C1); SBAR();   VRD(3,15); \
    PVM(1,3,1); C1[7]=EX(C1[7]); C1[8]=EX(C1[8]); C1[9]=EX(C1[9]); PIN(C1); SBAR(); \
    PVM(2,3,2); C1[10]=EX(C1[10]); C1[11]=EX(C1[11]); C1[12]=EX(C1[12]); PIN(C1); SBAR(); \
    PVM(3,3,3); C1[13]=EX(C1[13]); C1[14]=EX(C1[14]); C1[15]=EX(C1[15]); PIN(C1); SBAR(); \
    }while(0)
  int t=1;
  #undef CMASK
  #define CMASK(P0,P1,t) do{}while(0)
  for(;t+5<NT;t+=2){
    STEP(pB0,pB1,pA0,pA1,t,true,true,true);     WAIT_BAR(3); RESC(); ROT();
    STEP(pA0,pA1,pB0,pB1,t+1,true,true,true);   WAIT_BAR(3); RESC(); ROT();
  }
  #undef CMASK
  #define CMASK(P0,P1,t) do{int jb_=(t)-(NT-4); if(jb_>=0){ const int dj_=jb_-(wid>>1); if(dj_>=0)cmask(P0,P1,jb_,qrel,hi); } }while(0)
  #define ENDW(tt) do{ if((tt)+3<NT){WAIT_BAR(3);} else if((tt)+2<NT){WAIT_BAR(2);} else {WAIT_BAR(0);} }while(0)
  for(;t+1<NT;t+=2){
    STEP(pB0,pB1,pA0,pA1,t,(t+3<NT),(t+1<NT),(t+1<NT));       ENDW(t);   RESC(); ROT();
    STEP(pA0,pA1,pB0,pB1,t+1,(t+4<NT),(t+2<NT),(t+2<NT));     ENDW(t+1); RESC(); ROT();
  }
  STEP(pB0,pB1,pA0,pA1,NT-1,false,false,false); RESC();
  if((wid>>1)==3){ float sacc=pB0[0]+pB0[1]; _Pragma("unroll") for(int r=2;r<16;++r)sacc+=pB0[r]; _Pragma("unroll") for(int r=0;r<16;++r)sacc+=pB1[r]; l_reg+=sacc;
    pw0=(u32x4){PKW(pB0,0),PKW(pB0,2),PKW(pB0,4),PKW(pB0,6)};pw1=(u32x4){PKW(pB0,8),PKW(pB0,10),PKW(pB0,12),PKW(pB0,14)};pw2=(u32x4){PKW(pB1,0),PKW(pB1,2),PKW(pB1,4),PKW(pB1,6)};pw3=(u32x4){PKW(pB1,8),PKW(pB1,10),PKW(pB1,12),PKW(pB1,14)};
    int ln_=lane; asm volatile("":"+v"(ln_)); const int vb0=(int)(lds0+LDS_V)+((ln_>>4)&1)*32+(ln_&3)*8+(4*(ln_>>5)+((ln_&15)>>2))*64;
    SBAR(); pv(o,vb0+2*sl_cur,PAF(0),PAF(1),PAF(2),PAF(3)); }
  #undef PKW
  #undef PAF
  #undef VFR
  #undef PIN
  #undef MX3
  #undef GAPA
  #undef GAPB
  #undef EX
  #undef VRD
  #undef KRD
  #undef PVM
  #undef STEP
  #undef ENDW
  {auto rr=__builtin_amdgcn_permlane32_swap(__float_as_uint(l_reg),__float_as_uint(l_reg),false,false);l_reg=__uint_as_float(rr[0])+__uint_as_float(rr[1]);}
  if(hi==0)wsf[32+r32]=l_reg;asm volatile("s_waitcnt lgkmcnt(0)":::"memory");
  float rli[16];
  #pragma unroll
  for(int r=0;r<16;++r)rli[r]=__builtin_amdgcn_rcpf(wsf[32+crow(r,hi)]);
  bf16*Ow=Oh+(long)(q0+wid*QBLK)*DM;
  { int r32e=r32,hie=hi; asm volatile("":"+v"(r32e),"+v"(hie));
    bf16*stash=(bf16*)(shm+LDS_OST)+wid*4096;
    if(cmode==0){
      #pragma unroll
      for(int r=0;r<16;++r){const int orow=crow(r,hie);
        #pragma unroll
        for(int d0=0;d0<4;++d0)stash[orow*128+d0*32+r32e]=__float2bfloat16(o[d0][r]*rli[r]);}
    } else {
      float ss[16];
      #pragma unroll
      for(int r=0;r<16;++r){const int orow=crow(r,hie); float q=0.f;
        #pragma unroll
        for(int d0=0;d0<4;++d0){const float v=__bfloat162float(stash[orow*128+d0*32+r32e])-lam*(o[d0][r]*rli[r]); o[d0][r]=v; q+=v*v;}
        ss[r]=q;}
      #pragma unroll
      for(int st=0;st<4;++st){const int m=16>>st,n=16>>st; const bool up=(r32e&m)!=0;
        #pragma unroll
        for(int i=0;i<n/2;++i){const float a=ss[i],b2=ss[i+n/2]; const float keep=up?b2:a,send=up?a:b2; ss[i]=keep+__shfl_xor(send,m);} }
      ss[0]+=__shfl_xor(ss[0],1);
      asm volatile("s_waitcnt lgkmcnt(0)":::"memory");
      if((r32e&1)==0)wsf[crow(r32e>>1,hie)]=__builtin_amdgcn_rsqf(ss[0]*(1.0f/128.0f)+1e-6f);
      asm volatile("s_waitcnt lgkmcnt(0)":::"memory");
      float gs[4];
      #pragma unroll
      for(int d0=0;d0<4;++d0)gs[d0]=gsub[d0*32+r32e];
      #pragma unroll
      for(int r=0;r<16;++r){const float rs=wsf[crow(r,hie)];
        #pragma unroll
        for(int d0=0;d0<4;++d0)o[d0][r]*=rs*gs[d0];}
#if ATTN_OUT_FP8
      { unsigned char*stg8=(unsigned char*)stash;
        #pragma unroll
        for(int r=0;r<16;++r){const int orow=crow(r,hie); const int w0_=__builtin_amdgcn_cvt_pk_fp8_f32(o[0][r],o[1][r],0,false), w1_=__builtin_amdgcn_cvt_pk_fp8_f32(o[2][r],o[3][r],0,false);
          stg8[orow*128+r32e]=(unsigned char)w0_; stg8[orow*128+32+r32e]=(unsigned char)(w0_>>8); stg8[orow*128+64+r32e]=(unsigned char)w1_; stg8[orow*128+96+r32e]=(unsigned char)(w1_>>8);}
        asm volatile("s_waitcnt lgkmcnt(0)":::"memory");
        int lane_e=lane; asm volatile("":"+v"(lane_e));
        unsigned char*Ow8=(unsigned char*)Oh+(long)(q0+wid*QBLK)*DM;
        #pragma unroll
        for(int i=0;i<4;++i){const int row=i*8+(lane_e>>3),ch=lane_e&7; const u32x4 v=*(const u32x4*)(stg8+row*128+ch*16); ATTN_STORE16(Ow8+(long)row*DM+ch*16,v);}
        asm volatile("s_waitcnt lgkmcnt(0)":::"memory"); }
#else
      bf16*stg=stash;
      #pragma unroll
      for(int ps=0;ps<2;++ps){
        #pragma unroll
        for(int r=0;r<16;++r){const int orow=crow(r,hie);
          #pragma unroll
          for(int d0=0;d0<2;++d0)stg[orow*64+d0*32+r32e]=__float2bfloat16(o[2*ps+d0][r]);}
        asm volatile("s_waitcnt lgkmcnt(0)":::"memory");
        int lane_e=lane; asm volatile("":"+v"(lane_e));
        #pragma unroll
        for(int i=0;i<4;++i){const int row=i*8+(lane_e>>3),ch=lane_e&7; const u32x4 v=*(const u32x4*)(stg+row*64+ch*8); ATTN_STORE16(Ow+(long)row*DM+ps*64+ch*8,v);}
        asm volatile("s_waitcnt lgkmcnt(0)":::"memory"); }
#endif
      } }
  asm volatile("s_waitcnt lgkmcnt(0)\n\ts_barrier":::"memory");
  #undef DMA_K
  #undef DMA_V
  #undef CMASK
  #undef START
  #undef RESC
  #undef ROT
}
constexpr int ATTN_LDS_BYTES=LDS_BYTES;
struct DiffTensors { const bf16* Q; const bf16* K; const bf16* V; bf16* OA; const float* gsub; float lam; };
template<int THRL=8> __device__ __forceinline__ void attn_phase(char*lds,const DiffTensors&T,int vcu,int G){
  const int ngrp=G>>4, grp=vcu>>4, j=vcu&15;
  #pragma unroll 1
  for(int p=0;p*ngrp+grp<64&&grp<ngrp;++p){
    const int bh=p*ngrp+grp,b=bh>>3,h=bh&7,qb=(p&1)?NQB-1-j:j; const long rb=(long)b*SEQ*DM;
    #pragma unroll 1
    for(int c=0;c<2;++c){
      const bf16*Qh=T.Q+rb+(2*h+c)*64,*Kh=T.K+rb+(2*h+c)*64,*Vh=T.V+rb+h*128;
      bf16*Oh=ATTN_OUT_FP8?(bf16*)((unsigned char*)T.OA+rb+h*128):T.OA+rb+h*128;
      attn_unit<THRL>(qb,c,T.lam,T.gsub,Qh,Kh,Vh,Oh,lds); }
  }
}
#undef SBAR
#undef WAIT_BAR
}

constexpr int NWAVES = 8;
constexpr int BATCH = 8, SEQ = 4096, D = 1024, M = BATCH * SEQ;
constexpr int NEXP = 16, DEXP = 512, ECAP = 32768;
constexpr float LN_EPS = 1e-5f, RMS_EPS = 1e-6f;
constexpr float DN_ALPHA = 1.41421356237309515f;
constexpr float LAMBDA_INIT = 0.35550906759096926f;
#ifndef N_LAUNCH_MODE
#define N_LAUNCH_MODE 1
#endif
constexpr int N_PHASES = 16;

constexpr size_t MiB = 1u << 20;
constexpr size_t WS_CTL = 0, CTL_ZERO_BYTES = 1 * MiB;
constexpr size_t WS_TAB = 1 * MiB;
constexpr size_t WS_WIN = 2 * MiB;
constexpr size_t WS_WOUT = 10 * MiB;
constexpr size_t WS_WQKV = 12 * MiB;
constexpr size_t WS_WBO = 18 * MiB;
constexpr size_t WS_WGU = 20 * MiB;
constexpr size_t WS_WD = 84 * MiB;
constexpr size_t WS_BUF = 120 * MiB, BUFSZ = 64 * MiB;
constexpr size_t WS_A = WS_BUF, WS_B = WS_BUF + BUFSZ, WS_C = WS_BUF + 2 * BUFSZ, WS_D = WS_BUF + 3 * BUFSZ, WS_E = WS_BUF + 4 * BUFSZ, WS_F = WS_BUF + 5 * BUFSZ;
constexpr size_t WS_DEST = 504 * MiB, WS_GATE = 506 * MiB;
constexpr size_t WS_END = 508 * MiB;
constexpr int CW_CNT = 1024;
constexpr int CW_BAR = 4096;

constexpr int RING_OFF = 0, RING_BYTES = 143360;
constexpr int LDSCTL_OFF = RING_BYTES, MISC_OFF = LDSCTL_OFF + 320;
constexpr int MOETAB_OFF = LDSCTL_OFF + 1024;
constexpr int LDS_BYTES = 147456;
static_assert(MOETAB_OFF + 256 <= LDS_BYTES && MISC_OFF + 128 <= MOETAB_OFF, "LDS map");

#define GAS __attribute__((address_space(1)))
#define LAS __attribute__((address_space(3)))
typedef unsigned short bf16;
typedef unsigned v4u __attribute__((ext_vector_type(4)));
typedef unsigned v2u __attribute__((ext_vector_type(2)));
typedef float f32x4 __attribute__((ext_vector_type(4)));
typedef float f32x2 __attribute__((ext_vector_type(2)));
typedef short bf16x8 __attribute__((ext_vector_type(8)));
typedef short s16x4 __attribute__((ext_vector_type(4)));
typedef GAS unsigned gu32;
typedef GAS unsigned long long gu64;
#define RLX_AGENT __ATOMIC_RELAXED, __HIP_MEMORY_SCOPE_AGENT
#define LDS_WAIT() asm volatile("s_waitcnt lgkmcnt(0)" ::: "memory")
#define VM_WAIT() asm volatile("s_waitcnt vmcnt(0)" ::: "memory")
__device__ __forceinline__ unsigned f2bf(float f) { unsigned u = __builtin_bit_cast(unsigned, f); return (u + 0x7fffu + ((u >> 16) & 1u)) >> 16; }
__device__ __forceinline__ unsigned pk2(float lo, float hi) { return f2bf(lo) | (f2bf(hi) << 16); }
__device__ __forceinline__ float bflo(unsigned u) { return __uint_as_float(u << 16); }
__device__ __forceinline__ float bfhi(unsigned u) { return __uint_as_float(u & 0xffff0000u); }

#define XB_TMO      128
#define XB_XCNT(j)  (256  + 64 * (j))
#define XB_XSUB(j)  (1280 + 64 * (j))
#define XB_XGEN(j)  (2304 + 64 * (j))
#define XB_TOP      3328
#define XB_TOPGEN   3392
#define XCD_BAR_WORDS 3456
#define XB_SPIN_CAP (1u << 18)

__device__ __forceinline__ unsigned xb_ld(unsigned* p)              { return __hip_atomic_load(p, __ATOMIC_RELAXED, __HIP_MEMORY_SCOPE_AGENT); }
__device__ __forceinline__ unsigned xb_add(unsigned* p, unsigned v) { return __hip_atomic_fetch_add(p, v, __ATOMIC_RELAXED, __HIP_MEMORY_SCOPE_AGENT); }
__device__ __forceinline__ unsigned xb_xcc_id() { return (unsigned)__builtin_amdgcn_s_getreg((3 << 11) | 20) & 0xFu; }
#define XB_SPIN(cond, bar) do { unsigned _sp = 0; while (cond) { __builtin_amdgcn_s_sleep(1); \
    if ((++_sp & 255u) == 0u) { if (xb_ld(&(bar)[XB_TMO])) break; if (_sp > XB_SPIN_CAP) { atomicAdd(&(bar)[XB_TMO], 1u); break; } } } } while (0)

struct XcdBarrier {
    unsigned* bar; unsigned x;
    volatile LAS unsigned* st;
};

__device__ __forceinline__ XcdBarrier xcd_barrier_post(unsigned* bar, volatile LAS unsigned* st) {
    XcdBarrier b; b.bar = bar; b.x = xb_xcc_id(); b.st = st;
    if (threadIdx.x == 0) (void)xb_add(&bar[XB_XCNT(b.x)], 1u);
    return b;
}
__device__ __forceinline__ void xcd_barrier_complete(unsigned* bar, unsigned x, unsigned& nloc, unsigned& nx) {
    const unsigned G = gridDim.x * gridDim.y * gridDim.z;
    unsigned sum, cnt, mine, sp = 0u;
    for (;;) {
        sum = 0u; cnt = 0u; mine = 0u;
#pragma unroll
        for (unsigned j = 0; j < 16; ++j) { const unsigned c = xb_ld(&bar[XB_XCNT(j)]); sum += c; cnt += (c > 0u) ? 1u : 0u; mine = (j == x) ? c : mine; }
        if (sum == G) break;
        __builtin_amdgcn_s_sleep(1);
        if ((++sp & 255u) == 0u) { if (xb_ld(&bar[XB_TMO])) break; if (sp > XB_SPIN_CAP) { atomicAdd(&bar[XB_TMO], 1u); break; } }
    }
    nloc = mine > 0u ? mine : 1u; nx = cnt > 0u ? cnt : 1u;
}

__device__ __forceinline__ void xcd_barrier(const XcdBarrier& b) {
    asm volatile("s_waitcnt vmcnt(0)" ::: "memory");
    __syncthreads();
    if (threadIdx.x == 0) {
        unsigned* bar = b.bar;
        __builtin_amdgcn_s_waitcnt(0);
        unsigned nloc = b.st[0], nx = b.st[1];
        if (nloc == 0u) { xcd_barrier_complete(bar, b.x, nloc, nx); b.st[0] = nloc; b.st[1] = nx; }
        const unsigned old = xb_add(&bar[XB_XSUB(b.x)], 1u);
        const unsigned gen = old / nloc;
        if (old + 1u == (gen + 1u) * nloc) {
            __builtin_amdgcn_fence(__ATOMIC_RELEASE, "agent");
            asm volatile("s_waitcnt vmcnt(0)" ::: "memory");
            const unsigned og = xb_add(&bar[XB_TOP], 1u);
            const unsigned tg = og / nx;
            if (og + 1u == (tg + 1u) * nx) xb_add(&bar[XB_TOPGEN], 1u);
            else XB_SPIN(xb_ld(&bar[XB_TOPGEN]) == tg, bar);
            __builtin_amdgcn_fence(__ATOMIC_ACQUIRE, "agent");
            xb_add(&bar[XB_XGEN(b.x)], 1u);
            asm volatile("s_waitcnt vmcnt(0)" ::: "memory");
        } else {
            XB_SPIN(xb_ld(&bar[XB_XGEN(b.x)]) == gen, bar);
            __builtin_amdgcn_fence(__ATOMIC_ACQUIRE, "agent");
            asm volatile("s_waitcnt vmcnt(0)" ::: "memory");
        }
    }
    __syncthreads();
}

struct Frame {
    LAS unsigned char* lds;
    gu32* ctl;
    int tid, lane, wave;
    int vcu, G;
};
__device__ __forceinline__ float wave_sum(float v) {
#pragma unroll
    for (int o = 1; o < 64; o <<= 1) v += __shfl_xor(v, o);
    return v;
}
__device__ __forceinline__ void transpose_item(const float* W, int ldw, int k0, int n0, bf16* WT, int ldk, int dst_row0, float scale, LAS float* scr, int lane) {
#pragma unroll
    for (int i = 0; i < 32; ++i) { const int kk = 2 * i + (lane >> 5); scr[kk * 33 + (lane & 31)] = __builtin_nontemporal_load(W + (size_t)(k0 + kk) * ldw + n0 + (lane & 31)); }
    LDS_WAIT(); asm volatile("" ::: "memory");
    const int c = lane & 7;
#pragma unroll
    for (int j = 0; j < 4; ++j) { const int n = (lane >> 3) + 8 * j; const LAS float* s = scr + (8 * c) * 33 + n;
        v4u o; o.x = pk2(s[0 * 33] * scale, s[1 * 33] * scale); o.y = pk2(s[2 * 33] * scale, s[3 * 33] * scale); o.z = pk2(s[4 * 33] * scale, s[5 * 33] * scale); o.w = pk2(s[6 * 33] * scale, s[7 * 33] * scale);
        *(GAS v4u*)(WT + (size_t)(dst_row0 + n) * ldk + k0 + 8 * c) = o; }
    LDS_WAIT(); asm volatile("" ::: "memory");
}
__device__ __forceinline__ void transpose_item8(const float* W, int ldw, int k0, int n0, unsigned char* WT8, int ldk, int dst_row0, float scale, LAS float* scr, int lane) {
#pragma unroll
    for (int i = 0; i < 32; ++i) { const int kk = 2 * i + (lane >> 5); scr[kk * 33 + (lane & 31)] = __builtin_nontemporal_load(W + (size_t)(k0 + kk) * ldw + n0 + (lane & 31)); }
    LDS_WAIT(); asm volatile("" ::: "memory");
    const int c = lane & 7;
#pragma unroll
    for (int j = 0; j < 4; ++j) { const int n = (lane >> 3) + 8 * j; const LAS float* sp = scr + (8 * c) * 33 + n;
        int w0 = 0, w1 = 0;
        w0 = __builtin_amdgcn_cvt_pk_fp8_f32(sp[0 * 33] * scale, sp[1 * 33] * scale, w0, false); w0 = __builtin_amdgcn_cvt_pk_fp8_f32(sp[2 * 33] * scale, sp[3 * 33] * scale, w0, true);
        w1 = __builtin_amdgcn_cvt_pk_fp8_f32(sp[4 * 33] * scale, sp[5 * 33] * scale, w1, false); w1 = __builtin_amdgcn_cvt_pk_fp8_f32(sp[6 * 33] * scale, sp[7 * 33] * scale, w1, true);
        *(GAS v2u*)(WT8 + (size_t)(dst_row0 + n) * ldk + k0 + 8 * c) = (v2u){(unsigned)w0, (unsigned)w1}; }
    LDS_WAIT(); asm volatile("" ::: "memory");
}
__device__ __forceinline__ void transpose_plain(const float* W, int K, int N, bf16* WT, int row_off, float scale, LAS float* scr, int item, int lane) {
    const int nblk = N / 32, kb = item / nblk, nb = item % nblk;
    transpose_item(W, N, 64 * kb, 32 * nb, WT, K, row_off + 32 * nb, scale, scr, lane);
}

__device__ __forceinline__ void transpose_plain8(const float* W, int K, int N, unsigned char* WT8, int row_off, float scale, LAS float* scr, int item, int lane) {
    const int nblk = N / 32, kb = item / nblk, nb = item % nblk;
    transpose_item8(W, N, 64 * kb, 32 * nb, WT8, K, row_off + 32 * nb, scale, scr, lane);
}
constexpr float W8_SCALE = 64.0f;
#ifndef MIX_SPLIT
#define MIX_SPLIT 0
#endif
#ifndef ALIGN_P3
#define ALIGN_P3 true
#endif
#ifndef R_BF16
#define R_BF16 1
#endif
#ifndef FP8_PROJ
#define FP8_PROJ 13
#endif
__host__ __device__ constexpr int proj_rank(int grp, bool f8) { int r = 0; for (int g2 = 0; g2 < grp; ++g2) if ((((FP8_PROJ) >> g2) & 1) == (f8 ? 1 : 0)) ++r; return r; }
__host__ __device__ constexpr int proj_count(bool f8) { return proj_rank(4, f8); }
__host__ __device__ constexpr int proj_gmap(bool f8) { int m = 0, r = 0; for (int g2 = 0; g2 < 4; ++g2) if ((((FP8_PROJ) >> g2) & 1) == (f8 ? 1 : 0)) { m |= g2 << (4 * r); ++r; } return m; }
constexpr size_t WS_WIN8 = WS_WIN + (size_t)proj_count(false) * 2 * MiB;
#ifndef FP8_QKV
#define FP8_QKV 1
#endif
struct Inputs { const float *x, *a_w_in, *a_lb, *a_norm_g, *a_w_out, *kv_w, *b_w_q, *b_lam, *b_subln_g, *b_w_out, *ln1_g, *ln1_b, *ln2_g, *ln2_b, *router_w, *router_b, *moe_w_gate, *moe_w_up, *moe_w_down; };

constexpr int DN_IN = 16 * 128, DN_SQ = 16 * 32, DN_KV = 16 * 64, DN_ALL = DN_IN + DN_SQ + DN_KV + DN_SQ + DN_SQ;
__device__ __forceinline__ void dense_weight_convert(Frame& F, const Inputs& in, unsigned char* ws, int it_lo, int it_hi, int w0, int nw) {
    LAS float* scr = (LAS float*)(F.lds + RING_OFF + F.wave * 16384);
    constexpr int I_IN = DN_IN, I_SQ = DN_SQ, I_KV = DN_KV;
    for (int it = it_lo + w0; it < it_hi; it += nw) {
        int r = it;
        if (r < I_IN) { const int nb_ = r % 128, kb_ = r / 128, grp_ = nb_ >> 5;
            if ((FP8_PROJ >> grp_) & 1) transpose_item8(in.a_w_in, 4 * D, 64 * kb_, 32 * nb_, ws + WS_WIN8, D, proj_rank(grp_, true) * 1024 + 32 * (nb_ & 31), W8_SCALE, scr, F.lane);
            else transpose_item(in.a_w_in, 4 * D, 64 * kb_, 32 * nb_, (bf16*)(ws + WS_WIN), D, proj_rank(grp_, false) * 1024 + 32 * (nb_ & 31), 1.f, scr, F.lane);
            continue; } r -= I_IN;
        if (r < I_SQ) { transpose_plain(in.a_w_out, D, D, (bf16*)(ws + WS_WOUT), 0, 1.f, scr, r, F.lane); continue; } r -= I_SQ;
        if (r < I_KV) { if (FP8_QKV) transpose_plain8(in.kv_w, D, 2 * D, ws + WS_WQKV, D, W8_SCALE, scr, r, F.lane); else transpose_plain(in.kv_w, D, 2 * D, (bf16*)(ws + WS_WQKV), D, 1.f, scr, r, F.lane); continue; } r -= I_KV;
        if (r < I_SQ) { if (FP8_QKV) transpose_plain8(in.b_w_q, D, D, ws + WS_WQKV, 0, attn_body::C2 * W8_SCALE, scr, r, F.lane); else transpose_plain(in.b_w_q, D, D, (bf16*)(ws + WS_WQKV), 0, attn_body::C2, scr, r, F.lane); continue; } r -= I_SQ;
        if (ATTN_OUT_FP8) transpose_plain8(in.b_w_out, D, D, ws + WS_WBO, 0, W8_SCALE, scr, r, F.lane); else transpose_plain(in.b_w_out, D, D, (bf16*)(ws + WS_WBO), 0, 1.f, scr, r, F.lane);
    }
}
#ifndef SHADOW_CONV
#define SHADOW_CONV 1
#endif
#ifndef SHADOW_DENSE
#define SHADOW_DENSE 1
#endif
__device__ __forceinline__ void p0_prologue(Frame& F, const Inputs& in, unsigned char* ws) {
    const int gw = F.vcu * NWAVES + F.wave, NGW = F.G * NWAVES;
    dense_weight_convert(F, in, ws, 0, (SHADOW_DENSE && SHADOW_CONV && N_LAUNCH_MODE == 1) ? DN_IN : DN_ALL, gw, NGW);
    bf16* XB = (bf16*)(ws + WS_A);
    for (int m0 = gw; m0 < M; m0 += 4 * NGW) {
        f32x4 xv[4][4];
#pragma unroll
        for (int q = 0; q < 4; ++q) { const int m = m0 + q * NGW; if (m < M) { const GAS f32x4* xr = (const GAS f32x4*)(in.x + (size_t)m * D) + F.lane;
#pragma unroll
            for (int j = 0; j < 4; ++j) xv[q][j] = __builtin_nontemporal_load(xr + 64 * j); } }
        asm volatile("" ::: "memory");
#pragma unroll
        for (int q = 0; q < 4; ++q) { const int m = m0 + q * NGW; if (m < M) { GAS v2u* o8 = (GAS v2u*)(XB + (size_t)m * D) + F.lane;
#pragma unroll
            for (int j = 0; j < 4; ++j) { const f32x4 v = xv[q][j]; v2u o; o.x = pk2(v.x, v.y); o.y = pk2(v.z, v.w); o8[64 * j] = o;
                if (FP8_PROJ) { int w8 = 0; w8 = __builtin_amdgcn_cvt_pk_fp8_f32(v.x, v.y, w8, false); w8 = __builtin_amdgcn_cvt_pk_fp8_f32(v.z, v.w, w8, true); *(GAS unsigned*)(ws + WS_F + (size_t)m * D + 4 * F.lane + 256 * j) = (unsigned)w8; } } } }
    }
    if (blockIdx.x == 0) {
        float* tab = (float*)(ws + WS_TAB);
        for (int d = F.tid; d < D; d += NWAVES * 64) { const float a0 = in.a_lb[d], a1 = in.a_lb[D + d]; tab[d] = 1.0f / (1.0f + __expf(a1 - a0)); }
        if (F.wave == 0) { const float p = wave_sum(in.b_lam[F.lane] * in.b_lam[64 + F.lane]), q = wave_sum(in.b_lam[128 + F.lane] * in.b_lam[192 + F.lane]);
            if (F.lane == 0) tab[1024] = __expf(p) - __expf(q) + LAMBDA_INIT; }
    }
}
#ifndef FP8_L0
#define FP8_L0 1
#endif
#ifndef FP8_L1
#define FP8_L1 1
#endif
constexpr int MOE_PER = 768, MOE_NIT = 2 * NEXP * MOE_PER;
__device__ __forceinline__ void moe_weight_convert(Frame& F, const Inputs& in, unsigned char* ws, int it_lo, int it_hi, int w0, int nw) {
    LAS float* scr = (LAS float*)(F.lds + RING_OFF + F.wave * 16384);
    constexpr int PER = MOE_PER;
    for (int it = it_lo + w0; it < it_hi; it += nw) {
        const int le = it / PER, r = it % PER, kind = r >> 8, q = r & 255, l = le >> 4, e = le & 15;
        const bool f8 = l ? (FP8_L1 != 0) : (FP8_L0 != 0);
        unsigned char* gu = ws + WS_WGU + (size_t)l * (32 * MiB) + (size_t)e * D * D * (f8 ? 1 : 2);
        unsigned char* dn = ws + WS_WD + (size_t)l * (16 * MiB) + (size_t)e * D * DEXP * (f8 ? 1 : 2);
        if (kind < 2) { const int kb = q >> 4, nb = q & 15, n0 = 32 * nb; const float* W = (kind == 0 ? in.moe_w_gate : in.moe_w_up) + (size_t)le * D * DEXP;
            const int drow = (n0 >> 7) * 256 + kind * 128 + (n0 & 127);
            if (f8) transpose_item8(W, DEXP, 64 * kb, n0, gu, D, drow, W8_SCALE, scr, F.lane); else transpose_item(W, DEXP, 64 * kb, n0, (bf16*)gu, D, drow, 1.f, scr, F.lane); }
        else { const int kb = q >> 5, nb = q & 31; const float* W = in.moe_w_down + (size_t)le * DEXP * D;
            if (f8) transpose_item8(W, D, 64 * kb, 32 * nb, dn, DEXP, 32 * nb, W8_SCALE, scr, F.lane); else transpose_item(W, D, 64 * kb, 32 * nb, (bf16*)dn, DEXP, 32 * nb, 1.f, scr, F.lane); }
    }
}

#ifndef SHADOW_CONV
#define SHADOW_CONV 1
#endif
template <class W> __device__ __forceinline__ void xcd_barrier_w(const XcdBarrier& b, const W& work) {
    asm volatile("s_waitcnt vmcnt(0)" ::: "memory");
    __syncthreads();
    if (__builtin_amdgcn_readfirstlane((int)threadIdx.x >> 6) != 0) work();
    if (threadIdx.x == 0) {
        unsigned* bar = b.bar;
        __builtin_amdgcn_s_waitcnt(0);
        unsigned nloc = b.st[0], nx = b.st[1];
        if (nloc == 0u) { xcd_barrier_complete(bar, b.x, nloc, nx); b.st[0] = nloc; b.st[1] = nx; }
        const unsigned old = xb_add(&bar[XB_XSUB(b.x)], 1u);
        const unsigned gen = old / nloc;
        if (old + 1u == (gen + 1u) * nloc) {
            __builtin_amdgcn_fence(__ATOMIC_RELEASE, "agent");
            asm volatile("s_waitcnt vmcnt(0)" ::: "memory");
            const unsigned og = xb_add(&bar[XB_TOP], 1u);
            const unsigned tg = og / nx;
            if (og + 1u == (tg + 1u) * nx) xb_add(&bar[XB_TOPGEN], 1u);
            else XB_SPIN(xb_ld(&bar[XB_TOPGEN]) == tg, bar);
            __builtin_amdgcn_fence(__ATOMIC_ACQUIRE, "agent");
            xb_add(&bar[XB_XGEN(b.x)], 1u);
            asm volatile("s_waitcnt vmcnt(0)" ::: "memory");
        } else {
            XB_SPIN(xb_ld(&bar[XB_XGEN(b.x)]) == gen, bar);
            __builtin_amdgcn_fence(__ATOMIC_ACQUIRE, "agent");
            asm volatile("s_waitcnt vmcnt(0)" ::: "memory");
        }
    }
    asm volatile("s_waitcnt lgkmcnt(0)\n\ts_barrier" ::: "memory");
}
#ifndef SH_DOUBLE
#define SH_DOUBLE 2
#endif
constexpr int SH_PER = 7 * 256, SH_P0 = (MOE_NIT / 2 - (5 + SH_DOUBLE) * SH_PER) > 0 ? (MOE_NIT / 2 - (5 + SH_DOUBLE) * SH_PER) : 0;
static_assert(SH_P0 >= 0 && 7 * SH_PER >= MOE_NIT / 2, "shadow conversion schedule");
__device__ __forceinline__ void shadow_convert(Frame& F, const Inputs& in, unsigned char* ws, int j) {
    int lo, hi;
    if (j < 5) { lo = SH_P0 + (j + (j < SH_DOUBLE ? j : SH_DOUBLE)) * SH_PER; hi = lo + (j < SH_DOUBLE ? 2 : 1) * SH_PER; if (hi > MOE_NIT / 2) hi = MOE_NIT / 2; if (lo > hi) lo = hi; }
    else if (j < 12) { lo = MOE_NIT / 2 + (j - 5) * SH_PER; hi = lo + SH_PER < MOE_NIT ? lo + SH_PER : MOE_NIT; }
    else { lo = 0; hi = 0; }
    moe_weight_convert(F, in, ws, lo, hi, F.vcu * 7 + (F.wave - 1), F.G * 7);
    if (SHADOW_DENSE) {
        if (j == 2) dense_weight_convert(F, in, ws, DN_IN, DN_IN + DN_SQ, F.vcu * 7 + (F.wave - 1), F.G * 7);
        else if (j == 3) dense_weight_convert(F, in, ws, DN_IN + DN_SQ, DN_IN + DN_SQ + DN_KV + DN_SQ, F.vcu * 7 + (F.wave - 1), F.G * 7);
        else if (j == 4) dense_weight_convert(F, in, ws, DN_IN + DN_SQ + DN_KV + DN_SQ, DN_ALL, F.vcu * 7 + (F.wave - 1), F.G * 7);
    }
}

constexpr int SC_TOT = 0, SC_DEC = 4096, SC_SS = SC_DEC + 512, SC_QT = SC_SS + 2048, SC_KT = SC_QT + 17408, SC_QH = SC_KT + 17408,
              SC_KHT = SC_QH + 17408, SC_VT = SC_KHT + 18432, SC_P = SC_VT + 18432, SC_END = SC_P + 9216, SC_OUT = SC_QT;
static_assert(SC_END <= RING_BYTES && 64 * 528 <= 2 * 17408, "scan LDS map");
__device__ __forceinline__ float h2f(unsigned short h) { return (float)__builtin_bit_cast(__fp16, h); }
__device__ __forceinline__ unsigned cvtpk(float lo, float hi) { typedef float f2_t __attribute__((ext_vector_type(2))); typedef __bf16 b2_t __attribute__((ext_vector_type(2)));
    f2_t v = {lo, hi}; b2_t b = __builtin_convertvector(v, b2_t); return __builtin_bit_cast(unsigned, b); }
__device__ __forceinline__ float row16_sum(float v) {
    v += __builtin_bit_cast(float, __builtin_amdgcn_update_dpp(0, __builtin_bit_cast(int, v), 0xB1, 0xF, 0xF, true));
    v += __builtin_bit_cast(float, __builtin_amdgcn_update_dpp(0, __builtin_bit_cast(int, v), 0x4E, 0xF, 0xF, true));
    v += __builtin_bit_cast(float, __builtin_amdgcn_update_dpp(0, __builtin_bit_cast(int, v), 0x141, 0xF, 0xF, true));
    v += __builtin_bit_cast(float, __builtin_amdgcn_update_dpp(0, __builtin_bit_cast(int, v), 0x140, 0xF, 0xF, true));
    return v;
}
__device__ __forceinline__ void store16_sc1(void* p, v4u v) { *(GAS v4u*)p = v; }
#ifndef Y2L0_FP8
#define Y2L0_FP8 1
#endif
#ifndef Y2L1_FP8
#define Y2L1_FP8 1
#endif
#ifndef OI_FP8
#define OI_FP8 0
#endif
#ifndef QH_FP8
#define QH_FP8 1
#endif
#ifndef US_FP8
#define US_FP8 1
#endif
constexpr int US_CH = US_FP8 ? 16384 : 32768, US_W = US_CH / 8, US_KS = US_W / 4, US_LN = US_KS / 64;
__device__ __forceinline__ unsigned pk4_fp8(float a, float b, float c, float d) { int w = 0; w = __builtin_amdgcn_cvt_pk_fp8_f32(a, b, w, false); w = __builtin_amdgcn_cvt_pk_fp8_f32(c, d, w, true); return (unsigned)w; }
__device__ __forceinline__ void un4_fp8(unsigned w, float (&o)[4]) { const f32x2 lo = __builtin_amdgcn_cvt_pk_f32_fp8((int)w, false), hi = __builtin_amdgcn_cvt_pk_f32_fp8((int)w, true); o[0] = lo.x; o[1] = lo.y; o[2] = hi.x; o[3] = hi.y; }
__device__ __forceinline__ size_t tile_off(int b, int h, int c, int x) { return ((size_t)b * SEQ + c * 64 + (x >> 8)) * (D * 2) + (size_t)h * 256 + (x & 255); }

#define LDS_BAR() asm volatile("s_waitcnt lgkmcnt(0)\n\ts_barrier" ::: "memory")
__device__ __forceinline__ void scan2a_range(Frame& F, int u_lo, int u_hi, const bf16* Q0, const bf16* LF, const bf16* V0, unsigned char* UD, unsigned char* QHF, unsigned char* OI, float* DECG) {
    LAS unsigned char* L = F.lds + RING_OFF;
    LAS float* TOT = (LAS float*)(L + SC_TOT); LAS float* DEC = (LAS float*)(L + SC_DEC);
    const int lane = F.lane, w = F.wave, row16 = lane & 15, quad = lane >> 4;
    if (u_lo >= u_hi) return;
    unsigned pq[8], pl[8], pv[8];
    f32x4 sloc[4][2]; float cum0 = 1.f, cum1 = 1.f;
#pragma unroll
    for (int kp = 0; kp < 4; ++kp) { sloc[kp][0] = (f32x4){0.f, 0.f, 0.f, 0.f}; sloc[kp][1] = (f32x4){0.f, 0.f, 0.f, 0.f}; }
#define SC2A_LOAD(u_) do { const int b_ = (u_) >> 9, h_ = ((u_) >> 6) & 7, c_ = (u_) & 63; const size_t o = ((size_t)b_ * SEQ + c_ * 64 + 8 * w) * D + (size_t)h_ * 128 + 2 * lane; \
        _Pragma("unroll") for (int j = 0; j < 8; ++j) { pq[j] = *(const GAS unsigned*)(Q0 + o + (size_t)j * D); pl[j] = *(const GAS unsigned*)(LF + o + (size_t)j * D); pv[j] = *(const GAS unsigned*)(V0 + o + (size_t)j * D); } } while (0)
    SC2A_LOAD(u_lo);
    for (int u = u_lo; u < u_hi; ++u) {
    const int b = u >> 9, h = (u >> 6) & 7, c = u & 63, ch = u;
    unsigned cq[8], cl[8], cv[8];
#pragma unroll
    for (int j = 0; j < 8; ++j) { cq[j] = pq[j]; cl[j] = pl[j]; cv[j] = pv[j]; }
    if (u + 1 < u_hi) SC2A_LOAD(u + 1);
    float lf0[8], lf1[8], pre0[8], pre1[8], kk0[8], kk1[8];
#pragma unroll
    for (int j = 0; j < 8; ++j) { const float f0 = h2f((unsigned short)(cl[j] & 0xffffu)), f1 = h2f((unsigned short)(cl[j] >> 16));
        kk0[j] = 1.0f - f0; kk1[j] = 1.0f - f1; lf0[j] = __logf(f0); lf1[j] = __logf(f1); pre0[j] = lf0[j] + (j ? pre0[j - 1] : 0.f); pre1[j] = lf1[j] + (j ? pre1[j - 1] : 0.f); }
    *(LAS f32x2*)(TOT + w * 128 + 2 * lane) = (f32x2){pre0[7], pre1[7]};
    LDS_BAR();
    { float off0 = 0.f, off1 = 0.f, bref0 = 0.f, bref1 = 0.f, bl0 = 0.f, bl1 = 0.f;
#pragma unroll
      for (int ww = 0; ww < 8; ++ww) { const f32x2 t = *(const LAS f32x2*)(TOT + ww * 128 + 2 * lane);
          if (ww < w) { off0 += t.x; off1 += t.y; } if (ww < 4) { bref0 += t.x; bref1 += t.y; } bl0 += t.x; bl1 += t.y; }
      const float E10 = __expf(bref0), E11 = __expf(bref1), E20 = __expf(bl0 - bref0), E21 = __expf(bl1 - bref1);
      unsigned kh0[4], kh1[4], vt0[4], vt1[4]; float pk0 = 0.f, pk1 = 0.f;
#pragma unroll
      for (int j = 0; j < 8; ++j) { const int r = 8 * w + j;
          const float q0 = bflo(cq[j]), q1 = bfhi(cq[j]);
          const float e0 = __expf(pre0[j] + off0 - bref0), e1 = __expf(pre1[j] + off1 - bref1);
          const float k0 = kk0[j], k1 = kk1[j];
          const float qt0 = q0 * e0, qt1 = q1 * e1, kt0 = k0 * __builtin_amdgcn_rcpf(e0), kt1 = k1 * __builtin_amdgcn_rcpf(e1);
          *(LAS unsigned*)(L + SC_QT + r * 272 + 4 * lane) = cvtpk(qt0, qt1);
          *(LAS unsigned*)(L + SC_KT + r * 272 + 4 * lane) = cvtpk(kt0, kt1);
          *(LAS unsigned*)(L + SC_QH + r * 272 + 4 * lane) = cvtpk(qt0 * E10, qt1 * E11);
          const float kh0f = kt0 * E20, kh1f = kt1 * E21;
          if (j & 1) { kh0[j >> 1] = cvtpk(pk0, kh0f); kh1[j >> 1] = cvtpk(pk1, kh1f); vt0[j >> 1] = (cv[j - 1] & 0xffffu) | (cv[j] << 16); vt1[j >> 1] = (cv[j - 1] >> 16) | (cv[j] & 0xffff0000u); }
          else { pk0 = kh0f; pk1 = kh1f; } }
      *(LAS v4u*)(L + SC_KHT + (2 * lane) * 144 + 16 * w) = (v4u){kh0[0], kh0[1], kh0[2], kh0[3]};
      *(LAS v4u*)(L + SC_KHT + (2 * lane + 1) * 144 + 16 * w) = (v4u){kh1[0], kh1[1], kh1[2], kh1[3]};
      *(LAS v4u*)(L + SC_VT + (2 * lane) * 144 + 16 * w) = (v4u){vt0[0], vt0[1], vt0[2], vt0[3]};
      *(LAS v4u*)(L + SC_VT + (2 * lane + 1) * 144 + 16 * w) = (v4u){vt1[0], vt1[1], vt1[2], vt1[3]};
      if (w == 0) { const float d0_ = __expf(bl0), d1_ = __expf(bl1); cum0 *= d0_; cum1 *= d1_;
          *(LAS f32x2*)(DEC + 2 * lane) = (f32x2){d0_, d1_};
          *(GAS f32x2*)(DECG + (size_t)ch * 128 + 2 * lane) = (f32x2){cum0, cum1}; } }
    LDS_BAR();
    { const int ti = w >> 1;
#pragma unroll
      for (int jj = 0; jj < 2; ++jj) { const int tj = 2 * (w & 1) + jj; f32x4 a = (f32x4){0.f, 0.f, 0.f, 0.f};
          if (tj <= ti) {
#pragma unroll
              for (int ks = 0; ks < 4; ++ks) { const bf16x8 af = *(const LAS bf16x8*)(L + SC_QT + (16 * ti + row16) * 272 + (32 * ks + 8 * quad) * 2);
                  const bf16x8 bfr = *(const LAS bf16x8*)(L + SC_KT + (16 * tj + row16) * 272 + (32 * ks + 8 * quad) * 2);
                  a = __builtin_amdgcn_mfma_f32_16x16x32_bf16(af, bfr, a, 0, 0, 0); } }
          unsigned short pv4[4];
#pragma unroll
          for (int j = 0; j < 4; ++j) { const int t = 16 * ti + 4 * quad + j, s2 = 16 * tj + row16; pv4[j] = (unsigned short)f2bf((s2 <= t) ? a[j] : 0.f); }
#pragma unroll
          for (int j = 0; j < 4; ++j) *(LAS unsigned short*)(L + SC_P + (16 * ti + 4 * quad + j) * 144 + (16 * tj + row16) * 2) = pv4[j]; } }
#pragma unroll
    for (int ff = 0; ff < 2; ++ff) { const int f = 2 * w + ff, mi = f >> 2, ks = f & 3;
        const v2u a0 = *(const LAS v2u*)(L + SC_QH + (16 * mi + row16) * 272 + (32 * ks + 4 * quad) * 2), a1 = *(const LAS v2u*)(L + SC_QH + (16 * mi + row16) * 272 + (32 * ks + 16 + 4 * quad) * 2);
        if (QH_FP8) *(GAS v2u*)(QHF + (size_t)ch * 8192 + f * 512 + lane * 8) = (v2u){pk4_fp8(bflo(a0.x), bfhi(a0.x), bflo(a0.y), bfhi(a0.y)), pk4_fp8(bflo(a1.x), bfhi(a1.x), bflo(a1.y), bfhi(a1.y))};
        else *(GAS v4u*)(QHF + (size_t)ch * 16384 + f * 1024 + lane * 16) = (v4u){a0.x, a0.y, a1.x, a1.y}; }
    bf16x8 vfr[2];
#pragma unroll
    for (int ks = 0; ks < 2; ++ks) vfr[ks] = *(const LAS bf16x8*)(L + SC_VT + (16 * w + row16) * 144 + (32 * ks + 8 * quad) * 2);
#pragma unroll
    for (int kp = 0; kp < 4; ++kp) { f32x4 u2[2];
#pragma unroll
        for (int hh = 0; hh < 2; ++hh) { const int i2 = 2 * kp + hh; f32x4 s = (f32x4){0.f, 0.f, 0.f, 0.f};
#pragma unroll
            for (int ks = 0; ks < 2; ++ks) { const bf16x8 af = *(const LAS bf16x8*)(L + SC_KHT + (16 * i2 + row16) * 144 + (32 * ks + 8 * quad) * 2);
                s = __builtin_amdgcn_mfma_f32_16x16x32_bf16(af, vfr[ks], s, 0, 0, 0); }
            const f32x4 dv_ = *(const LAS f32x4*)(DEC + 32 * kp + 16 * hh + 4 * quad);
            sloc[kp][hh] = dv_ * sloc[kp][hh] + s; u2[hh] = sloc[kp][hh]; }
        if (US_FP8) *(GAS v2u*)(UD + (size_t)ch * US_CH + w * US_W + kp * US_KS + lane * US_LN) = (v2u){pk4_fp8(u2[0][0], u2[0][1], u2[0][2], u2[0][3]), pk4_fp8(u2[1][0], u2[1][1], u2[1][2], u2[1][3])};
        else store16_sc1(UD + (size_t)ch * 32768 + w * 4096 + kp * 1024 + lane * 16, (v4u){cvtpk(u2[0][0], u2[0][1]), cvtpk(u2[0][2], u2[0][3]), cvtpk(u2[1][0], u2[1][1]), cvtpk(u2[1][2], u2[1][3])}); }
    LDS_BAR();
    { f32x4 oacc[4];
#pragma unroll
      for (int mi = 0; mi < 4; ++mi) { oacc[mi] = (f32x4){0.f, 0.f, 0.f, 0.f};
#pragma unroll
          for (int ks = 0; ks < 2; ++ks) { const bf16x8 af = *(const LAS bf16x8*)(L + SC_P + (16 * mi + row16) * 144 + (32 * ks + 8 * quad) * 2);
              oacc[mi] = __builtin_amdgcn_mfma_f32_16x16x32_bf16(af, vfr[ks], oacc[mi], 0, 0, 0); } }
#pragma unroll
      for (int hh = 0; hh < 2; ++hh) { if (OI_FP8) { if (hh == 0) *(GAS v4u*)(OI + tile_off(b, h, c, w * 1024 + lane * 16)) = (v4u){pk4_fp8(oacc[0][0], oacc[0][1], oacc[0][2], oacc[0][3]), pk4_fp8(oacc[1][0], oacc[1][1], oacc[1][2], oacc[1][3]), pk4_fp8(oacc[2][0], oacc[2][1], oacc[2][2], oacc[2][3]), pk4_fp8(oacc[3][0], oacc[3][1], oacc[3][2], oacc[3][3])}; }
          else *(GAS v4u*)(OI + tile_off(b, h, c, w * 2048 + hh * 1024 + lane * 16)) =
          (v4u){cvtpk(oacc[2 * hh][0], oacc[2 * hh][1]), cvtpk(oacc[2 * hh][2], oacc[2 * hh][3]), cvtpk(oacc[2 * hh + 1][0], oacc[2 * hh + 1][1]), cvtpk(oacc[2 * hh + 1][2], oacc[2 * hh + 1][3])}; } }
    }
#undef SC2A_LOAD
}
__device__ __forceinline__ void scan2c_range(Frame& F, int u_lo, int u_hi, const unsigned char* UD, const unsigned char* QHF, const bf16* G0, const float* norm_g, bf16* O0, const float* DECG) {
    if (u_lo >= u_hi) return;
    LAS unsigned char* L = F.lds + RING_OFF;
    LAS float* SS = (LAS float*)(L + SC_SS);
    const int lane = F.lane, w = F.wave, row16 = lane & 15, quad = lane >> 4;
    unsigned pg[8]; v4u poi[2], psf[4], pqh[16]; f32x4 pdc[4][2];
    f32x4 carry[4][2];
#pragma unroll
    for (int ks = 0; ks < 4; ++ks) { carry[ks][0] = (f32x4){0.f, 0.f, 0.f, 0.f}; carry[ks][1] = (f32x4){0.f, 0.f, 0.f, 0.f}; }
    { const int glen = u_hi - u_lo, c_lo = u_lo & 63, ngrp = c_lo / glen, ubh = u_lo - c_lo;
      for (int gq = 0; gq < ngrp; ++gq) { const int ul = ubh + (gq + 1) * glen - 1;
#pragma unroll
          for (int ks = 0; ks < 4; ++ks) { float a4[4], b4[4];
              if (US_FP8) { const v2u t_ = *(const GAS v2u*)(UD + (size_t)ul * US_CH + w * US_W + ks * US_KS + lane * US_LN); un4_fp8(t_.x, a4); un4_fp8(t_.y, b4); }
              else { const v4u t_ = *(const GAS v4u*)(UD + (size_t)ul * 32768 + w * 4096 + ks * 1024 + lane * 16); a4[0] = bflo(t_.x); a4[1] = bfhi(t_.x); a4[2] = bflo(t_.y); a4[3] = bfhi(t_.y); b4[0] = bflo(t_.z); b4[1] = bfhi(t_.z); b4[2] = bflo(t_.w); b4[3] = bfhi(t_.w); }
              const f32x4 da = *(const GAS f32x4*)(DECG + (size_t)ul * 128 + 32 * ks + 4 * quad), db = *(const GAS f32x4*)(DECG + (size_t)ul * 128 + 32 * ks + 16 + 4 * quad);
              carry[ks][0] = da * carry[ks][0] + (f32x4){a4[0], a4[1], a4[2], a4[3]}; carry[ks][1] = db * carry[ks][1] + (f32x4){b4[0], b4[1], b4[2], b4[3]}; } } }
#define SC2C_LOAD(u_) do { const int b_ = (u_) >> 9, h_ = ((u_) >> 6) & 7, c_ = (u_) & 63; \
        _Pragma("unroll") for (int j = 0; j < 8; ++j) pg[j] = *(const GAS unsigned*)(G0 + ((size_t)b_ * SEQ + c_ * 64 + 8 * w + j) * D + (size_t)h_ * 128 + 2 * lane); \
        _Pragma("unroll") for (int hh = 0; hh < 2; ++hh) { if (OI_FP8) { if (hh == 0) poi[0] = *(const GAS v4u*)((const unsigned char*)O0 + tile_off(b_, h_, c_, w * 1024 + lane * 16)); } else poi[hh] = *(const GAS v4u*)((const unsigned char*)O0 + tile_off(b_, h_, c_, w * 2048 + hh * 1024 + lane * 16)); } \
        _Pragma("unroll") for (int ks = 0; ks < 4; ++ks) { const bool in_ = (u_) > u_lo;     \
            if (US_FP8) { const v2u t_ = in_ ? *(const GAS v2u*)(UD + (size_t)((u_) - 1) * US_CH + w * US_W + ks * US_KS + lane * US_LN) : (v2u){0u, 0u}; psf[ks] = (v4u){t_.x, t_.y, 0u, 0u}; } \
            else psf[ks] = in_ ? *(const GAS v4u*)(UD + (size_t)((u_) - 1) * 32768 + w * 4096 + ks * 1024 + lane * 16) : (v4u){0u, 0u, 0u, 0u}; \
            pdc[ks][0] = in_ ? *(const GAS f32x4*)(DECG + (size_t)((u_) - 1) * 128 + 32 * ks + 4 * quad) : (f32x4){1.f, 1.f, 1.f, 1.f}; \
            pdc[ks][1] = in_ ? *(const GAS f32x4*)(DECG + (size_t)((u_) - 1) * 128 + 32 * ks + 16 + 4 * quad) : (f32x4){1.f, 1.f, 1.f, 1.f}; } \
        _Pragma("unroll") for (int f = 0; f < 16; ++f) { if (QH_FP8) { const v2u t_ = *(const GAS v2u*)(QHF + (size_t)(u_) * 8192 + f * 512 + lane * 8); pqh[f] = (v4u){t_.x, t_.y, 0u, 0u}; } else pqh[f] = *(const GAS v4u*)(QHF + (size_t)(u_) * 16384 + f * 1024 + lane * 16); } } while (0)
    SC2C_LOAD(u_lo);
    for (int u = u_lo; u < u_hi; ++u) {
        const int b = u >> 9, h = (u >> 6) & 7, c = u & 63;
        const size_t gcol = (size_t)h * 128 + 2 * lane;
        unsigned cg[8];
#pragma unroll
        for (int j = 0; j < 8; ++j) cg[j] = pg[j];
        v4u sfb[4];
#pragma unroll
        for (int ks = 0; ks < 4; ++ks) { float a4[4], b4[4];
            if (US_FP8) { un4_fp8(psf[ks].x, a4); un4_fp8(psf[ks].y, b4); }
            else { a4[0] = bflo(psf[ks].x); a4[1] = bfhi(psf[ks].x); a4[2] = bflo(psf[ks].y); a4[3] = bfhi(psf[ks].y); b4[0] = bflo(psf[ks].z); b4[1] = bfhi(psf[ks].z); b4[2] = bflo(psf[ks].w); b4[3] = bfhi(psf[ks].w); }
#pragma unroll
            for (int e = 0; e < 4; ++e) { a4[e] += pdc[ks][0][e] * carry[ks][0][e]; b4[e] += pdc[ks][1][e] * carry[ks][1][e]; }
            sfb[ks] = (v4u){cvtpk(a4[0], a4[1]), cvtpk(a4[2], a4[3]), cvtpk(b4[0], b4[1]), cvtpk(b4[2], b4[3])}; }
        f32x4 oacc[4];
#pragma unroll
        for (int mi = 0; mi < 4; ++mi) { if (OI_FP8) { float t4[4]; un4_fp8(mi == 0 ? poi[0].x : mi == 1 ? poi[0].y : mi == 2 ? poi[0].z : poi[0].w, t4); oacc[mi] = (f32x4){t4[0], t4[1], t4[2], t4[3]}; }
            else { const unsigned lo = mi & 1 ? poi[mi >> 1].z : poi[mi >> 1].x, hi2 = mi & 1 ? poi[mi >> 1].w : poi[mi >> 1].y; oacc[mi] = (f32x4){bflo(lo), bfhi(lo), bflo(hi2), bfhi(hi2)}; } }
#pragma unroll
        for (int mi = 0; mi < 4; ++mi)
#pragma unroll
            for (int ks = 0; ks < 4; ++ks) { v4u qa = pqh[mi * 4 + ks];
                if (QH_FP8) { float a4[4], b4[4]; un4_fp8(qa.x, a4); un4_fp8(qa.y, b4); qa = (v4u){cvtpk(a4[0], a4[1]), cvtpk(a4[2], a4[3]), cvtpk(b4[0], b4[1]), cvtpk(b4[2], b4[3])}; }
                oacc[mi] = __builtin_amdgcn_mfma_f32_16x16x32_bf16(__builtin_bit_cast(bf16x8, qa), __builtin_bit_cast(bf16x8, sfb[ks]), oacc[mi], 0, 0, 0); }
        if (u + 1 < u_hi) SC2C_LOAD(u + 1);
#pragma unroll
        for (int mi = 0; mi < 4; ++mi)
#pragma unroll
            for (int j = 0; j < 4; ++j) { const float v = oacc[mi][j]; const float q = row16_sum(v * v);
                const int t = 16 * mi + 4 * quad + j;
                if (row16 == 0) SS[t * 8 + w] = q;
                *(LAS float*)(L + SC_OUT + t * 528 + (16 * w + row16) * 4) = v; }
        LDS_BAR();
        const float ng0 = norm_g[h * 128 + 2 * lane], ng1 = norm_g[h * 128 + 2 * lane + 1];
#pragma unroll
        for (int j = 0; j < 8; ++j) { const int r = 8 * w + j;
            const f32x4 sa = *(const LAS f32x4*)(SS + r * 8), sb = *(const LAS f32x4*)(SS + r * 8 + 4);
            const float rstd = __builtin_amdgcn_rsqf((((sa.x + sa.y) + (sa.z + sa.w)) + ((sb.x + sb.y) + (sb.z + sb.w))) * (1.0f / 128.0f) + RMS_EPS);
            const f32x2 v = *(const LAS f32x2*)(L + SC_OUT + r * 528 + 8 * lane);
            *(GAS unsigned*)(O0 + ((size_t)b * SEQ + c * 64 + r) * D + gcol) = cvtpk(v.x * rstd * ng0 * pg8::sigmoidf_(bflo(cg[j])), v.y * rstd * ng1 * pg8::sigmoidf_(bfhi(cg[j]))); }
        LDS_BAR();
    }
#undef SC2C_LOAD
}

constexpr int RT_WT = 0, RT_LCNT = 65536, RT_LBASE = RT_LCNT + 64, RT_INFO = RT_LBASE + 64, RT_LG = RT_INFO + 3072;
static_assert(RT_LG + 8192 <= RING_BYTES, "router LDS map");
template <bool RB16, int RESMODE> __device__ __forceinline__ void ln_router_phase(Frame& F, const float* R, const void* res, const float* lng, const float* lnb, const float* router_w, const float* router_b,
                                                bf16* X1B, unsigned char* X18, gu32* cnt, int* DEST, float* GATE) {
    LAS unsigned char* L = F.lds + RING_OFF;
    LAS float* WT = (LAS float*)(L + RT_WT); LAS int* lcnt = (LAS int*)(L + RT_LCNT); LAS int* lbase = (LAS int*)(L + RT_LBASE); LAS int* info = (LAS int*)(L + RT_INFO); LAS float* LG = (LAS float*)(L + RT_LG);
    for (int idx = F.tid; idx < 16 * D; idx += NWAVES * 64) { const int col = idx >> 4, e = idx & 15; WT[e * D + col] = router_w[idx]; }
    if (F.tid < 16) lcnt[F.tid] = 0;
    f32x4 gv[4], bv[4];
#pragma unroll
    for (int j = 0; j < 4; ++j) { gv[j] = *(const f32x4*)(lng + 4 * F.lane + 256 * j); bv[j] = *(const f32x4*)(lnb + 4 * F.lane + 256 * j); }
    __syncthreads();
    const int lane = F.lane;
    for (int base = F.vcu * 128; base < M; base += F.G * 128) {
        f32x4 v[4][4];
#define LNR_LOAD(it_) do { const int lr0_ = F.wave * 16 + (it_) * 4; \
            _Pragma("unroll") for (int r = 0; r < 4; ++r) { \
                if (RB16 || RESMODE) { const GAS v2u* xr = (const GAS v2u*)((const bf16*)R + (size_t)(base + lr0_ + r) * D) + lane; \
                    _Pragma("unroll") for (int j = 0; j < 4; ++j) { const v2u t = xr[64 * j]; v[r][j] = (f32x4){bflo(t.x), bfhi(t.x), bflo(t.y), bfhi(t.y)}; } } \
                else { const GAS f32x4* xr = (const GAS f32x4*)(R + (size_t)(base + lr0_ + r) * D) + lane; \
                    _Pragma("unroll") for (int j = 0; j < 4; ++j) v[r][j] = xr[64 * j]; } \
                if (RESMODE == 1) { const GAS f32x4* rr = (const GAS f32x4*)((const float*)res + (size_t)(base + lr0_ + r) * D) + lane;     \
                    _Pragma("unroll") for (int j = 0; j < 4; ++j) v[r][j] = rr[64 * j] * DN_ALPHA + v[r][j]; } \
                if (RESMODE == 2) { const GAS v2u* rr = (const GAS v2u*)((const bf16*)res + (size_t)(base + lr0_ + r) * D) + lane; \
                    _Pragma("unroll") for (int j = 0; j < 4; ++j) { const v2u t = rr[64 * j]; v[r][j] = (f32x4){bflo(t.x), bfhi(t.x), bflo(t.y), bfhi(t.y)} * DN_ALPHA + v[r][j]; } } } \
        } while (0)
        LNR_LOAD(0);
#pragma unroll 1
        for (int it = 0; it < 4; ++it) {
            const int lr0 = F.wave * 16 + it * 4;
#pragma unroll
            for (int r = 0; r < 4; ++r) { float s = 0.f;
#pragma unroll
                for (int j = 0; j < 4; ++j) s += (v[r][j].x + v[r][j].y) + (v[r][j].z + v[r][j].w);
                const float mean = wave_sum(s) * (1.f / D); float s2 = 0.f;
#pragma unroll
                for (int j = 0; j < 4; ++j) { v[r][j] = v[r][j] - mean; s2 += (v[r][j].x * v[r][j].x + v[r][j].y * v[r][j].y) + (v[r][j].z * v[r][j].z + v[r][j].w * v[r][j].w); }
                const float rstd = 1.f / sqrtf(wave_sum(s2) * (1.f / D) + LN_EPS);
                GAS v2u* o8 = (GAS v2u*)(X1B + (size_t)(base + lr0 + r) * D) + lane;
#pragma unroll
                for (int j = 0; j < 4; ++j) { v[r][j] = v[r][j] * rstd * gv[j] + bv[j]; v2u o; o.x = pk2(v[r][j].x, v[r][j].y); o.y = pk2(v[r][j].z, v[r][j].w); o8[64 * j] = o;
                    if (X18) { int w8 = 0; w8 = __builtin_amdgcn_cvt_pk_fp8_f32(v[r][j].x, v[r][j].y, w8, false); w8 = __builtin_amdgcn_cvt_pk_fp8_f32(v[r][j].z, v[r][j].w, w8, true);
                        *(GAS unsigned*)(X18 + (size_t)(base + lr0 + r) * D + 4 * lane + 256 * j) = (unsigned)w8; } } }
            float val[64];
#pragma unroll
            for (int e = 0; e < 16; ++e) { f32x4 wv[4];
#pragma unroll
                for (int j = 0; j < 4; ++j) wv[j] = *(const LAS f32x4*)(WT + e * D + 4 * lane + 256 * j);
#pragma unroll
                for (int r = 0; r < 4; ++r) { float p = 0.f;
#pragma unroll
                    for (int j = 0; j < 4; ++j) p += (v[r][j].x * wv[j].x + v[r][j].y * wv[j].y) + (v[r][j].z * wv[j].z + v[r][j].w * wv[j].w);
                    val[r * 16 + e] = p; } }
#pragma unroll
            for (int st = 0; st < 6; ++st) { const int m = 32 >> st, n = 64 >> st; const bool up = (lane & m) != 0;
                if (st == 2) { if (it + 1 < 4) LNR_LOAD(it + 1); }
#pragma unroll
                for (int i = 0; i < n / 2; ++i) { const float a = val[i], b2 = val[i + n / 2]; const float keep = up ? b2 : a, send = up ? a : b2; val[i] = keep + __shfl_xor(send, m); } }
            LG[(lr0 + (lane >> 4)) * 16 + (lane & 15)] = val[0];
        }
#undef LNR_LOAD
        LDS_WAIT(); asm volatile("" ::: "memory");
        if (lane < 16) {
            const int lr = F.wave * 16 + lane;
            float lg[16];
#pragma unroll
            for (int q = 0; q < 4; ++q) { const f32x4 t = *(const LAS f32x4*)(LG + lr * 16 + 4 * q); lg[4 * q] = t.x; lg[4 * q + 1] = t.y; lg[4 * q + 2] = t.z; lg[4 * q + 3] = t.w; }
            float mx = lg[0];
#pragma unroll
            for (int e = 1; e < 16; ++e) mx = fmaxf(mx, lg[e]);
            float pe[16], sum = 0.f;
#pragma unroll
            for (int e = 0; e < 16; ++e) { pe[e] = __expf(lg[e] - mx); sum += pe[e]; }
            const float inv = 1.0f / sum; float sel[16];
#pragma unroll
            for (int e = 0; e < 16; ++e) { pe[e] *= inv; sel[e] = pe[e] + router_b[e]; }
            float gs[4];
#pragma unroll
            for (int g = 0; g < 4; ++g) { const float a = sel[4 * g], b2 = sel[4 * g + 1], c2 = sel[4 * g + 2], d2 = sel[4 * g + 3];
                const float hi1 = fmaxf(a, b2), lo1 = fminf(a, b2), hi2 = fmaxf(c2, d2), lo2 = fminf(c2, d2);
                gs[g] = fmaxf(hi1, hi2) + fmaxf(fminf(hi1, hi2), fmaxf(lo1, lo2)); }
            int gb = 0; float gbv = gs[0];
#pragma unroll
            for (int g = 1; g < 4; ++g) if (gs[g] > gbv) { gbv = gs[g]; gb = g; }
            float s4[4], p4[4];
#pragma unroll
            for (int k = 0; k < 4; ++k) { s4[k] = gb == 0 ? sel[k] : gb == 1 ? sel[4 + k] : gb == 2 ? sel[8 + k] : sel[12 + k]; p4[k] = gb == 0 ? pe[k] : gb == 1 ? pe[4 + k] : gb == 2 ? pe[8 + k] : pe[12 + k]; }
            int i0 = 0; float b0 = s4[0];
#pragma unroll
            for (int k = 1; k < 4; ++k) if (s4[k] > b0) { b0 = s4[k]; i0 = k; }
            int i1 = -1; float b1 = -INFINITY;
#pragma unroll
            for (int k = 0; k < 4; ++k) if (k != i0 && (i1 < 0 || s4[k] > b1)) { b1 = s4[k]; i1 = k; }
            const float q0 = i0 == 0 ? p4[0] : i0 == 1 ? p4[1] : i0 == 2 ? p4[2] : p4[3], q1 = i1 == 0 ? p4[0] : i1 == 1 ? p4[1] : i1 == 2 ? p4[2] : p4[3];
            const float den = 1.0f / (q0 + q1);
            const int e0 = gb * 4 + i0, e1 = gb * 4 + i1;
            const int p0 = __hip_atomic_fetch_add(lcnt + e0, 1, __ATOMIC_RELAXED, __HIP_MEMORY_SCOPE_WORKGROUP), p1 = __hip_atomic_fetch_add(lcnt + e1, 1, __ATOMIC_RELAXED, __HIP_MEMORY_SCOPE_WORKGROUP);
            info[lr] = e0; info[128 + lr] = e1; info[256 + lr] = p0; info[384 + lr] = p1; info[512 + lr] = __float_as_int(q0 * den); info[640 + lr] = __float_as_int(q1 * den);
        }
        __syncthreads();
        if (F.tid < 16) { const int n = lcnt[F.tid]; lbase[F.tid] = n ? (int)__hip_atomic_fetch_add(cnt + 64 * F.tid, (unsigned)n, RLX_AGENT) : 0; }
        __syncthreads();
        if (F.tid < 128) { const int lr = F.tid, row = base + lr; const int e0 = info[lr], e1 = info[128 + lr];
            const int d0 = e0 * ECAP + lbase[e0] + info[256 + lr], d1 = e1 * ECAP + lbase[e1] + info[384 + lr];
            DEST[d0] = row * 2; GATE[d0] = __int_as_float(info[512 + lr]); DEST[d1] = row * 2 + 1; GATE[d1] = __int_as_float(info[640 + lr]); }
        __syncthreads();
        if (F.tid < 16) lcnt[F.tid] = 0;
        __syncthreads();
    }
}
__device__ __forceinline__ int moe_table(Frame& F, gu32* cnt) {
    LAS int* tab = (LAS int*)(F.lds + MOETAB_OFF);
    __syncthreads();
    if (F.wave == 0) {
        const int e = F.lane & 15; const int n = (int)__hip_atomic_load(cnt + 64 * e, RLX_AGENT); const int nt = (n + 255) >> 8;
        int incl = nt;
#pragma unroll
        for (int d = 1; d < 16; d <<= 1) { const int t = __shfl_up(incl, d, 16); if (e >= d) incl += t; }
        if (F.lane < 16) { tab[e] = incl - nt; tab[17 + e] = (incl - nt) * 256; tab[34 + e] = n; if (e == 15) { tab[16] = incl; tab[33] = incl * 256; } }
    }
    __syncthreads();
    return tab[16] * 4;
}
struct Ln2Raw { v4u a[2], y0[2], y1[2]; };
template <bool Y8> __device__ __forceinline__ void ln2_load(Ln2Raw& r, const bf16* X1B, const bf16* Y2, int m, int lane) {
#pragma unroll
    for (int j = 0; j < 2; ++j) { const size_t c = 8 * lane + 512 * j;
        r.a[j] = *(const GAS v4u*)(X1B + (size_t)m * D + c);
        if (Y8) { const v2u t0 = *(const GAS v2u*)((const unsigned char*)Y2 + (size_t)(2 * m) * D + c), t1 = *(const GAS v2u*)((const unsigned char*)Y2 + (size_t)(2 * m + 1) * D + c);
            r.y0[j] = (v4u){t0.x, t0.y, 0u, 0u}; r.y1[j] = (v4u){t1.x, t1.y, 0u, 0u}; }
        else { r.y0[j] = *(const GAS v4u*)(Y2 + (size_t)(2 * m) * D + c); r.y1[j] = *(const GAS v4u*)(Y2 + (size_t)(2 * m + 1) * D + c); } }
}
template <bool FINAL, bool Y8 = false> __device__ __forceinline__ void ln2_phase(Frame& F, const bf16* X1B, const bf16* Y2, const float* lng, const float* lnb, bf16* XOUT, float* out, unsigned char* X8 = nullptr) {
    float gv[16], bv[16];
#pragma unroll
    for (int j = 0; j < 2; ++j)
#pragma unroll
        for (int i = 0; i < 8; ++i) { gv[8 * j + i] = lng[8 * F.lane + 512 * j + i]; bv[8 * j + i] = lnb[8 * F.lane + 512 * j + i]; }
    const int gw = F.vcu * NWAVES + F.wave, NGW = F.G * NWAVES;
    Ln2Raw cur, nxt;
    if (gw < M) ln2_load<Y8>(cur, X1B, Y2, gw, F.lane);
    for (int m = gw; m < M; m += NGW) {
        if (m + NGW < M) ln2_load<Y8>(nxt, X1B, Y2, m + NGW, F.lane);
        float v[16]; float s = 0.f;
#pragma unroll
        for (int j = 0; j < 2; ++j) { const v4u a = cur.a[j];
            if (Y8) { float p0[4], p1[4], q0[4], q1[4]; un4_fp8(cur.y0[j].x, p0); un4_fp8(cur.y0[j].y, p1); un4_fp8(cur.y1[j].x, q0); un4_fp8(cur.y1[j].y, q1);
#pragma unroll
                for (int i = 0; i < 4; ++i) { const float ya = i < 2 ? (p0[2 * i] + q0[2 * i]) : (p1[2 * i - 4] + q1[2 * i - 4]), yb = i < 2 ? (p0[2 * i + 1] + q0[2 * i + 1]) : (p1[2 * i - 3] + q1[2 * i - 3]);
                    v[8 * j + 2 * i] = DN_ALPHA * bflo(a[i]) + ya; v[8 * j + 2 * i + 1] = DN_ALPHA * bfhi(a[i]) + yb; } }
            else { const v4u y0 = cur.y0[j], y1 = cur.y1[j];
#pragma unroll
                for (int i = 0; i < 4; ++i) { v[8 * j + 2 * i] = DN_ALPHA * bflo(a[i]) + (bflo(y0[i]) + bflo(y1[i])); v[8 * j + 2 * i + 1] = DN_ALPHA * bfhi(a[i]) + (bfhi(y0[i]) + bfhi(y1[i])); } } }
#pragma unroll
        for (int i = 0; i < 16; ++i) s += v[i];
        const float mean = wave_sum(s) * (1.f / D); float s2 = 0.f;
#pragma unroll
        for (int i = 0; i < 16; ++i) { v[i] -= mean; s2 += v[i] * v[i]; }
        const float rstd = 1.f / sqrtf(wave_sum(s2) * (1.f / D) + LN_EPS);
#pragma unroll
        for (int i = 0; i < 16; ++i) v[i] = v[i] * rstd * gv[i] + bv[i];
#pragma unroll
        for (int j = 0; j < 2; ++j) { const size_t c = (size_t)m * D + 8 * F.lane + 512 * j;
            if (FINAL) { *(GAS f32x4*)(out + c) = (f32x4){v[8 * j], v[8 * j + 1], v[8 * j + 2], v[8 * j + 3]}; *(GAS f32x4*)(out + c + 4) = (f32x4){v[8 * j + 4], v[8 * j + 5], v[8 * j + 6], v[8 * j + 7]}; }
            else { *(GAS v4u*)(XOUT + c) = (v4u){pk2(v[8 * j], v[8 * j + 1]), pk2(v[8 * j + 2], v[8 * j + 3]), pk2(v[8 * j + 4], v[8 * j + 5]), pk2(v[8 * j + 6], v[8 * j + 7])};
                if (X8) { int w0 = 0, w1 = 0; w0 = __builtin_amdgcn_cvt_pk_fp8_f32(v[8 * j], v[8 * j + 1], w0, false); w0 = __builtin_amdgcn_cvt_pk_fp8_f32(v[8 * j + 2], v[8 * j + 3], w0, true);
                    w1 = __builtin_amdgcn_cvt_pk_fp8_f32(v[8 * j + 4], v[8 * j + 5], w1, false); w1 = __builtin_amdgcn_cvt_pk_fp8_f32(v[8 * j + 6], v[8 * j + 7], w1, true); *(GAS v2u*)(X8 + c) = (v2u){(unsigned)w0, (unsigned)w1}; } } }
        cur = nxt;
    }
}
__device__ __forceinline__ void combine_phase(Frame& F, const bf16* O1, const bf16* O2, const float* subln_g, const float* tab, bf16* OA) {
    const float lam = tab[1024];
    float gv[8];
#pragma unroll
    for (int i = 0; i < 8; ++i) gv[i] = subln_g[8 * (F.lane & 15) + i] * (1.0f - LAMBDA_INIT);
    const int gw = F.vcu * NWAVES + F.wave, NGW = F.G * NWAVES;
    for (int m = gw; m < M; m += NGW) {
#pragma unroll
        for (int j = 0; j < 2; ++j) { const size_t c = (size_t)m * D + 8 * F.lane + 512 * j;
            const v4u a = *(const GAS v4u*)(O1 + c), b2 = *(const GAS v4u*)(O2 + c); float v[8]; float q = 0.f;
#pragma unroll
            for (int i = 0; i < 4; ++i) { v[2 * i] = bflo(a[i]) - lam * bflo(b2[i]); v[2 * i + 1] = bfhi(a[i]) - lam * bfhi(b2[i]); q += v[2 * i] * v[2 * i] + v[2 * i + 1] * v[2 * i + 1]; }
            q += __shfl_xor(q, 1); q += __shfl_xor(q, 2); q += __shfl_xor(q, 4); q += __shfl_xor(q, 8);
            const float rstd = 1.0f / sqrtf(q * (1.0f / 128.0f) + RMS_EPS);
            *(GAS v4u*)(OA + c) = (v4u){pk2(v[0] * rstd * gv[0], v[1] * rstd * gv[1]), pk2(v[2] * rstd * gv[2], v[3] * rstd * gv[3]), pk2(v[4] * rstd * gv[4], v[5] * rstd * gv[5]), pk2(v[6] * rstd * gv[6], v[7] * rstd * gv[7])}; }
    }
}

struct Args { const float* in[19]; float* out; unsigned char* ws; int ph_lo, ph_hi, li, pad; };
__global__ void __launch_bounds__(NWAVES * 64, 2) yoco_fwd(Args args) {
    extern __shared__ __attribute__((aligned(16))) unsigned char lds[];
    Frame F;
    F.lds = (LAS unsigned char*)lds;
    F.tid = threadIdx.x; F.lane = F.tid & 63; F.wave = __builtin_amdgcn_readfirstlane(F.tid >> 6);
    F.G = gridDim.x; { const int bx = blockIdx.x; F.vcu = (F.G % 8 == 0) ? (bx % 8) * (F.G / 8) + bx / 8 : bx; }
    unsigned char* ws = args.ws;
    F.ctl = (gu32*)(ws + WS_CTL);
    Inputs in;
    in.x = args.in[0]; in.a_w_in = args.in[1]; in.a_lb = args.in[2]; in.a_norm_g = args.in[3]; in.a_w_out = args.in[4]; in.kv_w = args.in[5]; in.b_w_q = args.in[6]; in.b_lam = args.in[7];
    in.b_subln_g = args.in[8]; in.b_w_out = args.in[9]; in.ln1_g = args.in[10]; in.ln1_b = args.in[11]; in.ln2_g = args.in[12]; in.ln2_b = args.in[13]; in.router_w = args.in[14]; in.router_b = args.in[15];
    in.moe_w_gate = args.in[16]; in.moe_w_up = args.in[17]; in.moe_w_down = args.in[18];
    for (int u = F.tid; u < (LDS_BYTES - LDSCTL_OFF) / 4; u += NWAVES * 64) ((LAS unsigned*)(F.lds + LDSCTL_OFF))[u] = 0u;
    __syncthreads();
    XcdBarrier bar; bar.bar = (unsigned*)(F.ctl + CW_BAR) + args.li * XCD_BAR_WORDS; bar.x = 0; bar.st = nullptr;
    if (N_LAUNCH_MODE == 1) bar = xcd_barrier_post((unsigned*)(F.ctl + CW_BAR) + args.li * XCD_BAR_WORDS, (volatile LAS unsigned*)(F.lds + MISC_OFF) + 8);
    const int lo = args.ph_lo, hi = args.ph_hi;
#ifndef PHASE_MASK
#define PHASE_MASK 0xffff
#endif
#define IN(k) (((PHASE_MASK >> (k)) & 1) && lo <= (k) && (k) < hi)
#define RETID() do { int t_ = threadIdx.x; asm volatile("" : "+v"(t_)); F.tid = t_; F.lane = t_ & 63; } while (0)
#ifndef REPEAT_MASK
#define REPEAT_MASK 0
#endif
#define NREP(k) (((REPEAT_MASK >> (k)) & 1) ? 2 : 1)
#define REP(k) for (int rep_ = 0; rep_ < NREP(k); ++rep_, (rep_ < NREP(k) ? xcd_barrier(bar) : (void)0))
#ifdef DIAG_PHASE
#define SEAM(k) do { if (IN(k) && IN((k) + 1)) xcd_barrier(bar); if (blockIdx.x == 0 && F.tid == 0) ((unsigned long long*)(ws + WS_TAB + 8192))[(k) + 1] = __builtin_amdgcn_s_memrealtime(); } while (0)
#else
#define BARW(j) do { if (SHADOW_CONV && N_LAUNCH_MODE == 1) xcd_barrier_w(bar, [&]() { shadow_convert(F, in, ws, (j)); }); else xcd_barrier(bar); } while (0)
#define SEAM_ORD(k) ((k) <= 1 ? (k) : (k) <= 9 ? (k) + 1 : (k))
#define SEAM(k) do { if (IN(k) && IN((k) + 1)) BARW(SEAM_ORD(k)); } while (0)
#endif
    bf16* const bA = (bf16*)(ws + WS_A); bf16* const bB = (bf16*)(ws + WS_B); bf16* const bC = (bf16*)(ws + WS_C); bf16* const bD = (bf16*)(ws + WS_D); bf16* const bE = (bf16*)(ws + WS_E); bf16* const bF = (bf16*)(ws + WS_F);
    const float* const tab = (const float*)(ws + WS_TAB);
    int* const DEST = (int*)(ws + WS_DEST); float* const GATE = (float*)(ws + WS_GATE);

#ifdef DIAG_PHASE
    if (blockIdx.x == 0 && F.tid == 0) ((unsigned long long*)(ws + WS_TAB + 8192))[0] = __builtin_amdgcn_s_memrealtime();
#endif
    if (IN(0)) REP(0) { RETID(); p0_prologue(F, in, ws); moe_weight_convert(F, in, ws, 0, (SHADOW_CONV && N_LAUNCH_MODE == 1) ? SH_P0 : MOE_NIT, F.vcu * NWAVES + F.wave, F.G * NWAVES); } SEAM(0);
    if (IN(1)) REP(1) { RETID();
        { pg8::Gemm g{bA, (const bf16*)(ws + WS_WIN), D}; pg8::StaticOrder S; S.init(M, proj_count(false) * D, D, F.G, (int)blockIdx.x);
          pg8::EpiProj E{bB, bC, bD, bE, tab, proj_gmap(false)};
          pg8::gemm_phase<pg8::EpiProj, pg8::StaticOrder, true>(F.lds + RING_OFF, g, S, E); }
        if constexpr (FP8_PROJ != 0) {
            __syncthreads();
            pg8::Gemm g{bF, ws + WS_WIN8, D}; pg8::StaticOrder S; S.init(M, proj_count(true) * D, D, F.G, (int)blockIdx.x);
            pg8::EpiProj E{bB, bC, bD, bE, tab, proj_gmap(true)};
            pg8::gemm_phase<pg8::EpiProj, pg8::StaticOrder, true, true>(F.lds + RING_OFF, g, S, E); }
    } SEAM(1);
    if (IN(2)) REP(2) { RETID();
        unsigned char* UD = (unsigned char*)args.out; unsigned char* QHF = (US_FP8 && QH_FP8) ? (unsigned char*)args.out + 64 * MiB : (unsigned char*)bA; float* DECG = (float*)(ws + WS_DEST);
        const int upw = (4096 + F.G - 1) / F.G;
        { const int u0 = F.vcu * upw, u1 = (F.vcu + 1) * upw < 4096 ? (F.vcu + 1) * upw : 4096; scan2a_range(F, u0, u1, bB, bC, bD, UD, QHF, (unsigned char*)bF, DECG); }
#ifdef PROBE_2A
        xcd_barrier(bar);
        { const int u0 = F.vcu * upw, u1 = (F.vcu + 1) * upw < 4096 ? (F.vcu + 1) * upw : 4096; scan2a_range(F, u0, u1, bB, bC, bD, UD, QHF, (unsigned char*)bF, DECG); }
#endif
        BARW(2);
        { const int u0 = F.vcu * upw, u1 = (F.vcu + 1) * upw < 4096 ? (F.vcu + 1) * upw : 4096; scan2c_range(F, u0, u1, UD, QHF, bE, in.a_norm_g, bF, DECG); }
    } SEAM(2);
    if (IN(3)) REP(3) { RETID();
        pg8::Gemm g{bF, (const bf16*)(ws + WS_WOUT), D}; pg8::StaticOrder S; S.init(M, D, D, F.G, (int)blockIdx.x);
        if constexpr (MIX_SPLIT) { pg8::EpiBf16 E{bB, D, 0, 0, 1.0f}; pg8::gemm_phase<pg8::EpiBf16, pg8::StaticOrder, true>(F.lds + RING_OFF, g, S, E); }
#ifndef XRES_BF16
#define XRES_BF16 1
#endif
        else if constexpr (XRES_BF16) { pg8::EpiResid<true, R_BF16 != 0> E{bA, (float*)bB, DN_ALPHA}; pg8::gemm_phase<pg8::EpiResid<true, R_BF16 != 0>, pg8::StaticOrder, ALIGN_P3>(F.lds + RING_OFF, g, S, E); }
        else { pg8::EpiResid<false, R_BF16 != 0> E{in.x, (float*)bB, DN_ALPHA}; pg8::gemm_phase<pg8::EpiResid<false, R_BF16 != 0>, pg8::StaticOrder, ALIGN_P3>(F.lds + RING_OFF, g, S, E); }
    } SEAM(3);
#ifdef PROBE_P4
    if (IN(4)) { ln_router_phase<R_BF16 != 0, MIX_SPLIT ? 1 : 0>(F, (const float*)bB, in.x, in.ln1_g, in.ln1_b, in.router_w, in.router_b, bA, nullptr, F.ctl + CW_CNT + 2048, (int*)args.out, (float*)args.out + 16 * ECAP); xcd_barrier(bar); }
#endif
    if (IN(4)) REP(4) { RETID(); ln_router_phase<R_BF16 != 0, MIX_SPLIT == 2 ? 2 : MIX_SPLIT ? 1 : 0>(F, (const float*)bB, MIX_SPLIT == 2 ? (const void*)bA : (const void*)in.x, in.ln1_g, in.ln1_b, in.router_w, in.router_b, bA, FP8_L0 ? (unsigned char*)bF : nullptr, F.ctl + CW_CNT, DEST, GATE); } SEAM(4);
    if (IN(5)) REP(5) { RETID();
        const int total = moe_table(F, F.ctl + CW_CNT);
        pg8::MoeOrder S{(const LAS int*)(F.lds + MOETAB_OFF), F.G, (int)blockIdx.x, total, D, DEST, (size_t)D * D, true, (const LAS int*)(F.lds + RING_OFF + pg8::STAGE_BYTES)};
        S.fill_rows((LAS int*)(F.lds + RING_OFF + pg8::STAGE_BYTES));
        if constexpr (FP8_L0) { pg8::Gemm g{bF, ws + WS_WGU, D}; pg8::EpiGateUp8 E{(unsigned char*)bD}; pg8::gemm_phase<pg8::EpiGateUp8, pg8::MoeOrder, true, true, 1, true>(F.lds + RING_OFF, g, S, E); }
        else { pg8::Gemm g{bA, ws + WS_WGU, D}; pg8::EpiGateUp E{bD}; pg8::gemm_phase<pg8::EpiGateUp, pg8::MoeOrder, true>(F.lds + RING_OFF, g, S, E); }
    } SEAM(5);
    if (IN(6)) REP(6) { RETID();
        const int total = (N_LAUNCH_MODE == 1 && IN(5)) ? ((const LAS int*)(F.lds + MOETAB_OFF))[16] * 4 : moe_table(F, F.ctl + CW_CNT);
        pg8::Gemm g{bD, ws + WS_WD, DEXP};
        pg8::MoeOrder S{(const LAS int*)(F.lds + MOETAB_OFF), F.G, (int)blockIdx.x, total, DEXP, DEST, (size_t)D * DEXP, false, nullptr};
        S.fill_dest((LAS int*)(F.lds + RING_OFF + pg8::STAGE_BYTES), GATE);
        pg8::EpiDown<Y2L0_FP8 != 0> E{bB, DEST, GATE, (const LAS int*)(F.lds + RING_OFF + pg8::STAGE_BYTES)};
        pg8::gemm_phase<pg8::EpiDown<Y2L0_FP8 != 0>, pg8::MoeOrder, true, FP8_L0 != 0, 1, true>(F.lds + RING_OFF, g, S, E);
    } SEAM(6);
    if (IN(7)) REP(7) { RETID(); ln2_phase<false, Y2L0_FP8 != 0>(F, bA, bB, in.ln2_g, in.ln2_b, bF, nullptr, FP8_QKV ? (unsigned char*)bD : nullptr); } SEAM(7);
#ifdef PROBE_BARS
    if (IN(7)) for (int xb = 0; xb < PROBE_BARS; ++xb) xcd_barrier(bar);
#endif
    if (IN(8)) REP(8) { RETID();
        pg8::Gemm g{FP8_QKV ? (const void*)bD : (const void*)bF, ws + WS_WQKV, D}; pg8::StaticOrder S; S.init(M, 3 * D, D, F.G, (int)blockIdx.x);
        pg8::EpiBf16 E{bA, D, D, (size_t)(BUFSZ / 2), 1.0f};
#ifdef PROBE_KREP_P8
        pg8::gemm_phase<pg8::EpiBf16, pg8::StaticOrder, true, FP8_QKV != 0, PROBE_KREP_P8>(F.lds + RING_OFF, g, S, E);
#else
        pg8::gemm_phase<pg8::EpiBf16, pg8::StaticOrder, true, FP8_QKV != 0>(F.lds + RING_OFF, g, S, E);
#endif
    } SEAM(8);
    if (IN(9)) REP(9) { RETID();
        LAS float* gs = (LAS float*)(F.lds + LDSCTL_OFF + 2048);
        { int t9 = F.tid; asm volatile("" : "+v"(t9));
          if (t9 < 128) gs[t9] = in.b_subln_g[t9] * (1.0f - LAMBDA_INIT); }
        __syncthreads();
        const attn_body::DiffTensors AT{(const attn_body::bf16*)bA, (const attn_body::bf16*)bB, (const attn_body::bf16*)bC, (attn_body::bf16*)bD, (const float*)(lds + LDSCTL_OFF + 2048), tab[1024]};
        attn_body::attn_phase<8>((char*)lds + RING_OFF, AT, F.vcu, F.G);
    } SEAM(9);
    if (IN(11)) REP(11) { RETID();
        pg8::Gemm g{bD, (const bf16*)(ws + WS_WBO), D}; pg8::StaticOrder S; S.init(M, D, D, F.G, (int)blockIdx.x);
        if constexpr (MIX_SPLIT) { pg8::EpiBf16 E{bA, D, 0, 0, 1.0f}; pg8::gemm_phase<pg8::EpiBf16, pg8::StaticOrder, true>(F.lds + RING_OFF, g, S, E); }
        else { pg8::EpiResid<true, R_BF16 != 0> E{bF, (float*)bA, DN_ALPHA}; pg8::gemm_phase<pg8::EpiResid<true, R_BF16 != 0>, pg8::StaticOrder, ALIGN_P3, ATTN_OUT_FP8 != 0>(F.lds + RING_OFF, g, S, E); }
    } SEAM(11);
    if (IN(12)) REP(12) { RETID(); ln_router_phase<R_BF16 != 0, MIX_SPLIT ? 2 : 0>(F, (const float*)bA, bF, in.ln1_g + D, in.ln1_b + D, in.router_w, in.router_b, bC, FP8_L1 ? (unsigned char*)bE : nullptr, F.ctl + CW_CNT + 1024, DEST, GATE); } SEAM(12);
    if (IN(13)) REP(13) { RETID();
        const int total = moe_table(F, F.ctl + CW_CNT + 1024);
        pg8::MoeOrder S{(const LAS int*)(F.lds + MOETAB_OFF), F.G, (int)blockIdx.x, total, D, DEST, (size_t)D * D, true, (const LAS int*)(F.lds + RING_OFF + pg8::STAGE_BYTES)};
        S.fill_rows((LAS int*)(F.lds + RING_OFF + pg8::STAGE_BYTES));
        if constexpr (FP8_L1) { pg8::Gemm g{bE, ws + WS_WGU + 32 * MiB, D}; pg8::EpiGateUp8 E{(unsigned char*)bD}; pg8::gemm_phase<pg8::EpiGateUp8, pg8::MoeOrder, true, true, 1, true>(F.lds + RING_OFF, g, S, E); }
        else { pg8::Gemm g{bC, ws + WS_WGU + 32 * MiB, D}; pg8::EpiGateUp E{bD}; pg8::gemm_phase<pg8::EpiGateUp, pg8::MoeOrder, true>(F.lds + RING_OFF, g, S, E); }
    } SEAM(13);
    if (IN(14)) REP(14) { RETID();
        const int total = (N_LAUNCH_MODE == 1 && IN(13)) ? ((const LAS int*)(F.lds + MOETAB_OFF))[16] * 4 : moe_table(F, F.ctl + CW_CNT + 1024);
        pg8::Gemm g{bD, ws + WS_WD + 16 * MiB, DEXP};
        pg8::MoeOrder S{(const LAS int*)(F.lds + MOETAB_OFF), F.G, (int)blockIdx.x, total, DEXP, DEST, (size_t)D * DEXP, false, nullptr};
        S.fill_dest((LAS int*)(F.lds + RING_OFF + pg8::STAGE_BYTES), GATE);
        pg8::EpiDown<Y2L1_FP8 != 0> E{bA, DEST, GATE, (const LAS int*)(F.lds + RING_OFF + pg8::STAGE_BYTES)};
        pg8::gemm_phase<pg8::EpiDown<Y2L1_FP8 != 0>, pg8::MoeOrder, true, FP8_L1 != 0, 1, true>(F.lds + RING_OFF, g, S, E);
    } SEAM(14);
#ifdef DIAG_PHASE
    if (IN(15)) REP(15) { RETID();
        const unsigned long long* ts = (const unsigned long long*)(ws + WS_TAB + 8192);
        const float us = (float)(__hip_atomic_load(ts + DIAG_PHASE + 1, RLX_AGENT) - __hip_atomic_load(ts + DIAG_PHASE, RLX_AGENT)) * 0.01f, cval = sqrtf(us);
        const int gw = F.vcu * NWAVES + F.wave, NGW = F.G * NWAVES;
        for (int m = gw; m < M; m += NGW) { GAS f32x4* o = (GAS f32x4*)(args.out + (size_t)m * D) + F.lane;
#pragma unroll
            for (int j = 0; j < 4; ++j) o[64 * j] = (f32x4){cval, cval, cval, cval}; }
    }
#else
    if (IN(15)) REP(15) { RETID(); ln2_phase<true, Y2L1_FP8 != 0>(F, bC, bA, in.ln2_g + D, in.ln2_b + D, nullptr, args.out); }
#endif
#undef IN
#undef SEAM
}

extern "C" void kernel_launch(void* const* d_in, const int* in_sizes, int n_in, void* d_out, int out_size, void* d_ws, size_t ws_size, hipStream_t stream) {
    static int grid = 0;
    if (grid == 0) {
        if (n_in != 19 || in_sizes[0] != M * D || out_size != M * D || ws_size < WS_END) { fprintf(stderr, "kernel_launch: unexpected shapes (n_in %d, in0 %d, out %d, ws %zu); nothing launched\n", n_in, n_in > 0 ? in_sizes[0] : -1, out_size, ws_size); grid = -1; return; }
        int dev = 0, cus = 0, per_cu = 0;
        if (hipGetDevice(&dev) != hipSuccess || hipDeviceGetAttribute(&cus, hipDeviceAttributeMultiprocessorCount, dev) != hipSuccess) { grid = -1; return; }
        if (hipFuncSetAttribute((const void*)yoco_fwd, hipFuncAttributeMaxDynamicSharedMemorySize, LDS_BYTES) != hipSuccess) { fprintf(stderr, "kernel_launch: hipFuncSetAttribute failed\n"); grid = -1; return; }
        if (hipOccupancyMaxActiveBlocksPerMultiprocessor(&per_cu, (const void*)yoco_fwd, NWAVES * 64, LDS_BYTES) != hipSuccess || per_cu < 1) { fprintf(stderr, "kernel_launch: occupancy query reports %d workgroups per CU\n", per_cu); }
        (void)hipGetLastError();
        grid = cus;
    }
    if (grid < 0) return;
    if (hipMemsetAsync((char*)d_ws + WS_CTL, 0, CTL_ZERO_BYTES, stream) != hipSuccess) return;
    Args a{};
    for (int i = 0; i < 19; ++i) a.in[i] = (const float*)d_in[i];
    a.out = (float*)d_out; a.ws = (unsigned char*)d_ws;
#ifdef PROBE_REPEAT
    if (N_LAUNCH_MODE == 1) { const int cuts[4] = {0, PROBE_REPEAT + 1, PROBE_REPEAT + 1, N_PHASES};
        for (int l = 0; l < 3; ++l) { a.ph_lo = (l == 1) ? PROBE_REPEAT : cuts[l]; a.ph_hi = cuts[l + 1]; a.li = l; if (a.ph_lo < a.ph_hi) hipLaunchKernelGGL(yoco_fwd, dim3(grid), dim3(NWAVES * 64), LDS_BYTES, stream, a); } }
#else
    if (N_LAUNCH_MODE == 1) { a.ph_lo = 0; a.ph_hi = N_PHASES; hipLaunchKernelGGL(yoco_fwd, dim3(grid), dim3(NWAVES * 64), LDS_BYTES, stream, a); }
#endif
    else for (int p = 0; p < N_PHASES; ++p) { a.ph_lo = p; a.ph_hi = p + 1; hipLaunchKernelGGL(yoco_fwd, dim3(grid), dim3(NWAVES * 64), LDS_BYTES, stream, a); }
}
```

```cpp
#include <hip/hip_runtime.h>
#include <hip/hip_bf16.h>
#include <cstdio>
#include <cstdint>
#include <cmath>

namespace pg8 {
#define PG8_LAS __attribute__((address_space(3)))
typedef unsigned short bf16_t;
typedef short bf16x8 __attribute__((ext_vector_type(8)));
typedef float f32x4 __attribute__((ext_vector_type(4)));
typedef float f32x2 __attribute__((ext_vector_type(2)));
typedef unsigned u32x4 __attribute__((ext_vector_type(4)));
typedef unsigned u32x2 __attribute__((ext_vector_type(2)));
constexpr int BM = 256, BK = 64, HALF = 128, HTB = HALF * BK * 2  , STAGE_BYTES = 8 * HTB, NXCD = 8, WGM = 8;

__host__ __device__ __forceinline__ int lds_byte(int r, int c) { const int st = (r >> 4) * 2 + (c >> 5), rr = r & 15, cc = c & 31, ob = rr * 64 + cc * 2; return st * 1024 + (ob ^ (((ob >> 9) & 1) << 5)); }
__host__ __device__ __forceinline__ void stage_rc(int b, int& R, int& C) { const int st = b / 1024, sb = b % 1024, swz = sb ^ (((sb >> 9) & 1) << 5); R = (st >> 1) * 16 + swz / 64; C = (st & 1) * 32 + (swz % 64) / 2; }
__host__ __device__ __forceinline__ int perm32(int rho) { const int n = rho >> 4, i = rho & 15; return 8 * (i >> 2) + 4 * n + (i & 3); }

struct Unit { int pm, pn, e, row0, cnt, slot0, qm; };
struct Gemm { const void* A; const void* Bt; int K; };
typedef int v8i_t __attribute__((ext_vector_type(8)));
typedef int v4i_t __attribute__((ext_vector_type(4)));

struct StaticOrder {
    int nM, nN, nwg, G, c, K;
    __device__ void init(int M, int N, int K_, int G_, int c_) { nM = M / BM; nN = N / BM; nwg = nM * nN; G = G_; c = c_; K = K_; }
    __device__ bool next(int i, Unit& u) const {
        const long L = (long)i * G + c; if (L >= nwg) return false;
        int wgid = (int)L; { const int q = nwg / NXCD, r = nwg % NXCD, xcd = wgid % NXCD, off = wgid / NXCD; wgid = (xcd < r ? xcd * (q + 1) : r * (q + 1) + (xcd - r) * q) + off; }
        const int nig = WGM * nN, gid = wgid / nig, fm = gid * WGM, gsz = (nM - fm) < WGM ? (nM - fm) : WGM;
        u.pm = fm + ((wgid % nig) % gsz); u.pn = (wgid % nig) / gsz; u.e = 0; u.row0 = 0; u.cnt = BM; u.slot0 = u.pm * BM; u.qm = 15; return true;
    }
    __device__ __forceinline__ int a_row(const Unit& u, int r) const { return u.pm * BM + r; }
    __device__ __forceinline__ size_t b_off(const Unit& u) const { return (size_t)u.pn * BM * K; }
};
#ifndef MOE_QUARTERS
#define MOE_QUARTERS 1
#endif
struct MoeOrder {
    const PG8_LAS int* tab; int G, c, total, K; const int* dest; size_t wstride; bool gather; const PG8_LAS int* rows;
    __device__ bool next(int i, Unit& u) const {
        const int nfr = total / G, rem = total - nfr * G; int L, qm = 15;
        if (i < nfr) L = i * G + c;
        else if (i > nfr || rem == 0) return false;
        else if (MOE_QUARTERS && 4 * rem <= G) { if ((c >> 2) >= rem) return false; L = nfr * G + (c >> 2); qm = 1 << (c & 3); }
        else if (MOE_QUARTERS && 2 * rem <= G) { if ((c >> 1) >= rem) return false; L = nfr * G + (c >> 1); qm = (c & 1) ? 12 : 3; }
        else { L = nfr * G + c; if (L >= total) return false; }
        const int rt = L >> 2; int e = 0;
#pragma unroll
        for (int j = 1; j < 16; ++j) e += (rt >= tab[j]) ? 1 : 0;
        u.e = e; u.row0 = (rt - tab[e]) * BM; u.cnt = tab[34 + e]; u.slot0 = tab[17 + e] + u.row0; u.pm = i  ; u.pn = L & 3; u.qm = qm;
        if (qm != 15) { const int q0 = (qm & 3) ? ((qm & 1) ? 0 : 64) : ((qm & 4) ? 128 : 192); if (u.row0 + q0 >= u.cnt) return false; }
        return true;
    }
    __device__ __forceinline__ int a_row(const Unit& u, int r) const {
        if (!gather) return u.slot0 + r;
        return rows[(u.pm & 7) * BM + r];
    }
    __device__ __forceinline__ void fill_rows(PG8_LAS int* rows_w) const {
        for (int q = threadIdx.x; q < 8 * BM; q += 512) { Unit u; int v = 0;
            if (next(q >> 8, u)) { const int idx = u.row0 + (q & 255); v = idx < u.cnt ? (dest[u.e * 32768 + idx] >> 1) : 0; }
            rows_w[q] = v; }
        __syncthreads();
    }
    __device__ __forceinline__ void fill_dest(PG8_LAS int* dg_w, const float* gate) const {
        for (int q = threadIdx.x; q < 5 * BM; q += 512) { Unit u; int d = -1, gb = 0;
            if (next(q >> 8, u)) { const int idx = u.row0 + (q & 255); if (idx < u.cnt) { d = dest[u.e * 32768 + idx]; gb = __float_as_int(gate[u.e * 32768 + idx]); } }
            dg_w[2 * q] = d; dg_w[2 * q + 1] = gb; }
        __syncthreads();
    }
    __device__ __forceinline__ size_t b_off(const Unit& u) const { return (size_t)u.e * wstride + (size_t)u.pn * BM * K; }
};

__device__ __forceinline__ unsigned cvt_pk_bf16(float lo, float hi) { unsigned r; asm volatile("v_cvt_pk_bf16_f32 %0, %1, %2" : "=v"(r) : "v"(lo), "v"(hi)); return r; }
__device__ __forceinline__ float bf_lo(unsigned u) { return __uint_as_float(u << 16); }
__device__ __forceinline__ float bf_hi(unsigned u) { return __uint_as_float(u & 0xffff0000u); }
__device__ __forceinline__ float sigmoidf_(float x) { return __builtin_amdgcn_rcpf(1.0f + __expf(-x)); }
__device__ __forceinline__ unsigned cvt_pk_f16(float lo, float hi) { typedef __fp16 h2 __attribute__((ext_vector_type(2))); h2 v = __builtin_amdgcn_cvt_pkrtz(lo, hi); return __builtin_bit_cast(unsigned, v); }

#ifndef EPI_NT
#define EPI_NT 0
#endif
template <class V> __device__ __forceinline__ void epi_st(V* p, const V v) {
    if (EPI_NT == 1) __builtin_nontemporal_store(v, p);
    else if (EPI_NT == 2) { if constexpr (sizeof(V) == 16) asm volatile("global_store_dwordx4 %0, %1, off sc1\n\ts_nop 0" :: "v"(p), "v"(v) : "memory"); else asm volatile("global_store_dwordx2 %0, %1, off sc1\n\ts_nop 0" :: "v"(p), "v"(v) : "memory"); }
    else if (EPI_NT == 3) { if constexpr (sizeof(V) == 16) asm volatile("global_store_dwordx4 %0, %1, off sc0 sc1\n\ts_nop 0" :: "v"(p), "v"(v) : "memory"); else asm volatile("global_store_dwordx2 %0, %1, off sc0 sc1\n\ts_nop 0" :: "v"(p), "v"(v) : "memory"); }
    else *p = v; }
struct EpiBf16 {
    static constexpr int NST = 16; static constexpr bool PERM = true;
    bf16_t* O; int ldc; int split_cols; size_t split_stride; float scale0;
    __device__ __forceinline__ void operator()(const f32x4 (&acc)[2][2][4][2], const Unit& u, int wr, int wc, int fr, int fq) const {
        const int row0 = u.pm * BM + wr * 64 + fr; int colt = u.pn * BM; bf16_t* base = O;
        float sc = 1.f; if (split_cols) { const int t = colt / split_cols; base += (size_t)t * split_stride; colt -= t * split_cols; if (t == 0) sc = scale0; }
        const int col0 = colt + wc * 32 + 8 * fq;
#pragma unroll
        for (int ai = 0; ai < 2; ++ai)
#pragma unroll
            for (int m = 0; m < 4; ++m) { bf16_t* rowp = base + (size_t)(row0 + ai * HALF + m * 16) * ldc + col0;
#pragma unroll
                for (int bj = 0; bj < 2; ++bj) { const f32x4 v0 = acc[ai][bj][m][0] * sc, v1 = acc[ai][bj][m][1] * sc;
                    u32x4 w; w.x = cvt_pk_bf16(v0[0], v0[1]); w.y = cvt_pk_bf16(v0[2], v0[3]); w.z = cvt_pk_bf16(v1[0], v1[1]); w.w = cvt_pk_bf16(v1[2], v1[3]);
                    epi_st((u32x4*)(rowp + bj * HALF), w); } }
    }
};
struct EpiProj {
    static constexpr int NST = 16; static constexpr bool PERM = true;
    bf16_t *Q, *LF, *V, *G; const float* lb; int gmap;
    __device__ __forceinline__ void operator()(const f32x4 (&acc)[2][2][4][2], const Unit& u, int wr, int wc, int fr, int fq) const {
        const int grp = (gmap >> (4 * (u.pn >> 2))) & 15, row0 = u.pm * BM + wr * 64 + fr, col0 = (u.pn & 3) * BM + wc * 32 + 8 * fq;
        bf16_t* base = grp == 0 ? Q : grp == 1 ? LF : grp == 2 ? V : G;
        f32x4 lbv[2][2];
#pragma unroll
        for (int bj = 0; bj < 2; ++bj)
#pragma unroll
            for (int n = 0; n < 2; ++n) lbv[bj][n] = *(const f32x4*)(lb + col0 + bj * HALF + 4 * n);
#pragma unroll
        for (int ai = 0; ai < 2; ++ai)
#pragma unroll
            for (int m = 0; m < 4; ++m) { bf16_t* rowp = base + (size_t)(row0 + ai * HALF + m * 16) * 1024 + col0;
#pragma unroll
                for (int bj = 0; bj < 2; ++bj) { f32x4 v[2] = {acc[ai][bj][m][0], acc[ai][bj][m][1]}; u32x4 w;
                    if (grp == 1) {
#pragma unroll
                        for (int n = 0; n < 2; ++n)
#pragma unroll
                            for (int j = 0; j < 4; ++j) { const float l = lbv[bj][n][j]; v[n][j] = l + (1.0f - l) * sigmoidf_(v[n][j]); }
                        w.x = cvt_pk_f16(v[0][0], v[0][1]); w.y = cvt_pk_f16(v[0][2], v[0][3]); w.z = cvt_pk_f16(v[1][0], v[1][1]); w.w = cvt_pk_f16(v[1][2], v[1][3]);
                    } else {
                        w.x = cvt_pk_bf16(v[0][0], v[0][1]); w.y = cvt_pk_bf16(v[0][2], v[0][3]); w.z = cvt_pk_bf16(v[1][0], v[1][1]); w.w = cvt_pk_bf16(v[1][2], v[1][3]);
                    }
                    epi_st((u32x4*)(rowp + bj * HALF), w); } }
    }
};
template <bool RES_BF16, bool OUT_BF16 = false> struct EpiResid {
    static constexpr int NST = 8; static constexpr bool PERM = false;
    const void* res; float* R; float alpha;
    __device__ __forceinline__ void operator()(const f32x4 (&acc)[2][2][4][2], const Unit& u, int wr, int wc, int fr, int fq) const {
        const int row0 = u.pm * BM + wr * 64 + fr, col0 = u.pn * BM + wc * 32 + 4 * fq;
#pragma unroll
        for (int ai = 0; ai < 2; ++ai)
#pragma unroll
          for (int mp = 0; mp < 2; ++mp) {
            f32x4 rv[2][2][2];
#pragma unroll
            for (int mm = 0; mm < 2; ++mm) { const size_t off = (size_t)(row0 + ai * HALF + (2 * mp + mm) * 16) * 1024 + col0;
#pragma unroll
                for (int bj = 0; bj < 2; ++bj)
#pragma unroll
                    for (int n = 0; n < 2; ++n) { const size_t o = off + bj * HALF + n * 16;
                        if (RES_BF16) { const u32x2 p = *(const u32x2*)((const bf16_t*)res + o); rv[mm][bj][n] = (f32x4){bf_lo(p.x), bf_hi(p.x), bf_lo(p.y), bf_hi(p.y)}; }
                        else rv[mm][bj][n] = *(const f32x4*)((const float*)res + o); } }
            asm volatile("" ::: "memory");
#pragma unroll
            for (int mm = 0; mm < 2; ++mm) { const int m = 2 * mp + mm; const size_t off = (size_t)(row0 + ai * HALF + m * 16) * 1024 + col0;
#pragma unroll
                for (int bj = 0; bj < 2; ++bj)
#pragma unroll
                    for (int n = 0; n < 2; ++n) { const size_t o = off + bj * HALF + n * 16;
                        const f32x4 ov = rv[mm][bj][n] * alpha + acc[ai][bj][m][n];
                        if (OUT_BF16) *(u32x2*)((bf16_t*)R + o) = (u32x2){cvt_pk_bf16(ov[0], ov[1]), cvt_pk_bf16(ov[2], ov[3])}; else *(f32x4*)(R + o) = ov; } }
            asm volatile("" ::: "memory"); }
    }
};
struct EpiGateUp {
    static constexpr int NST = 8; static constexpr bool PERM = true;
    bf16_t* H;
    __device__ __forceinline__ void operator()(const f32x4 (&acc)[2][2][4][2], const Unit& u, int wr, int wc, int fr, int fq) const {
        const int row0 = u.slot0 + wr * 64 + fr, col0 = u.pn * HALF + wc * 32 + 8 * fq;
#pragma unroll
        for (int ai = 0; ai < 2; ++ai)
#pragma unroll
            for (int m = 0; m < 4; ++m) { f32x4 h[2];
#pragma unroll
                for (int n = 0; n < 2; ++n)
#pragma unroll
                    for (int j = 0; j < 4; ++j) { const float g = acc[ai][0][m][n][j]; h[n][j] = g * sigmoidf_(g) * acc[ai][1][m][n][j]; }
                u32x4 w; w.x = cvt_pk_bf16(h[0][0], h[0][1]); w.y = cvt_pk_bf16(h[0][2], h[0][3]); w.z = cvt_pk_bf16(h[1][0], h[1][1]); w.w = cvt_pk_bf16(h[1][2], h[1][3]);
                *(u32x4*)(H + (size_t)(row0 + ai * HALF + m * 16) * 512 + col0) = w; }
    }
};
struct EpiGateUp8 {
    static constexpr int NST = 8; static constexpr bool PERM = true;
    unsigned char* H;
    __device__ __forceinline__ void operator()(const f32x4 (&acc)[2][2][4][2], const Unit& u, int wr, int wc, int fr, int fq) const {
        const int row0 = u.slot0 + wr * 64 + fr, col0 = u.pn * HALF + wc * 32 + 8 * fq;
#pragma unroll
        for (int ai = 0; ai < 2; ++ai) { if (!((u.qm >> (2 * ai + wr)) & 1)) continue;
#pragma unroll
            for (int m = 0; m < 4; ++m) { f32x4 h[2];
#pragma unroll
                for (int n = 0; n < 2; ++n)
#pragma unroll
                    for (int j = 0; j < 4; ++j) { const float g = acc[ai][0][m][n][j]; h[n][j] = g * sigmoidf_(g) * acc[ai][1][m][n][j]; }
                int w0 = 0, w1 = 0;
                w0 = __builtin_amdgcn_cvt_pk_fp8_f32(h[0][0], h[0][1], w0, false); w0 = __builtin_amdgcn_cvt_pk_fp8_f32(h[0][2], h[0][3], w0, true);
                w1 = __builtin_amdgcn_cvt_pk_fp8_f32(h[1][0], h[1][1], w1, false); w1 = __builtin_amdgcn_cvt_pk_fp8_f32(h[1][2], h[1][3], w1, true);
                epi_st((u32x2*)(H + (size_t)(row0 + ai * HALF + m * 16) * 512 + col0), (u32x2){(unsigned)w0, (unsigned)w1}); } }
    }
};
template <bool OUT8 = false> struct EpiDown {
    static constexpr int NST = 0; static constexpr bool PERM = true;
    bf16_t* Y2; const int* dest; const float* gate; const PG8_LAS int* dg;
    __device__ __forceinline__ void operator()(const f32x4 (&acc)[2][2][4][2], const Unit& u, int wr, int wc, int fr, int fq) const {
        const int col0 = u.pn * BM + wc * 32 + 8 * fq;
        int dd[2][4]; float gg[2][4];
#pragma unroll
        for (int ai = 0; ai < 2; ++ai)
#pragma unroll
            for (int m = 0; m < 4; ++m) { const int tr = ai * HALF + wr * 64 + m * 16 + fr, idx = u.row0 + tr; const bool ok = idx < u.cnt;
                if (!((u.qm >> (2 * ai + wr)) & 1)) { dd[ai][m] = -1; gg[ai][m] = 0.f; continue; }
                if (dg) { const u32x2 t = *(const PG8_LAS u32x2*)(dg + 2 * ((u.pm % 5) * BM + tr)); dd[ai][m] = (int)t.x; gg[ai][m] = __uint_as_float(t.y); }
                else { dd[ai][m] = ok ? dest[u.e * 32768 + idx] : -1; gg[ai][m] = ok ? gate[u.e * 32768 + idx] : 0.f; } }
        asm volatile("" ::: "memory");
#pragma unroll
        for (int ai = 0; ai < 2; ++ai)
#pragma unroll
            for (int m = 0; m < 4; ++m) { const int d = dd[ai][m];
                if (d >= 0) { const float gt = gg[ai][m]; bf16_t* rowp = Y2 + (size_t)d * 1024 + col0;
#pragma unroll
                    for (int bj = 0; bj < 2; ++bj) { const f32x4 v0 = acc[ai][bj][m][0] * gt, v1 = acc[ai][bj][m][1] * gt;
                        if (OUT8) { int w0 = 0, w1 = 0; w0 = __builtin_amdgcn_cvt_pk_fp8_f32(v0[0], v0[1], w0, false); w0 = __builtin_amdgcn_cvt_pk_fp8_f32(v0[2], v0[3], w0, true);
                            w1 = __builtin_amdgcn_cvt_pk_fp8_f32(v1[0], v1[1], w1, false); w1 = __builtin_amdgcn_cvt_pk_fp8_f32(v1[2], v1[3], w1, true);
                            *(u32x2*)((unsigned char*)Y2 + (size_t)d * 1024 + col0 + bj * HALF) = (u32x2){(unsigned)w0, (unsigned)w1}; continue; }
                        u32x4 w; w.x = cvt_pk_bf16(v0[0], v0[1]); w.y = cvt_pk_bf16(v0[2], v0[3]); w.z = cvt_pk_bf16(v1[0], v1[1]); w.w = cvt_pk_bf16(v1[2], v1[3]);
                        *(u32x4*)(rowp + bj * HALF) = w; } } }
    }
};

#ifndef RELAX_EPI
#define RELAX_EPI 0
#endif
template <class Epi, class Sched, bool ALIGN_EPI, bool F8 = false, int KREP = 1, bool QSKIP = false>
__device__ __forceinline__ void gemm_phase(PG8_LAS unsigned char* lds, const Gemm g, const Sched& S, const Epi& E) {
    const int tid = threadIdx.x, wid = __builtin_amdgcn_readfirstlane(tid >> 6), lane = tid & 63, wr = wid >> 2, wc = wid & 3, fr = lane & 15, fq = lane >> 4;
    const int K = g.K, PB = F8 ? K : 2 * K  , nt = PB / 128;
    int sR[2]; unsigned sC2[2], voffB[2];
#pragma unroll
    for (int i = 0; i < 2; ++i) { int R, C; stage_rc(tid * 16 + i * 8192, R, C); const int Rb = Epi::PERM ? ((R & ~31) + perm32(R & 31)) : R;
        sR[i] = R; sC2[i] = (unsigned)C * 2u; voffB[i] = (unsigned)(Rb * PB) + (unsigned)C * 2u; }
#define PG8_MKA(dst, u) do { _Pragma("unroll") for (int _h = 0; _h < 2; ++_h) _Pragma("unroll") for (int _i = 0; _i < 2; ++_i) \
        dst[_h][_i] = (unsigned)S.a_row(u, sR[_i] + HALF * _h) * (unsigned)PB + sC2[_i]; } while (0)
    const size_t kstep = (size_t)(BK * 2);
    const size_t hstep = (size_t)HALF * PB;
    const unsigned ldsw = (unsigned)wid * 1024u;
    const int aoff = lds_byte(wr * 64 + fr, fq * 8), boff = lds_byte(wc * 32 + fr, fq * 8);
#define PG8_SA(b, h) (((b) * 2 + (h)) * HTB)
#define PG8_SB(b, h) ((4 + (b) * 2 + (h)) * HTB)
#define PG8_STAGE(bufoff, gbase, voff) do { _Pragma("unroll") for (int _i = 0; _i < 2; ++_i) \
        __builtin_amdgcn_global_load_lds((const unsigned*)((const char*)(gbase) + (voff)[_i]), (PG8_LAS unsigned*)(lds + (bufoff) + ldsw + _i * 8192), 16, 0, 0); } while (0)
#define PG8_LDA(dst, b, h) do { _Pragma("unroll") for (int m = 0; m < 4; ++m) { if constexpr (F8) { dst##8[m].lo = *(const PG8_LAS v4i_t*)(lds + PG8_SA(b, h) + aoff + m * 2048); dst##8[m].hi = *(const PG8_LAS v4i_t*)(lds + PG8_SA(b, h) + aoff + m * 2048 + 1024); } \
        else { _Pragma("unroll") for (int k = 0; k < 2; ++k) dst[m][k] = *(const PG8_LAS bf16x8*)(lds + PG8_SA(b, h) + aoff + m * 2048 + k * 1024); } } } while (0)
#define PG8_LDB(dst, b, h) do { _Pragma("unroll") for (int n = 0; n < 2; ++n) { if constexpr (F8) { dst##8[n].lo = *(const PG8_LAS v4i_t*)(lds + PG8_SB(b, h) + boff + n * 2048); dst##8[n].hi = *(const PG8_LAS v4i_t*)(lds + PG8_SB(b, h) + boff + n * 2048 + 1024); } \
        else { _Pragma("unroll") for (int k = 0; k < 2; ++k) dst[n][k] = *(const PG8_LAS bf16x8*)(lds + PG8_SB(b, h) + boff + n * 2048 + k * 1024); } } } while (0)
#define PG8_MMA(ai, bj, At, Bt) do { __builtin_amdgcn_s_setprio(1); _Pragma("unroll") for (int m = 0; m < 4; ++m) _Pragma("unroll") for (int n = 0; n < 2; ++n) { \
        if constexpr (F8) asm volatile("v_mfma_scale_f32_16x16x128_f8f6f4 %0, %1, %2, %0, %3, %4 op_sel_hi:[0,0,0]" : "+v"(acc[ai][bj][m][n]) : "v"(Bt##8[n]), "v"(At##8[m]), "v"(sc_w), "v"(sc_a)); \
        else { _Pragma("unroll") for (int k = 0; k < 2; ++k) acc[ai][bj][m][n] = __builtin_amdgcn_mfma_f32_16x16x32_bf16(Bt[n][k], At[m][k], acc[ai][bj][m][n], 0, 0, 0); } } __builtin_amdgcn_s_setprio(0); } while (0)
#define PG8_WAIT_V(n) asm volatile("s_waitcnt vmcnt(" #n ")" ::: "memory")
#define PG8_WAIT_L(n) asm volatile("s_waitcnt lgkmcnt(" #n ")" ::: "memory")
#define PG8_WAIT_VF do { if constexpr (RELAX_EPI && Epi::NST > 0) asm volatile("s_cmp_lg_u32 %0, 0\n\ts_cbranch_scc1 1f\n\ts_waitcnt vmcnt(8)\n\ts_branch 2f\n1:\ts_waitcnt vmcnt(%1)\n2:" :: "s"(fresh), "n"(8 + Epi::NST) : "scc", "memory"); else PG8_WAIT_V(8); } while (0)
#define PG8_BAR __builtin_amdgcn_s_barrier()
#define PG8_SCHED __builtin_amdgcn_sched_barrier(0)
    Unit cur, nxt; int ui = 0;
    if (!S.next(0, cur)) return;
    int qa0 = 1, qa1 = 1;
#define PG8_QSET(u) do { if constexpr (QSKIP) { const int q_ = __builtin_amdgcn_readfirstlane((u).qm); qa0 = (q_ >> wr) & 1; qa1 = (q_ >> (2 + wr)) & 1; } } while (0)
    PG8_QSET(cur);
    f32x4 acc[2][2][4][2];
#pragma unroll
    for (int a = 0; a < 2; ++a)
#pragma unroll
        for (int b = 0; b < 2; ++b)
#pragma unroll
            for (int m = 0; m < 4; ++m)
#pragma unroll
                for (int n = 0; n < 2; ++n) acc[a][b][m][n] = (f32x4){0.f, 0.f, 0.f, 0.f};
    bf16x8 At[4][2], B0[2][2], B1[2][2];
    v8i_t At8[4], B08[2], B18[2];
    const int sc_w = 0x79797979, sc_a = 0x7F7F7F7F;
    unsigned cVA[2][2], nVA[2][2];
    PG8_MKA(cVA, cur);
    const char* const gA = (const char*)g.A;
    const char* cB = (const char*)g.Bt + S.b_off(cur) * (F8 ? 1 : 2);
    PG8_STAGE(PG8_SB(0, 0), cB, voffB); PG8_STAGE(PG8_SB(0, 1), cB + hstep, voffB); PG8_STAGE(PG8_SA(0, 0), gA, cVA[0]); PG8_STAGE(PG8_SA(0, 1), gA, cVA[1]);
    if (wr == 1) PG8_BAR;
    PG8_WAIT_V(2); PG8_BAR;
    PG8_STAGE(PG8_SB(1, 0), cB + kstep, voffB); PG8_STAGE(PG8_SA(1, 0), gA + kstep, cVA[0]); PG8_STAGE(PG8_SB(1, 1), cB + hstep + kstep, voffB);
    PG8_WAIT_V(6); PG8_BAR;
    for (;;) {
        const bool has_next = S.next(ui + 1, nxt);
        const char* nB = cB;
        if (has_next) { PG8_MKA(nVA, nxt); nB = (const char*)g.Bt + S.b_off(nxt) * (F8 ? 1 : 2); }
        else {
#pragma unroll
            for (int _h = 0; _h < 2; ++_h)
#pragma unroll
                for (int _i = 0; _i < 2; ++_i) nVA[_h][_i] = cVA[_h][_i]; }
        for (int tt = 0; tt < nt * KREP; tt += 2) {
            const int t = KREP > 1 ? tt % nt : tt, t2 = KREP > 1 ? (tt + 2) % nt : tt + 2;
            const bool last = (tt == nt * KREP - 2); const int fresh = __builtin_amdgcn_readfirstlane((RELAX_EPI && Epi::NST > 0 && (tt == 0) && (ui > 0)) ? 1 : 0);
            const char* a1 = gA + (size_t)(t + 1) * kstep;
            const char* a2 = last ? gA : gA + (size_t)t2 * kstep; const char* b2 = last ? nB : cB + (size_t)t2 * kstep;
            const char* a3 = a2 + kstep; const char* b3 = b2 + kstep;
            unsigned xA0[2], xA1[2];
#pragma unroll
            for (int _i = 0; _i < 2; ++_i) { xA0[_i] = last ? nVA[0][_i] : cVA[0][_i]; xA1[_i] = last ? nVA[1][_i] : cVA[1][_i]; }
            PG8_LDB(B0, 0, 0); PG8_LDB(B1, 0, 1); PG8_SCHED; PG8_LDA(At, 0, 0); PG8_STAGE(PG8_SA(1, 1), a1, cVA[1]);
            PG8_WAIT_VF;
            PG8_WAIT_L(0); PG8_BAR; if (!QSKIP || qa0) { PG8_MMA(0, 0, At, B0); PG8_MMA(0, 1, At, B1); } PG8_BAR; PG8_SCHED;
            PG8_LDA(At, 0, 1); PG8_STAGE(PG8_SB(0, 0), b2, voffB); PG8_STAGE(PG8_SB(0, 1), b2 + hstep, voffB); PG8_STAGE(PG8_SA(0, 0), a2, xA0);
            PG8_WAIT_VF;
            PG8_WAIT_L(0); PG8_BAR; if (!QSKIP || qa1) { PG8_MMA(1, 0, At, B0); PG8_MMA(1, 1, At, B1); } PG8_BAR; PG8_SCHED;
            PG8_LDB(B0, 1, 0); PG8_LDB(B1, 1, 1); PG8_SCHED; PG8_LDA(At, 1, 0); PG8_STAGE(PG8_SA(0, 1), a2, xA1);
            PG8_WAIT_V(8); PG8_WAIT_L(0); PG8_BAR; if (!QSKIP || qa0) { PG8_MMA(0, 0, At, B0); PG8_MMA(0, 1, At, B1); } PG8_BAR; PG8_SCHED;
            PG8_LDA(At, 1, 1); PG8_STAGE(PG8_SB(1, 0), b3, voffB); PG8_STAGE(PG8_SB(1, 1), b3 + hstep, voffB); PG8_STAGE(PG8_SA(1, 0), a3, xA0);
            PG8_WAIT_V(8); PG8_WAIT_L(0); PG8_BAR; if (!QSKIP || qa1) { PG8_MMA(1, 0, At, B0); PG8_MMA(1, 1, At, B1); } PG8_BAR; PG8_SCHED;
        }
        if constexpr (ALIGN_EPI) { if (wr == 0) PG8_BAR; }
        if constexpr (F8) asm volatile("s_nop 15\n\ts_nop 15" ::: "memory");
        if constexpr (KREP > 1) {
#pragma unroll
            for (int a = 0; a < 2; ++a)
#pragma unroll
                for (int b = 0; b < 2; ++b)
#pragma unroll
                    for (int m = 0; m < 4; ++m)
#pragma unroll
                        for (int n = 0; n < 2; ++n) acc[a][b][m][n] = acc[a][b][m][n] * (1.0f / KREP); }
        E(acc, cur, wr, wc, fr, fq);
#ifdef PROBE_EPIREP
        if constexpr (KREP == 3) { asm volatile("" ::: "memory"); E(acc, cur, wr, wc, fr, fq); }
#endif
        if (!has_next) break;
#pragma unroll
        for (int a = 0; a < 2; ++a)
#pragma unroll
            for (int b = 0; b < 2; ++b)
#pragma unroll
                for (int m = 0; m < 4; ++m)
#pragma unroll
                    for (int n = 0; n < 2; ++n) acc[a][b][m][n] = (f32x4){0.f, 0.f, 0.f, 0.f};
        cur = nxt; cB = nB; ++ui; PG8_QSET(cur);
#pragma unroll
        for (int _h = 0; _h < 2; ++_h)
#pragma unroll
            for (int _i = 0; _i < 2; ++_i) cVA[_h][_i] = nVA[_h][_i];
        if constexpr (ALIGN_EPI) { if (wr == 1) PG8_BAR; }
    }
    PG8_WAIT_V(0);
    if constexpr (!ALIGN_EPI) { if (wr == 0) PG8_BAR; }
    PG8_BAR;
#undef PG8_MKA
#undef PG8_SA
#undef PG8_SB
#undef PG8_STAGE
#undef PG8_LDA
#undef PG8_LDB
#undef PG8_MMA
#undef PG8_WAIT_V
#undef PG8_WAIT_L
#undef PG8_BAR
#undef PG8_SCHED
}
}
#include <hip/hip_bf16.h>
#include <cmath>
namespace attn_body {
using bf16=__hip_bfloat16;
using bf16x8=__attribute__((ext_vector_type(8)))short;
using s16x4=__attribute__((ext_vector_type(4)))short;
using f32x16=__attribute__((ext_vector_type(16)))float;
using u32x4=__attribute__((ext_vector_type(4)))unsigned;
constexpr int SEQ=4096,D=64,DM=1024;
constexpr int NW=8,QBLK=32,QB=QBLK*NW,KVBLK=64,NQB=SEQ/QB;
constexpr int ATTN_PITCH=DM, ATTN_UNIT_ROWS=QB;
__device__ __forceinline__ int crow(int r,int hi){return (r&3)+8*(r>>2)+4*hi;}
#define SBAR() __builtin_amdgcn_sched_barrier(0)
__device__ __forceinline__ void cmask(f32x16&p0,f32x16&p1,int jb,int qrel,int hi){
  const float NEG=-INFINITY; const int dd=qrel-(64*jb+4*hi);
  #pragma unroll
  for(int r=0;r<16;++r){const int cc=(r&3)+8*(r>>2); if(cc>dd)p0[r]=NEG; if(cc+32>dd)p1[r]=NEG;}
}

constexpr int NSLOT=3, SLOTB=8192;
constexpr int LDS_K=0, LDS_V=NSLOT*SLOTB, LDS_WS=3*NSLOT*SLOTB  , LDS_OST=LDS_WS+NW*64*4, LDS_BYTES=LDS_OST+NW*8192  ;
constexpr float C2=0.125f*1.4426950408889634f;
__device__ __forceinline__ void glds16(const void*gsrc,unsigned lds_dst){unsigned keep;
  asm volatile("s_mov_b32 %0, m0\n\ts_mov_b32 m0, %2\n\ts_nop 0\n\tglobal_load_lds_dwordx4 %1, off\n\ts_mov_b32 m0, %0":"=&s"(keep):"v"(gsrc),"s"(lds_dst):"memory");}
template<int OFF> __device__ __forceinline__ void glds16s(const void*sbase,unsigned voff,unsigned lds_dst){unsigned keep;
  asm volatile("s_nop 4\n\ts_mov_b32 %0, m0\n\ts_mov_b32 m0, %2\n\ts_nop 0\n\tglobal_load_lds_dwordx4 %1, %3 offset:%c4\n\ts_mov_b32 m0, %0":"=&s"(keep):"v"(voff),"s"(lds_dst),"s"(sbase),"i"(OFF):"memory");}
__device__ __forceinline__ const void* uptr(const void*p){ const unsigned long long u=(unsigned long long)p; const unsigned lo=__builtin_amdgcn_readfirstlane((unsigned)u),hi=__builtin_amdgcn_readfirstlane((unsigned)(u>>32)); return (const void*)(((unsigned long long)hi<<32)|lo); }
__device__ __forceinline__ float max3f(float a,float b,float c){float r;asm("v_max3_f32 %0, %1, %2, %3":"=v"(r):"v"(a),"v"(b),"v"(c));return r;}
__device__ __forceinline__ float max2f(float a,float b){float r;asm("v_max_f32_e32 %0, %1, %2":"=v"(r):"v"(a),"v"(b));return r;}
__device__ __forceinline__ float fadd_s(float a,float b){float r;asm("v_add_f32_e32 %0, %1, %2":"=v"(r):"v"(a),"v"(b));return r;}
__device__ __forceinline__ float fsub_s(float a,float b){float r;asm("v_sub_f32_e32 %0, %1, %2":"=v"(r):"v"(a),"v"(b));return r;}
typedef float f32x2_t __attribute__((ext_vector_type(2))); typedef __bf16 bf16x2_t __attribute__((ext_vector_type(2)));
__device__ __forceinline__ unsigned cvtpk_s(float lo,float hi){f32x2_t v={lo,hi};bf16x2_t b=__builtin_convertvector(v,bf16x2_t);return __builtin_bit_cast(unsigned,b);}
#define WAIT_BAR(N) asm volatile("s_waitcnt vmcnt(" #N ") lgkmcnt(0)\n\ts_barrier":::"memory")

__device__ __forceinline__ void qkt(f32x16&p0,f32x16&p1,const char*Kslot,const bf16x8*qr,const f32x16&negm,int r32,int hi){
  const char*kb=Kslot+hi*1024+r32*16;
  #pragma unroll
  for(int d0=0;d0<4;++d0){
    const bf16x8 b0=*reinterpret_cast<const bf16x8*>(kb+d0*2048);
    const bf16x8 b1=*reinterpret_cast<const bf16x8*>(kb+d0*2048+512);
    if(d0==0){p0=__builtin_amdgcn_mfma_f32_32x32x16_bf16(b0,qr[0],negm,0,0,0);p1=__builtin_amdgcn_mfma_f32_32x32x16_bf16(b1,qr[0],negm,0,0,0);}
    else{p0=__builtin_amdgcn_mfma_f32_32x32x16_bf16(b0,qr[d0],p0,0,0,0);p1=__builtin_amdgcn_mfma_f32_32x32x16_bf16(b1,qr[d0],p1,0,0,0);}}
}
typedef __attribute__((address_space(3))) const char* lds_cptr;
typedef short v4i16_t __attribute__((ext_vector_type(4)));
__device__ __forceinline__ void kload8(bf16x8*kf,lds_cptr kp){
  kf[0]=*(const __attribute__((address_space(3))) bf16x8*)(kp);      kf[1]=*(const __attribute__((address_space(3))) bf16x8*)(kp+512);
  kf[2]=*(const __attribute__((address_space(3))) bf16x8*)(kp+2048); kf[3]=*(const __attribute__((address_space(3))) bf16x8*)(kp+2560);
  kf[4]=*(const __attribute__((address_space(3))) bf16x8*)(kp+4096); kf[5]=*(const __attribute__((address_space(3))) bf16x8*)(kp+4608);
  kf[6]=*(const __attribute__((address_space(3))) bf16x8*)(kp+6144); kf[7]=*(const __attribute__((address_space(3))) bf16x8*)(kp+6656);
}
__device__ __forceinline__ void kload2(bf16x8*kf,lds_cptr kp,int j){ kf[2*j]=*(const __attribute__((address_space(3))) bf16x8*)(kp+j*2048); kf[2*j+1]=*(const __attribute__((address_space(3))) bf16x8*)(kp+j*2048+512); }
__device__ __forceinline__ s16x4 vtr(lds_cptr p){ return __builtin_bit_cast(s16x4,__builtin_amdgcn_ds_read_tr16_b64_v4i16((__attribute__((address_space(3))) v4i16_t*)p)); }
__device__ __forceinline__ float rowmax(const f32x16&p0,const f32x16&p1){
  float a=max3f(p0[0],p0[1],p1[0]),b=max3f(p0[2],p0[3],p1[1]);a=max3f(a,p1[2],p1[3]);
  #pragma unroll
  for(int r=4;r<16;r+=4){a=max3f(a,p0[r],p0[r+1]);b=max3f(b,p0[r+2],p0[r+3]);a=max3f(a,p1[r],p1[r+1]);b=max3f(b,p1[r+2],p1[r+3]);}
  const float m=max2f(a,b);
  auto rr=__builtin_amdgcn_permlane32_swap(__float_as_uint(m),__float_as_uint(m),false,false);
  return max2f(__uint_as_float(rr[0]),__uint_as_float(rr[1]));
}
__device__ __forceinline__ void pv(f32x16*o,int vb,bf16x8 pa0,bf16x8 pa1,bf16x8 pa2,bf16x8 pa3){
  #pragma unroll
  for(int d0=0;d0<4;++d0){s16x4 lo[4],hi[4];
    #pragma unroll
    for(int ks=0;ks<4;++ks){
      asm volatile("ds_read_b64_tr_b16 %0,%1 offset:%c2":"=&v"(lo[ks]):"v"(vb),"i"(d0*4096+ks*1024):"memory");
      asm volatile("ds_read_b64_tr_b16 %0,%1 offset:%c2":"=&v"(hi[ks]):"v"(vb),"i"(d0*4096+ks*1024+512):"memory");}
    asm volatile("s_waitcnt lgkmcnt(0)":::"memory");SBAR();
    #define PK(k) (bf16x8){lo[k][0],lo[k][1],lo[k][2],lo[k][3],hi[k][0],hi[k][1],hi[k][2],hi[k][3]}
    o[d0]=__builtin_amdgcn_mfma_f32_32x32x16_bf16(pa0,PK(0),o[d0],0,0,0);
    o[d0]=__builtin_amdgcn_mfma_f32_32x32x16_bf16(pa1,PK(1),o[d0],0,0,0);
    o[d0]=__builtin_amdgcn_mfma_f32_32x32x16_bf16(pa2,PK(2),o[d0],0,0,0);
    o[d0]=__builtin_amdgcn_mfma_f32_32x32x16_bf16(pa3,PK(3),o[d0],0,0,0);
    #undef PK
  }
}

#ifndef ATTN_OUT_FP8
#define ATTN_OUT_FP8 1
#endif
#ifndef ATTN_STORE16
#define ATTN_STORE16(p,v) (*(u32x4*)(p)=(v))
#endif
template<int THRL> __device__ __forceinline__ void attn_unit(int qb,int cmode,float lam,const float*gsub,const bf16*Qh,const bf16*__restrict__ Kh,const bf16*__restrict__ Vh,bf16*Oh,char*shm){
  const int tid=threadIdx.x,lane=tid&63,r32=lane&31,hi=lane>>5; const int wid=__builtin_amdgcn_readfirstlane(tid>>6);
  const int q0=qb*QB;
  const bf16*Qw=Qh+(long)(q0+wid*QBLK)*DM;
  const unsigned lds0=(unsigned)(uintptr_t)shm;
  float*wsf=(float*)(shm+LDS_WS)+wid*64;
  const unsigned kvo=(unsigned)(lane*DM+wid*8)*2u;
  const unsigned vvo=(unsigned)((16*(wid&3)+(lane>>2))*DM+(wid>>2)*32+(lane&3)*8)*2u;
  const unsigned kdst=lds0+LDS_K+wid*1024, vdst=lds0+LDS_V+wid*1024;
  #define DMA_K(t,slot) glds16s<0>(uptr(Kh+(long)(t)*KVBLK*DM),kvo,(unsigned)__builtin_amdgcn_readfirstlane(kdst+(slot)))
  #define DMA_V(t,slot) do{ const void*vb_=uptr(Vh+(long)(t)*KVBLK*DM); glds16s<0>(vb_,vvo,(unsigned)__builtin_amdgcn_readfirstlane(vdst+2*(slot))); glds16s<128>(vb_,vvo,(unsigned)__builtin_amdgcn_readfirstlane(vdst+2*(slot)+8192-128)); }while(0)
  const char*Kbase=shm+LDS_K; bf16x8 kf[8];
  const lds_cptr shm3=(lds_cptr)shm; const lds_cptr kp0=shm3+LDS_K+hi*1024+r32*16; const lds_cptr vp0=shm3+LDS_V+((lane>>4)&1)*32+(lane&3)*8+(4*hi+((lane&15)>>2))*64;
  const int NT=(q0+QB)/KVBLK;
  DMA_K(0,0);DMA_V(0,0);DMA_K(1,SLOTB);
  bf16x8 qr[4];
  #pragma unroll
  for(int d0=0;d0<4;++d0)qr[d0]=*reinterpret_cast<const bf16x8*>(&Qw[(long)r32*DM+d0*16+hi*8]);
  float mhat=0.f,l_reg=0.f;f32x16 o[4];o[0]=f32x16{};o[1]=f32x16{};o[2]=f32x16{};o[3]=f32x16{};f32x16 negm=f32x16{};
  const int qrel=wid*QBLK+r32;
  #define CMASK(P0,P1,t) do{int jb_=(t)-(NT-4); if(jb_>=0){ const int dj_=jb_-(wid>>1); if(dj_>=0)cmask(P0,P1,jb_,qrel,hi); } }while(0)
  bool resc=false;
  #define START(P0,P1) do{ const float rm=rowmax(P0,P1); resc=false; \
    { const float dl=rm; mhat=fadd_s(mhat,dl); \
      _Pragma("unroll") for(int r=0;r<16;++r){P0[r]=fsub_s(P0[r],dl);P1[r]=fsub_s(P1[r],dl);} \
      _Pragma("unroll") for(int r=0;r<16;++r)negm[r]=-mhat; \
      } \
    _Pragma("unroll") for(int r=0;r<16;++r)P0[r]=__builtin_amdgcn_exp2f(P0[r]); }while(0)
  #define RESC() do{ if(resc){ asm volatile("s_waitcnt lgkmcnt(0)":::"memory"); \
      _Pragma("unroll") for(int d_=0;d_<4;++d_) _Pragma("unroll") for(int r=0;r<16;++r)o[d_][r]*=wsf[crow(r,hi)]; } }while(0)
  f32x16 pA0,pA1,pB0,pB1;
  int sl_prev=0,sl_cur=0,sl_next=SLOTB;
  #define ROT() do{sl_prev=sl_cur;sl_cur=sl_next;sl_next=(sl_next==(NSLOT-1)*SLOTB)?0:sl_next+SLOTB;}while(0)
  DMA_K(2,2*SLOTB);
  WAIT_BAR(4);
  qkt(pA0,pA1,Kbase,qr,negm,r32,hi);asm volatile("s_nop 15\n\ts_nop 7":"+v"(pA0),"+v"(pA1));CMASK(pA0,pA1,0);
  START(pA0,pA1);
  _Pragma("unroll") for(int r=0;r<16;++r)pA1[r]=__builtin_amdgcn_exp2f(pA1[r]);
  WAIT_BAR(0);
  DMA_K(3,0);DMA_V(1,SLOTB);
  ROT();
  kload8(kf,kp0+sl_cur);
  WAIT_BAR(3);
  s16x4 vlo[4],vhi[4]; u32x4 pw0,pw1,pw2,pw3;
  #define PKW(P,B) cvtpk_s(P[B],P[B+1])
  #define PAF(k) __builtin_bit_cast(bf16x8,pw##k)
  #define VFR(i) (bf16x8){vlo[i][0],vlo[i][1],vlo[i][2],vlo[i][3],vhi[i][0],vhi[i][1],vhi[i][2],vhi[i][3]}
  #define PIN(x) asm volatile("":"+v"(x))
  #define MX3(a,b,c) __builtin_fmaxf(__builtin_fmaxf((a),(b)),(c))
  #define GAPA(MF,A0,A1,A2,A3,W0,W1,PW) do{ MF; sacc+=A0; sacc+=A1; sacc+=A2; sacc+=A3; PIN(sacc); W0; W1; PIN(PW); SBAR(); }while(0)
  #define EX(v) __builtin_amdgcn_exp2f(v)
  #define GAPB(MF,X,B) do{ MF; X[B]=EX(X[B]); X[B+1]=EX(X[B+1]); PIN(X); SBAR(); }while(0)
  #define VRD(s_,f) do{ vlo[s_]=vtr(vp_+(((f)>>2)*4096+((f)&3)*1024)); vhi[s_]=vtr(vp_+(((f)>>2)*4096+((f)&3)*1024+512)); SBAR(); }while(0)
  #define KRD(G,j) do{ if(G){ kload2(kf,kp0+sl_next,j); SBAR(); } }while(0)
  #define PVM(d0,k,s_) o[d0]=__builtin_amdgcn_mfma_f32_32x32x16_bf16(PAF(k),VFR(s_),o[d0],0,0,0)
  #define STEP(C0,C1,P0,P1,t,GK,GV,GL) do{ SBAR(); \
    const lds_cptr vp_=vp0+2*sl_prev; \
    float sacc=(P0[0]+P0[1]); \
    GAPA(C0=__builtin_amdgcn_mfma_f32_32x32x16_bf16(kf[0],qr[0],negm,0,0,0), P0[2],P0[3],P0[4],P0[5],     pw0[0]=PKW(P0,0), pw0[1]=PKW(P0,2), pw0); \
    GAPA(C1=__builtin_amdgcn_mfma_f32_32x32x16_bf16(kf[1],qr[0],negm,0,0,0), P0[6],P0[7],P0[8],P0[9],     pw0[2]=PKW(P0,4), pw0[3]=PKW(P0,6), pw0); \
    GAPA(C0=__builtin_amdgcn_mfma_f32_32x32x16_bf16(kf[2],qr[1],C0,0,0,0),   P0[10],P0[11],P0[12],P0[13], pw1[0]=PKW(P0,8), pw1[1]=PKW(P0,10), pw1); \
    GAPA(C1=__builtin_amdgcn_mfma_f32_32x32x16_bf16(kf[3],qr[1],C1,0,0,0),   P0[14],P0[15],P1[0],P1[1],   pw1[2]=PKW(P0,12),pw1[3]=PKW(P0,14), pw1); \
    GAPA(C0=__builtin_amdgcn_mfma_f32_32x32x16_bf16(kf[4],qr[2],C0,0,0,0),   P1[2],P1[3],P1[4],P1[5],     pw2[0]=PKW(P1,0), pw2[1]=PKW(P1,2), pw2); \
    GAPA(C1=__builtin_amdgcn_mfma_f32_32x32x16_bf16(kf[5],qr[2],C1,0,0,0),   P1[6],P1[7],P1[8],P1[9],     pw2[2]=PKW(P1,4), pw2[3]=PKW(P1,6), pw2); \
    GAPA(C0=__builtin_amdgcn_mfma_f32_32x32x16_bf16(kf[6],qr[3],C0,0,0,0),   P1[10],P1[11],P1[12],P1[13], pw3[0]=PKW(P1,8), pw3[1]=PKW(P1,10), pw3); \
    GAPA(C1=__builtin_amdgcn_mfma_f32_32x32x16_bf16(kf[7],qr[3],C1,0,0,0),   P1[14],P1[15],0.f,0.f,       pw3[2]=PKW(P1,12),pw3[3]=PKW(P1,14), pw3); \
    l_reg+=sacc; \
    VRD(0,0); VRD(1,4); VRD(2,8); \
    if(GK){DMA_K((t)+3,sl_cur);} if(GV){DMA_V((t)+1,sl_next);} \
    CMASK(C0,C1,t); float a_,b_; \
    PVM(0,0,0); a_=MX3(C0[0],C0[1],C1[0]); b_=MX3(C0[2],C0[3],C1[1]); a_=MX3(a_,C1[2],C1[3]); PIN(a_); PIN(b_); SBAR();   VRD(3,12); \
    PVM(1,0,1); a_=MX3(a_,C0[4],C0[5]); b_=MX3(b_,C0[6],C0[7]); a_=MX3(a_,C1[4],C1[5]); b_=MX3(b_,C1[6],C1[7]); PIN(a_); PIN(b_); SBAR();   VRD(0,1); \
    PVM(2,0,2); a_=MX3(a_,C0[8],C0[9]); b_=MX3(b_,C0[10],C0[11]); a_=MX3(a_,C1[8],C1[9]); b_=MX3(b_,C1[10],C1[11]); PIN(a_); PIN(b_); SBAR();   VRD(1,5); \
    PVM(3,0,3); a_=MX3(a_,C0[12],C0[13]); b_=MX3(b_,C0[14],C0[15]); a_=MX3(a_,C1[12],C1[13]); b_=MX3(b_,C1[14],C1[15]); PIN(a_); PIN(b_); SBAR();   VRD(2,9); \
    { float rm=__builtin_fmaxf(a_,b_); { auto rr=__builtin_amdgcn_permlane32_swap(__float_as_uint(rm),__float_as_uint(rm),false,false); rm=__builtin_fmaxf(__uint_as_float(rr[0]),__uint_as_float(rr[1])); } \
      resc=false; \
      if(__builtin_expect(__any(rm>(float)THRL),0)){ const float dl=__builtin_fmaxf(rm,0.f); mhat+=dl; \
        _Pragma("unroll") for(int r=0;r<16;++r){C0[r]-=dl;C1[r]-=dl;negm[r]-=dl;} \
        const float f=__builtin_amdgcn_exp2f(-dl); l_reg*=f; if(hi==0)wsf[r32]=f; resc=true; } } \
    SBAR(); \
    PVM(0,1,0); C0[0]=EX(C0[0]); C0[1]=EX(C0[1]); C0[2]=EX(C0[2]); PIN(C0); SBAR();   VRD(3,13); \
    KRD(GL,0); PVM(1,1,1); C0[3]=EX(C0[3]); C0[4]=EX(C0[4]); PIN(C0); SBAR();   VRD(0,2); \
    PVM(2,1,2); C0[5]=EX(C0[5]); C0[6]=EX(C0[6]); C0[7]=EX(C0[7]); PIN(C0); SBAR();   VRD(1,6); \
    KRD(GL,1); PVM(3,1,3); C0[8]=EX(C0[8]); C0[9]=EX(C0[9]); PIN(C0); SBAR();   VRD(2,10); \
    PVM(0,2,0); C0[10]=EX(C0[10]); C0[11]=EX(C0[11]); C0[12]=EX(C0[12]); PIN(C0); SBAR();   VRD(3,14); \
    KRD(GL,2); PVM(1,2,1); C0[13]=EX(C0[13]); C0[14]=EX(C0[14]); PIN(C0); SBAR();   VRD(0,3); \
    PVM(2,2,2); C0[15]=EX(C0[15]); C1[0]=EX(C1[0]); C1[1]=EX(C1[1]); PIN(C0); PIN(C1); SBAR();   VRD(1,7); \
    KRD(GL,3); PVM(3,2,3); C1[2]=EX(C1[2]); C1[3]=EX(C1[3]); PIN(C1); SBAR();   VRD(2,11); \
    PVM(0,3,0); C1[4]=EX(C1[4]); C1[5]=EX(C1[5]); C1[6]=EX(C1[6]); PIN(C1); SBAR();   VRD(3,15); \
    PVM(1,3,1); C1[7]=EX(C1[7]); C1[8]=EX(C1[8]); C1[9]=EX(C1[9]); PIN(C1); SBAR(); \
    PVM(2,3,2); C1[10]=EX(C1[10]); C1[11]=EX(C1[11]); C1[12]=EX(C1[12]); PIN(C1); SBAR(); \
    PVM(3,3,3); C1[13]=EX(C1[13]); C1[14]=EX(C1[14]); C1[15]=EX(C1[15]); PIN(C1); SBAR(); \
    }while(0)
  int t=1;
  #undef CMASK
  #define CMASK(P0,P1,t) do{}while(0)
  for(;t+5<NT;t+=2){
    STEP(pB0,pB1,pA0,pA1,t,true,true,true);     WAIT_BAR(3); RESC(); ROT();
    STEP(pA0,pA1,pB0,pB1,t+1,true,true,true);   WAIT_BAR(3); RESC(); ROT();
  }
  #undef CMASK
  #define CMASK(P0,P1,t) do{int jb_=(t)-(NT-4); if(jb_>=0){ const int dj_=jb_-(wid>>1); if(dj_>=0)cmask(P0,P1,jb_,qrel,hi); } }while(0)
  #define ENDW(tt) do{ if((tt)+3<NT){WAIT_BAR(3);} else if((tt)+2<NT){WAIT_BAR(2);} else {WAIT_BAR(0);} }while(0)
  for(;t+1<NT;t+=2){
    STEP(pB0,pB1,pA0,pA1,t,(t+3<NT),(t+1<NT),(t+1<NT));       ENDW(t);   RESC(); ROT();
    STEP(pA0,pA1,pB0,pB1,t+1,(t+4<NT),(t+2<NT),(t+2<NT));     ENDW(t+1); RESC(); ROT();
  }
  STEP(pB0,pB1,pA0,pA1,NT-1,false,false,false); RESC();
  if((wid>>1)==3){ float sacc=pB0[0]+pB0[1]; _Pragma("unroll") for(int r=2;r<16;++r)sacc+=pB0[r]; _Pragma("unroll") for(int r=0;r<16;++r)sacc+=pB1[r]; l_reg+=sacc;
    pw0=(u32x4){PKW(pB0,0),PKW(pB0,2),PKW(pB0,4),PKW(pB0,6)};pw1=(u32x4){PKW(pB0,8),PKW(pB0,10),PKW(pB0,12),PKW(pB0,14)};pw2=(u32x4){PKW(pB1,0),PKW(pB1,2),PKW(pB1,4),PKW(pB1,6)};pw3=(u32x4){PKW(pB1,8),PKW(pB1,10),PKW(pB1,12),PKW(pB1,14)};
    int ln_=lane; asm volatile("":"+v"(ln_)); const int vb0=(int)(lds0+LDS_V)+((ln_>>4)&1)*32+(ln_&3)*8+(4*(ln_>>5)+((ln_&15)>>2))*64;
    SBAR(); pv(o,vb0+2*sl_cur,PAF(0),PAF(1),PAF(2),PAF(3)); }
  #undef PKW
  #undef PAF
  #undef VFR
  #undef PIN
  #undef MX3
  #undef GAPA
  #undef GAPB
  #undef EX
  #undef VRD
  #undef KRD
  #undef PVM
  #undef STEP
  #undef ENDW
  {auto rr=__builtin_amdgcn_permlane32_swap(__float_as_uint(l_reg),__float_as_uint(l_reg),false,false);l_reg=__uint_as_float(rr[0])+__uint_as_float(rr[1]);}
  if(hi==0)wsf[32+r32]=l_reg;asm volatile("s_waitcnt lgkmcnt(0)":::"memory");
  float rli[16];
  #pragma unroll
  for(int r=0;r<16;++r)rli[r]=__builtin_amdgcn_rcpf(wsf[32+crow(r,hi)]);
  bf16*Ow=Oh+(long)(q0+wid*QBLK)*DM;
  { int r32e=r32,hie=hi; asm volatile("":"+v"(r32e),"+v"(hie));
    bf16*stash=(bf16*)(shm+LDS_OST)+wid*4096;
    if(cmode==0){
      #pragma unroll
      for(int r=0;r<16;++r){const int orow=crow(r,hie);
        #pragma unroll
        for(int d0=0;d0<4;++d0)stash[orow*128+d0*32+r32e]=__float2bfloat16(o[d0][r]*rli[r]);}
    } else {
      float ss[16];
      #pragma unroll
      for(int r=0;r<16;++r){const int orow=crow(r,hie); float q=0.f;
        #pragma unroll
        for(int d0=0;d0<4;++d0){const float v=__bfloat162float(stash[orow*128+d0*32+r32e])-lam*(o[d0][r]*rli[r]); o[d0][r]=v; q+=v*v;}
        ss[r]=q;}
      #pragma unroll
      for(int st=0;st<4;++st){const int m=16>>st,n=16>>st; const bool up=(r32e&m)!=0;
        #pragma unroll
        for(int i=0;i<n/2;++i){const float a=ss[i],b2=ss[i+n/2]; const float keep=up?b2:a,send=up?a:b2; ss[i]=keep+__shfl_xor(send,m);} }
      ss[0]+=__shfl_xor(ss[0],1);
      asm volatile("s_waitcnt lgkmcnt(0)":::"memory");
      if((r32e&1)==0)wsf[crow(r32e>>1,hie)]=__builtin_amdgcn_rsqf(ss[0]*(1.0f/128.0f)+1e-6f);
      asm volatile("s_waitcnt lgkmcnt(0)":::"memory");
      float gs[4];
      #pragma unroll
      for(int d0=0;d0<4;++d0)gs[d0]=gsub[d0*32+r32e];
      #pragma unroll
      for(int r=0;r<16;++r){const float rs=wsf[crow(r,hie)];
        #pragma unroll
        for(int d0=0;d0<4;++d0)o[d0][r]*=rs*gs[d0];}
#if ATTN_OUT_FP8
      { unsigned char*stg8=(unsigned char*)stash;
        #pragma unroll
        for(int r=0;r<16;++r){const int orow=crow(r,hie); const int w0_=__builtin_amdgcn_cvt_pk_fp8_f32(o[0][r],o[1][r],0,false), w1_=__builtin_amdgcn_cvt_pk_fp8_f32(o[2][r],o[3][r],0,false);
          stg8[orow*128+r32e]=(unsigned char)w0_; stg8[orow*128+32+r32e]=(unsigned char)(w0_>>8); stg8[orow*128+64+r32e]=(unsigned char)w1_; stg8[orow*128+96+r32e]=(unsigned char)(w1_>>8);}
        asm volatile("s_waitcnt lgkmcnt(0)":::"memory");
        int lane_e=lane; asm volatile("":"+v"(lane_e));
        unsigned char*Ow8=(unsigned char*)Oh+(long)(q0+wid*QBLK)*DM;
        #pragma unroll
        for(int i=0;i<4;++i){const int row=i*8+(lane_e>>3),ch=lane_e&7; const u32x4 v=*(const u32x4*)(stg8+row*128+ch*16); ATTN_STORE16(Ow8+(long)row*DM+ch*16,v);}
        asm volatile("s_waitcnt lgkmcnt(0)":::"memory"); }
#else
      bf16*stg=stash;
      #pragma unroll
      for(int ps=0;ps<2;++ps){
        #pragma unroll
        for(int r=0;r<16;++r){const int orow=crow(r,hie);
          #pragma unroll
          for(int d0=0;d0<2;++d0)stg[orow*64+d0*32+r32e]=__float2bfloat16(o[2*ps+d0][r]);}
        asm volatile("s_waitcnt lgkmcnt(0)":::"memory");
        int lane_e=lane; asm volatile("":"+v"(lane_e));
        #pragma unroll
        for(int i=0;i<4;++i){const int row=i*8+(lane_e>>3),ch=lane_e&7; const u32x4 v=*(const u32x4*)(stg+row*64+ch*8); ATTN_STORE16(Ow+(long)row*DM+ps*64+ch*8,v);}
        asm volatile("s_waitcnt lgkmcnt(0)":::"memory"); }
#endif
      } }
  asm volatile("s_waitcnt lgkmcnt(0)\n\ts_barrier":::"memory");
  #undef DMA_K
  #undef DMA_V
  #undef CMASK
  #undef START
  #undef RESC
  #undef ROT
}
constexpr int ATTN_LDS_BYTES=LDS_BYTES;
struct DiffTensors { const bf16* Q; const bf16* K; const bf16* V; bf16* OA; const float* gsub; float lam; };
template<int THRL=8> __device__ __forceinline__ void attn_phase(char*lds,const DiffTensors&T,int vcu,int G){
  const int ngrp=G>>4, grp=vcu>>4, j=vcu&15;
  #pragma unroll 1
  for(int p=0;p*ngrp+grp<64&&grp<ngrp;++p){
    const int bh=p*ngrp+grp,b=bh>>3,h=bh&7,qb=(p&1)?NQB-1-j:j; const long rb=(long)b*SEQ*DM;
    #pragma unroll 1
    for(int c=0;c<2;++c){
      const bf16*Qh=T.Q+rb+(2*h+c)*64,*Kh=T.K+rb+(2*h+c)*64,*Vh=T.V+rb+h*128;
      bf16*Oh=ATTN_OUT_FP8?(bf16*)((unsigned char*)T.OA+rb+h*128):T.OA+rb+h*128;
      attn_unit<THRL>(qb,c,T.lam,T.gsub,Qh,Kh,Vh,Oh,lds); }
  }
}
#undef SBAR
#undef WAIT_BAR
}

constexpr int NWAVES = 8;
constexpr int BATCH = 8, SEQ = 4096, D = 1024, M = BATCH * SEQ;
constexpr int NEXP = 16, DEXP = 512, ECAP = 32768;
constexpr float LN_EPS = 1e-5f, RMS_EPS = 1e-6f;
constexpr float DN_ALPHA = 1.41421356237309515f;
constexpr float LAMBDA_INIT = 0.35550906759096926f;
#ifndef N_LAUNCH_MODE
#define N_LAUNCH_MODE 1
#endif
constexpr int N_PHASES = 16;

constexpr size_t MiB = 1u << 20;
constexpr size_t WS_CTL = 0, CTL_ZERO_BYTES = 1 * MiB;
constexpr size_t WS_TAB = 1 * MiB;
constexpr size_t WS_WIN = 2 * MiB;
constexpr size_t WS_WOUT = 10 * MiB;
constexpr size_t WS_WQKV = 12 * MiB;
constexpr size_t WS_WBO = 18 * MiB;
constexpr size_t WS_WGU = 20 * MiB;
constexpr size_t WS_WD = 84 * MiB;
constexpr size_t WS_BUF = 120 * MiB, BUFSZ = 64 * MiB;
constexpr size_t WS_A = WS_BUF, WS_B = WS_BUF + BUFSZ, WS_C = WS_BUF + 2 * BUFSZ, WS_D = WS_BUF + 3 * BUFSZ, WS_E = WS_BUF + 4 * BUFSZ, WS_F = WS_BUF + 5 * BUFSZ;
constexpr size_t WS_DEST = 504 * MiB, WS_GATE = 506 * MiB;
constexpr size_t WS_END = 508 * MiB;
constexpr int CW_CNT = 1024;
constexpr int CW_BAR = 4096;

constexpr int RING_OFF = 0, RING_BYTES = 143360;
constexpr int LDSCTL_OFF = RING_BYTES, MISC_OFF = LDSCTL_OFF + 320;
constexpr int MOETAB_OFF = LDSCTL_OFF + 1024;
constexpr int LDS_BYTES = 147456;
static_assert(MOETAB_OFF + 256 <= LDS_BYTES && MISC_OFF + 128 <= MOETAB_OFF, "LDS map");

#define GAS __attribute__((address_space(1)))
#define LAS __attribute__((address_space(3)))
typedef unsigned short bf16;
typedef unsigned v4u __attribute__((ext_vector_type(4)));
typedef unsigned v2u __attribute__((ext_vector_type(2)));
typedef float f32x4 __attribute__((ext_vector_type(4)));
typedef float f32x2 __attribute__((ext_vector_type(2)));
typedef short bf16x8 __attribute__((ext_vector_type(8)));
typedef short s16x4 __attribute__((ext_vector_type(4)));
typedef GAS unsigned gu32;
typedef GAS unsigned long long gu64;
#define RLX_AGENT __ATOMIC_RELAXED, __HIP_MEMORY_SCOPE_AGENT
#define LDS_WAIT() asm volatile("s_waitcnt lgkmcnt(0)" ::: "memory")
#define VM_WAIT() asm volatile("s_waitcnt vmcnt(0)" ::: "memory")
__device__ __forceinline__ unsigned f2bf(float f) { unsigned u = __builtin_bit_cast(unsigned, f); return (u + 0x7fffu + ((u >> 16) & 1u)) >> 16; }
__device__ __forceinline__ unsigned pk2(float lo, float hi) { return f2bf(lo) | (f2bf(hi) << 16); }
__device__ __forceinline__ float bflo(unsigned u) { return __uint_as_float(u << 16); }
__device__ __forceinline__ float bfhi(unsigned u) { return __uint_as_float(u & 0xffff0000u); }

#define XB_TMO      128
#define XB_XCNT(j)  (256  + 64 * (j))
#define XB_XSUB(j)  (1280 + 64 * (j))
#define XB_XGEN(j)  (2304 + 64 * (j))
#define XB_TOP      3328
#define XB_TOPGEN   3392
#define XCD_BAR_WORDS 3456
#define XB_SPIN_CAP (1u << 18)

__device__ __forceinline__ unsigned xb_ld(unsigned* p)              { return __hip_atomic_load(p, __ATOMIC_RELAXED, __HIP_MEMORY_SCOPE_AGENT); }
__device__ __forceinline__ unsigned xb_add(unsigned* p, unsigned v) { return __hip_atomic_fetch_add(p, v, __ATOMIC_RELAXED, __HIP_MEMORY_SCOPE_AGENT); }
__device__ __forceinline__ unsigned xb_xcc_id() { return (unsigned)__builtin_amdgcn_s_getreg((3 << 11) | 20) & 0xFu; }
#define XB_SPIN(cond, bar) do { unsigned _sp = 0; while (cond) { __builtin_amdgcn_s_sleep(1); \
    if ((++_sp & 255u) == 0u) { if (xb_ld(&(bar)[XB_TMO])) break; if (_sp > XB_SPIN_CAP) { atomicAdd(&(bar)[XB_TMO], 1u); break; } } } } while (0)

struct XcdBarrier {
    unsigned* bar; unsigned x;
    volatile LAS unsigned* st;
};

__device__ __forceinline__ XcdBarrier xcd_barrier_post(unsigned* bar, volatile LAS unsigned* st) {
    XcdBarrier b; b.bar = bar; b.x = xb_xcc_id(); b.st = st;
    if (threadIdx.x == 0) (void)xb_add(&bar[XB_XCNT(b.x)], 1u);
    return b;
}
__device__ __forceinline__ void xcd_barrier_complete(unsigned* bar, unsigned x, unsigned& nloc, unsigned& nx) {
    const unsigned G = gridDim.x * gridDim.y * gridDim.z;
    unsigned sum, cnt, mine, sp = 0u;
    for (;;) {
        sum = 0u; cnt = 0u; mine = 0u;
#pragma unroll
        for (unsigned j = 0; j < 16; ++j) { const unsigned c = xb_ld(&bar[XB_XCNT(j)]); sum += c; cnt += (c > 0u) ? 1u : 0u; mine = (j == x) ? c : mine; }
        if (sum == G) break;
        __builtin_amdgcn_s_sleep(1);
        if ((++sp & 255u) == 0u) { if (xb_ld(&bar[XB_TMO])) break; if (sp > XB_SPIN_CAP) { atomicAdd(&bar[XB_TMO], 1u); break; } }
    }
    nloc = mine > 0u ? mine : 1u; nx = cnt > 0u ? cnt : 1u;
}

__device__ __forceinline__ void xcd_barrier(const XcdBarrier& b) {
    asm volatile("s_waitcnt vmcnt(0)" ::: "memory");
    __syncthreads();
    if (threadIdx.x == 0) {
        unsigned* bar = b.bar;
        __builtin_amdgcn_s_waitcnt(0);
        unsigned nloc = b.st[0], nx = b.st[1];
        if (nloc == 0u) { xcd_barrier_complete(bar, b.x, nloc, nx); b.st[0] = nloc; b.st[1] = nx; }
        const unsigned old = xb_add(&bar[XB_XSUB(b.x)], 1u);
        const unsigned gen = old / nloc;
        if (old + 1u == (gen + 1u) * nloc) {
            __builtin_amdgcn_fence(__ATOMIC_RELEASE, "agent");
            asm volatile("s_waitcnt vmcnt(0)" ::: "memory");
            const unsigned og = xb_add(&bar[XB_TOP], 1u);
            const unsigned tg = og / nx;
            if (og + 1u == (tg + 1u) * nx) xb_add(&bar[XB_TOPGEN], 1u);
            else XB_SPIN(xb_ld(&bar[XB_TOPGEN]) == tg, bar);
            __builtin_amdgcn_fence(__ATOMIC_ACQUIRE, "agent");
            xb_add(&bar[XB_XGEN(b.x)], 1u);
            asm volatile("s_waitcnt vmcnt(0)" ::: "memory");
        } else {
            XB_SPIN(xb_ld(&bar[XB_XGEN(b.x)]) == gen, bar);
            __builtin_amdgcn_fence(__ATOMIC_ACQUIRE, "agent");
            asm volatile("s_waitcnt vmcnt(0)" ::: "memory");
        }
    }
    __syncthreads();
}

struct Frame {
    LAS unsigned char* lds;
    gu32* ctl;
    int tid, lane, wave;
    int vcu, G;
};
__device__ __forceinline__ float wave_sum(float v) {
#pragma unroll
    for (int o = 1; o < 64; o <<= 1) v += __shfl_xor(v, o);
    return v;
}
__device__ __forceinline__ void transpose_item(const float* W, int ldw, int k0, int n0, bf16* WT, int ldk, int dst_row0, float scale, LAS float* scr, int lane) {
#pragma unroll
    for (int i = 0; i < 32; ++i) { const int kk = 2 * i + (lane >> 5); scr[kk * 33 + (lane & 31)] = __builtin_nontemporal_load(W + (size_t)(k0 + kk) * ldw + n0 + (lane & 31)); }
    LDS_WAIT(); asm volatile("" ::: "memory");
    const int c = lane & 7;
#pragma unroll
    for (int j = 0; j < 4; ++j) { const int n = (lane >> 3) + 8 * j; const LAS float* s = scr + (8 * c) * 33 + n;
        v4u o; o.x = pk2(s[0 * 33] * scale, s[1 * 33] * scale); o.y = pk2(s[2 * 33] * scale, s[3 * 33] * scale); o.z = pk2(s[4 * 33] * scale, s[5 * 33] * scale); o.w = pk2(s[6 * 33] * scale, s[7 * 33] * scale);
        *(GAS v4u*)(WT + (size_t)(dst_row0 + n) * ldk + k0 + 8 * c) = o; }
    LDS_WAIT(); asm volatile("" ::: "memory");
}
__device__ __forceinline__ void transpose_item8(const float* W, int ldw, int k0, int n0, unsigned char* WT8, int ldk, int dst_row0, float scale, LAS float* scr, int lane) {
#pragma unroll
    for (int i = 0; i < 32; ++i) { const int kk = 2 * i + (lane >> 5); scr[kk * 33 + (lane & 31)] = __builtin_nontemporal_load(W + (size_t)(k0 + kk) * ldw + n0 + (lane & 31)); }
    LDS_WAIT(); asm volatile("" ::: "memory");
    const int c = lane & 7;
#pragma unroll
    for (int j = 0; j < 4; ++j) { const int n = (lane >> 3) + 8 * j; const LAS float* sp = scr + (8 * c) * 33 + n;
        int w0 = 0, w1 = 0;
        w0 = __builtin_amdgcn_cvt_pk_fp8_f32(sp[0 * 33] * scale, sp[1 * 33] * scale, w0, false); w0 = __builtin_amdgcn_cvt_pk_fp8_f32(sp[2 * 33] * scale, sp[3 * 33] * scale, w0, true);
        w1 = __builtin_amdgcn_cvt_pk_fp8_f32(sp[4 * 33] * scale, sp[5 * 33] * scale, w1, false); w1 = __builtin_amdgcn_cvt_pk_fp8_f32(sp[6 * 33] * scale, sp[7 * 33] * scale, w1, true);
        *(GAS v2u*)(WT8 + (size_t)(dst_row0 + n) * ldk + k0 + 8 * c) = (v2u){(unsigned)w0, (unsigned)w1}; }
    LDS_WAIT(); asm volatile("" ::: "memory");
}
__device__ __forceinline__ void transpose_plain(const float* W, int K, int N, bf16* WT, int row_off, float scale, LAS float* scr, int item, int lane) {
    const int nblk = N / 32, kb = item / nblk, nb = item % nblk;
    transpose_item(W, N, 64 * kb, 32 * nb, WT, K, row_off + 32 * nb, scale, scr, lane);
}

__device__ __forceinline__ void transpose_plain8(const float* W, int K, int N, unsigned char* WT8, int row_off, float scale, LAS float* scr, int item, int lane) {
    const int nblk = N / 32, kb = item / nblk, nb = item % nblk;
    transpose_item8(W, N, 64 * kb, 32 * nb, WT8, K, row_off + 32 * nb, scale, scr, lane);
}
constexpr float W8_SCALE = 64.0f;
#ifndef MIX_SPLIT
#define MIX_SPLIT 0
#endif
#ifndef ALIGN_P3
#define ALIGN_P3 true
#endif
#ifndef R_BF16
#define R_BF16 1
#endif
#ifndef FP8_PROJ
#define FP8_PROJ 13
#endif
__host__ __device__ constexpr int proj_rank(int grp, bool f8) { int r = 0; for (int g2 = 0; g2 < grp; ++g2) if ((((FP8_PROJ) >> g2) & 1) == (f8 ? 1 : 0)) ++r; return r; }
__host__ __device__ constexpr int proj_count(bool f8) { return proj_rank(4, f8); }
__host__ __device__ constexpr int proj_gmap(bool f8) { int m = 0, r = 0; for (int g2 = 0; g2 < 4; ++g2) if ((((FP8_PROJ) >> g2) & 1) == (f8 ? 1 : 0)) { m |= g2 << (4 * r); ++r; } return m; }
constexpr size_t WS_WIN8 = WS_WIN + (size_t)proj_count(false) * 2 * MiB;
#ifndef FP8_WO
#define FP8_WO 1
#endif
#ifndef FP8_QKV
#define FP8_QKV 1
#endif
struct Inputs { const float *x, *a_w_in, *a_lb, *a_norm_g, *a_w_out, *kv_w, *b_w_q, *b_lam, *b_subln_g, *b_w_out, *ln1_g, *ln1_b, *ln2_g, *ln2_b, *router_w, *router_b, *moe_w_gate, *moe_w_up, *moe_w_down; };

constexpr int DN_IN = 16 * 128, DN_SQ = 16 * 32, DN_KV = 16 * 64, DN_ALL = DN_IN + DN_SQ + DN_KV + DN_SQ + DN_SQ;
__device__ __forceinline__ void dense_weight_convert(Frame& F, const Inputs& in, unsigned char* ws, int it_lo, int it_hi, int w0, int nw) {
    LAS float* scr = (LAS float*)(F.lds + RING_OFF + F.wave * 16384);
    constexpr int I_IN = DN_IN, I_SQ = DN_SQ, I_KV = DN_KV;
    for (int it = it_lo + w0; it < it_hi; it += nw) {
        int r = it;
        if (r < I_IN) { const int nb_ = r % 128, kb_ = r / 128, grp_ = nb_ >> 5;
            if ((FP8_PROJ >> grp_) & 1) transpose_item8(in.a_w_in, 4 * D, 64 * kb_, 32 * nb_, ws + WS_WIN8, D, proj_rank(grp_, true) * 1024 + 32 * (nb_ & 31), W8_SCALE, scr, F.lane);
            else transpose_item(in.a_w_in, 4 * D, 64 * kb_, 32 * nb_, (bf16*)(ws + WS_WIN), D, proj_rank(grp_, false) * 1024 + 32 * (nb_ & 31), 1.f, scr, F.lane);
            continue; } r -= I_IN;
        if (r < I_SQ) { if (FP8_WO) transpose_plain8(in.a_w_out, D, D, ws + WS_WOUT, 0, W8_SCALE, scr, r, F.lane); else transpose_plain(in.a_w_out, D, D, (bf16*)(ws + WS_WOUT), 0, 1.f, scr, r, F.lane); continue; } r -= I_SQ;
        if (r < I_KV) { if (FP8_QKV) transpose_plain8(in.kv_w, D, 2 * D, ws + WS_WQKV, D, W8_SCALE, scr, r, F.lane); else transpose_plain(in.kv_w, D, 2 * D, (bf16*)(ws + WS_WQKV), D, 1.f, scr, r, F.lane); continue; } r -= I_KV;
        if (r < I_SQ) { if (FP8_QKV) transpose_plain8(in.b_w_q, D, D, ws + WS_WQKV, 0, attn_body::C2 * W8_SCALE, scr, r, F.lane); else transpose_plain(in.b_w_q, D, D, (bf16*)(ws + WS_WQKV), 0, attn_body::C2, scr, r, F.lane); continue; } r -= I_SQ;
        if (ATTN_OUT_FP8) transpose_plain8(in.b_w_out, D, D, ws + WS_WBO, 0, W8_SCALE, scr, r, F.lane); else transpose_plain(in.b_w_out, D, D, (bf16*)(ws + WS_WBO), 0, 1.f, scr, r, F.lane);
    }
}
#ifndef SHADOW_CONV
#define SHADOW_CONV 1
#endif
#ifndef SHADOW_DENSE
#define SHADOW_DENSE 1
#endif
__device__ __forceinline__ void p0_prologue(Frame& F, const Inputs& in, unsigned char* ws) {
    const int gw = F.vcu * NWAVES + F.wave, NGW = F.G * NWAVES;
    dense_weight_convert(F, in, ws, 0, (SHADOW_DENSE && SHADOW_CONV && N_LAUNCH_MODE == 1) ? DN_IN : DN_ALL, gw, NGW);
    bf16* XB = (bf16*)(ws + WS_A);
    for (int m0 = gw; m0 < M; m0 += 4 * NGW) {
        f32x4 xv[4][4];
#pragma unroll
        for (int q = 0; q < 4; ++q) { const int m = m0 + q * NGW; if (m < M) { const GAS f32x4* xr = (const GAS f32x4*)(in.x + (size_t)m * D) + F.lane;
#pragma unroll
            for (int j = 0; j < 4; ++j) xv[q][j] = __builtin_nontemporal_load(xr + 64 * j); } }
        asm volatile("" ::: "memory");
#pragma unroll
        for (int q = 0; q < 4; ++q) { const int m = m0 + q * NGW; if (m < M) { GAS v2u* o8 = (GAS v2u*)(XB + (size_t)m * D) + F.lane;
#pragma unroll
            for (int j = 0; j < 4; ++j) { const f32x4 v = xv[q][j]; v2u o; o.x = pk2(v.x, v.y); o.y = pk2(v.z, v.w); o8[64 * j] = o;
                if (FP8_PROJ) { int w8 = 0; w8 = __builtin_amdgcn_cvt_pk_fp8_f32(v.x, v.y, w8, false); w8 = __builtin_amdgcn_cvt_pk_fp8_f32(v.z, v.w, w8, true); *(GAS unsigned*)(ws + WS_F + (size_t)m * D + 4 * F.lane + 256 * j) = (unsigned)w8; } } } }
    }
    if (blockIdx.x == 0) {
        float* tab = (float*)(ws + WS_TAB);
        for (int d = F.tid; d < D; d += NWAVES * 64) { const float a0 = in.a_lb[d], a1 = in.a_lb[D + d]; tab[d] = 1.0f / (1.0f + __expf(a1 - a0)); }
        if (F.wave == 0) { const float p = wave_sum(in.b_lam[F.lane] * in.b_lam[64 + F.lane]), q = wave_sum(in.b_lam[128 + F.lane] * in.b_lam[192 + F.lane]);
            if (F.lane == 0) tab[1024] = __expf(p) - __expf(q) + LAMBDA_INIT; }
    }
}
#ifndef FP8_L0
#define FP8_L0 1
#endif
#ifndef FP8_L1
#define FP8_L1 1
#endif
constexpr int MOE_PER = 768, MOE_NIT = 2 * NEXP * MOE_PER;
__device__ __forceinline__ void moe_weight_convert(Frame& F, const Inputs& in, unsigned char* ws, int it_lo, int it_hi, int w0, int nw) {
    LAS float* scr = (LAS float*)(F.lds + RING_OFF + F.wave * 16384);
    constexpr int PER = MOE_PER;
    for (int it = it_lo + w0; it < it_hi; it += nw) {
        const int le = it / PER, r = it % PER, kind = r >> 8, q = r & 255, l = le >> 4, e = le & 15;
        const bool f8 = l ? (FP8_L1 != 0) : (FP8_L0 != 0);
        unsigned char* gu = ws + WS_WGU + (size_t)l * (32 * MiB) + (size_t)e * D * D * (f8 ? 1 : 2);
        unsigned char* dn = ws + WS_WD + (size_t)l * (16 * MiB) + (size_t)e * D * DEXP * (f8 ? 1 : 2);
        if (kind < 2) { const int kb = q >> 4, nb = q & 15, n0 = 32 * nb; const float* W = (kind == 0 ? in.moe_w_gate : in.moe_w_up) + (size_t)le * D * DEXP;
            const int drow = (n0 >> 7) * 256 + kind * 128 + (n0 & 127);
            if (f8) transpose_item8(W, DEXP, 64 * kb, n0, gu, D, drow, W8_SCALE, scr, F.lane); else transpose_item(W, DEXP, 64 * kb, n0, (bf16*)gu, D, drow, 1.f, scr, F.lane); }
        else { const int kb = q >> 5, nb = q & 31; const float* W = in.moe_w_down + (size_t)le * DEXP * D;
            if (f8) transpose_item8(W, D, 64 * kb, 32 * nb, dn, DEXP, 32 * nb, W8_SCALE, scr, F.lane); else transpose_item(W, D, 64 * kb, 32 * nb, (bf16*)dn, DEXP, 32 * nb, 1.f, scr, F.lane); }
    }
}

#ifndef SHADOW_CONV
#define SHADOW_CONV 1
#endif
template <class W> __device__ __forceinline__ void xcd_barrier_w(const XcdBarrier& b, const W& work) {
    asm volatile("s_waitcnt vmcnt(0)" ::: "memory");
    __syncthreads();
    if (__builtin_amdgcn_readfirstlane((int)threadIdx.x >> 6) != 0) work();
    if (threadIdx.x == 0) {
        unsigned* bar = b.bar;
        __builtin_amdgcn_s_waitcnt(0);
        unsigned nloc = b.st[0], nx = b.st[1];
        if (nloc == 0u) { xcd_barrier_complete(bar, b.x, nloc, nx); b.st[0] = nloc; b.st[1] = nx; }
        const unsigned old = xb_add(&bar[XB_XSUB(b.x)], 1u);
        const unsigned gen = old / nloc;
        if (old + 1u == (gen + 1u) * nloc) {
            __builtin_amdgcn_fence(__ATOMIC_RELEASE, "agent");
            asm volatile("s_waitcnt vmcnt(0)" ::: "memory");
            const unsigned og = xb_add(&bar[XB_TOP], 1u);
            const unsigned tg = og / nx;
            if (og + 1u == (tg + 1u) * nx) xb_add(&bar[XB_TOPGEN], 1u);
            else XB_SPIN(xb_ld(&bar[XB_TOPGEN]) == tg, bar);
            __builtin_amdgcn_fence(__ATOMIC_ACQUIRE, "agent");
            xb_add(&bar[XB_XGEN(b.x)], 1u);
            asm volatile("s_waitcnt vmcnt(0)" ::: "memory");
        } else {
            XB_SPIN(xb_ld(&bar[XB_XGEN(b.x)]) == gen, bar);
            __builtin_amdgcn_fence(__ATOMIC_ACQUIRE, "agent");
            asm volatile("s_waitcnt vmcnt(0)" ::: "memory");
        }
    }
    asm volatile("s_waitcnt lgkmcnt(0)\n\ts_barrier" ::: "memory");
}
#ifndef SH_DOUBLE
#define SH_DOUBLE 2
#endif
constexpr int SH_PER = 7 * 256, SH_P0 = (MOE_NIT / 2 - (5 + SH_DOUBLE) * SH_PER) > 0 ? (MOE_NIT / 2 - (5 + SH_DOUBLE) * SH_PER) : 0;
static_assert(SH_P0 >= 0 && 7 * SH_PER >= MOE_NIT / 2, "shadow conversion schedule");
__device__ __forceinline__ void shadow_convert(Frame& F, const Inputs& in, unsigned char* ws, int j) {
    int lo, hi;
    if (j < 5) { lo = SH_P0 + (j + (j < SH_DOUBLE ? j : SH_DOUBLE)) * SH_PER; hi = lo + (j < SH_DOUBLE ? 2 : 1) * SH_PER; if (hi > MOE_NIT / 2) hi = MOE_NIT / 2; if (lo > hi) lo = hi; }
    else if (j < 12) { lo = MOE_NIT / 2 + (j - 5) * SH_PER; hi = lo + SH_PER < MOE_NIT ? lo + SH_PER : MOE_NIT; }
    else { lo = 0; hi = 0; }
    moe_weight_convert(F, in, ws, lo, hi, F.vcu * 7 + (F.wave - 1), F.G * 7);
    if (SHADOW_DENSE) {
        if (j == 2) dense_weight_convert(F, in, ws, DN_IN, DN_IN + DN_SQ, F.vcu * 7 + (F.wave - 1), F.G * 7);
        else if (j == 3) dense_weight_convert(F, in, ws, DN_IN + DN_SQ, DN_IN + DN_SQ + DN_KV + DN_SQ, F.vcu * 7 + (F.wave - 1), F.G * 7);
        else if (j == 4) dense_weight_convert(F, in, ws, DN_IN + DN_SQ + DN_KV + DN_SQ, DN_ALL, F.vcu * 7 + (F.wave - 1), F.G * 7);
    }
}

constexpr int SC_TOT = 0, SC_DEC = 4096, SC_SS = SC_DEC + 512, SC_QT = SC_SS + 2048, SC_KT = SC_QT + 17408, SC_QH = SC_KT + 17408,
              SC_KHT = SC_QH + 17408, SC_VT = SC_KHT + 18432, SC_P = SC_VT + 18432, SC_END = SC_P + 9216, SC_OUT = SC_QT;
static_assert(SC_END <= RING_BYTES && 64 * 528 <= 2 * 17408, "scan LDS map");
__device__ __forceinline__ float h2f(unsigned short h) { return (float)__builtin_bit_cast(__fp16, h); }
__device__ __forceinline__ unsigned cvtpk(float lo, float hi) { typedef float f2_t __attribute__((ext_vector_type(2))); typedef __bf16 b2_t __attribute__((ext_vector_type(2)));
    f2_t v = {lo, hi}; b2_t b = __builtin_convertvector(v, b2_t); return __builtin_bit_cast(unsigned, b); }
__device__ __forceinline__ float row16_sum(float v) {
    v += __builtin_bit_cast(float, __builtin_amdgcn_update_dpp(0, __builtin_bit_cast(int, v), 0xB1, 0xF, 0xF, true));
    v += __builtin_bit_cast(float, __builtin_amdgcn_update_dpp(0, __builtin_bit_cast(int, v), 0x4E, 0xF, 0xF, true));
    v += __builtin_bit_cast(float, __builtin_amdgcn_update_dpp(0, __builtin_bit_cast(int, v), 0x141, 0xF, 0xF, true));
    v += __builtin_bit_cast(float, __builtin_amdgcn_update_dpp(0, __builtin_bit_cast(int, v), 0x140, 0xF, 0xF, true));
    return v;
}
__device__ __forceinline__ void store16_sc1(void* p, v4u v) { *(GAS v4u*)p = v; }
#ifndef Y2L0_FP8
#define Y2L0_FP8 1
#endif
#ifndef Y2L1_FP8
#define Y2L1_FP8 1
#endif
#ifndef OI_FP8
#define OI_FP8 0
#endif
#ifndef QH_FP8
#define QH_FP8 1
#endif
#ifndef US_FP8
#define US_FP8 1
#endif
constexpr int US_CH = US_FP8 ? 16384 : 32768, US_W = US_CH / 8, US_KS = US_W / 4, US_LN = US_KS / 64;
__device__ __forceinline__ unsigned pk4_fp8(float a, float b, float c, float d) { int w = 0; w = __builtin_amdgcn_cvt_pk_fp8_f32(a, b, w, false); w = __builtin_amdgcn_cvt_pk_fp8_f32(c, d, w, true); return (unsigned)w; }
__device__ __forceinline__ void un4_fp8(unsigned w, float (&o)[4]) { const f32x2 lo = __builtin_amdgcn_cvt_pk_f32_fp8((int)w, false), hi = __builtin_amdgcn_cvt_pk_f32_fp8((int)w, true); o[0] = lo.x; o[1] = lo.y; o[2] = hi.x; o[3] = hi.y; }
__device__ __forceinline__ size_t tile_off(int b, int h, int c, int x) { return ((size_t)b * SEQ + c * 64 + (x >> 8)) * (D * 2) + (size_t)h * 256 + (x & 255); }

#define LDS_BAR() asm volatile("s_waitcnt lgkmcnt(0)\n\ts_barrier" ::: "memory")
__device__ __forceinline__ void scan2a_range(Frame& F, int u_lo, int u_hi, const bf16* Q0, const bf16* LF, const bf16* V0, unsigned char* UD, unsigned char* QHF, unsigned char* OI, float* DECG) {
    LAS unsigned char* L = F.lds + RING_OFF;
    LAS float* TOT = (LAS float*)(L + SC_TOT); LAS float* DEC = (LAS float*)(L + SC_DEC);
    const int lane = F.lane, w = F.wave, row16 = lane & 15, quad = lane >> 4;
    if (u_lo >= u_hi) return;
    unsigned pq[8], pl[8], pv[8];
    f32x4 sloc[4][2]; float cum0 = 1.f, cum1 = 1.f;
#pragma unroll
    for (int kp = 0; kp < 4; ++kp) { sloc[kp][0] = (f32x4){0.f, 0.f, 0.f, 0.f}; sloc[kp][1] = (f32x4){0.f, 0.f, 0.f, 0.f}; }
#define SC2A_LOAD(u_) do { const int b_ = (u_) >> 9, h_ = ((u_) >> 6) & 7, c_ = (u_) & 63; const size_t o = ((size_t)b_ * SEQ + c_ * 64 + 8 * w) * D + (size_t)h_ * 128 + 2 * lane; \
        _Pragma("unroll") for (int j = 0; j < 8; ++j) { pq[j] = *(const GAS unsigned*)(Q0 + o + (size_t)j * D); pl[j] = *(const GAS unsigned*)(LF + o + (size_t)j * D); pv[j] = *(const GAS unsigned*)(V0 + o + (size_t)j * D); } } while (0)
    SC2A_LOAD(u_lo);
    for (int u = u_lo; u < u_hi; ++u) {
    const int b = u >> 9, h = (u >> 6) & 7, c = u & 63, ch = u;
    unsigned cq[8], cl[8], cv[8];
#pragma unroll
    for (int j = 0; j < 8; ++j) { cq[j] = pq[j]; cl[j] = pl[j]; cv[j] = pv[j]; }
    if (u + 1 < u_hi) SC2A_LOAD(u + 1);
    float lf0[8], lf1[8], pre0[8], pre1[8], kk0[8], kk1[8];
#pragma unroll
    for (int j = 0; j < 8; ++j) { const float f0 = h2f((unsigned short)(cl[j] & 0xffffu)), f1 = h2f((unsigned short)(cl[j] >> 16));
        kk0[j] = 1.0f - f0; kk1[j] = 1.0f - f1; lf0[j] = __logf(f0); lf1[j] = __logf(f1); pre0[j] = lf0[j] + (j ? pre0[j - 1] : 0.f); pre1[j] = lf1[j] + (j ? pre1[j - 1] : 0.f); }
    *(LAS f32x2*)(TOT + w * 128 + 2 * lane) = (f32x2){pre0[7], pre1[7]};
    LDS_BAR();
    { float off0 = 0.f, off1 = 0.f, bref0 = 0.f, bref1 = 0.f, bl0 = 0.f, bl1 = 0.f;
#pragma unroll
      for (int ww = 0; ww < 8; ++ww) { const f32x2 t = *(const LAS f32x2*)(TOT + ww * 128 + 2 * lane);
          if (ww < w) { off0 += t.x; off1 += t.y; } if (ww < 4) { bref0 += t.x; bref1 += t.y; } bl0 += t.x; bl1 += t.y; }
      const float E10 = __expf(bref0), E11 = __expf(bref1), E20 = __expf(bl0 - bref0), E21 = __expf(bl1 - bref1);
      unsigned kh0[4], kh1[4], vt0[4], vt1[4]; float pk0 = 0.f, pk1 = 0.f;
#pragma unroll
      for (int j = 0; j < 8; ++j) { const int r = 8 * w + j;
          const float q0 = bflo(cq[j]), q1 = bfhi(cq[j]);
          const float e0 = __expf(pre0[j] + off0 - bref0), e1 = __expf(pre1[j] + off1 - bref1);
          const float k0 = kk0[j], k1 = kk1[j];
          const float qt0 = q0 * e0, qt1 = q1 * e1, kt0 = k0 * __builtin_amdgcn_rcpf(e0), kt1 = k1 * __builtin_amdgcn_rcpf(e1);
          *(LAS unsigned*)(L + SC_QT + r * 272 + 4 * lane) = cvtpk(qt0, qt1);
          *(LAS unsigned*)(L + SC_KT + r * 272 + 4 * lane) = cvtpk(kt0, kt1);
          *(LAS unsigned*)(L + SC_QH + r * 272 + 4 * lane) = cvtpk(qt0 * E10, qt1 * E11);
          const float kh0f = kt0 * E20, kh1f = kt1 * E21;
          if (j & 1) { kh0[j >> 1] = cvtpk(pk0, kh0f); kh1[j >> 1] = cvtpk(pk1, kh1f); vt0[j >> 1] = (cv[j - 1] & 0xffffu) | (cv[j] << 16); vt1[j >> 1] = (cv[j - 1] >> 16) | (cv[j] & 0xffff0000u); }
          else { pk0 = kh0f; pk1 = kh1f; } }
      *(LAS v4u*)(L + SC_KHT + (2 * lane) * 144 + 16 * w) = (v4u){kh0[0], kh0[1], kh0[2], kh0[3]};
      *(LAS v4u*)(L + SC_KHT + (2 * lane + 1) * 144 + 16 * w) = (v4u){kh1[0], kh1[1], kh1[2], kh1[3]};
      *(LAS v4u*)(L + SC_VT + (2 * lane) * 144 + 16 * w) = (v4u){vt0[0], vt0[1], vt0[2], vt0[3]};
      *(LAS v4u*)(L + SC_VT + (2 * lane + 1) * 144 + 16 * w) = (v4u){vt1[0], vt1[1], vt1[2], vt1[3]};
      if (w == 0) { const float d0_ = __expf(bl0), d1_ = __expf(bl1); cum0 *= d0_; cum1 *= d1_;
          *(LAS f32x2*)(DEC + 2 * lane) = (f32x2){d0_, d1_};
          *(GAS f32x2*)(DECG + (size_t)ch * 128 + 2 * lane) = (f32x2){cum0, cum1}; } }
    LDS_BAR();
    { const int ti = w >> 1;
#pragma unroll
      for (int jj = 0; jj < 2; ++jj) { const int tj = 2 * (w & 1) + jj; f32x4 a = (f32x4){0.f, 0.f, 0.f, 0.f};
          if (tj <= ti) {
#pragma unroll
              for (int ks = 0; ks < 4; ++ks) { const bf16x8 af = *(const LAS bf16x8*)(L + SC_QT + (16 * ti + row16) * 272 + (32 * ks + 8 * quad) * 2);
                  const bf16x8 bfr = *(const LAS bf16x8*)(L + SC_KT + (16 * tj + row16) * 272 + (32 * ks + 8 * quad) * 2);
                  a = __builtin_amdgcn_mfma_f32_16x16x32_bf16(af, bfr, a, 0, 0, 0); } }
          unsigned short pv4[4];
#pragma unroll
          for (int j = 0; j < 4; ++j) { const int t = 16 * ti + 4 * quad + j, s2 = 16 * tj + row16; pv4[j] = (unsigned short)f2bf((s2 <= t) ? a[j] : 0.f); }
#pragma unroll
          for (int j = 0; j < 4; ++j) *(LAS unsigned short*)(L + SC_P + (16 * ti + 4 * quad + j) * 144 + (16 * tj + row16) * 2) = pv4[j]; } }
#pragma unroll
    for (int ff = 0; ff < 2; ++ff) { const int f = 2 * w + ff, mi = f >> 2, ks = f & 3;
        const v2u a0 = *(const LAS v2u*)(L + SC_QH + (16 * mi + row16) * 272 + (32 * ks + 4 * quad) * 2), a1 = *(const LAS v2u*)(L + SC_QH + (16 * mi + row16) * 272 + (32 * ks + 16 + 4 * quad) * 2);
        if (QH_FP8) *(GAS v2u*)(QHF + (size_t)ch * 8192 + f * 512 + lane * 8) = (v2u){pk4_fp8(bflo(a0.x), bfhi(a0.x), bflo(a0.y), bfhi(a0.y)), pk4_fp8(bflo(a1.x), bfhi(a1.x), bflo(a1.y), bfhi(a1.y))};
        else *(GAS v4u*)(QHF + (size_t)ch * 16384 + f * 1024 + lane * 16) = (v4u){a0.x, a0.y, a1.x, a1.y}; }
    bf16x8 vfr[2];
#pragma unroll
    for (int ks = 0; ks < 2; ++ks) vfr[ks] = *(const LAS bf16x8*)(L + SC_VT + (16 * w + row16) * 144 + (32 * ks + 8 * quad) * 2);
#pragma unroll
    for (int kp = 0; kp < 4; ++kp) { f32x4 u2[2];
#pragma unroll
        for (int hh = 0; hh < 2; ++hh) { const int i2 = 2 * kp + hh; f32x4 s = (f32x4){0.f, 0.f, 0.f, 0.f};
#pragma unroll
            for (int ks = 0; ks < 2; ++ks) { const bf16x8 af = *(const LAS bf16x8*)(L + SC_KHT + (16 * i2 + row16) * 144 + (32 * ks + 8 * quad) * 2);
                s = __builtin_amdgcn_mfma_f32_16x16x32_bf16(af, vfr[ks], s, 0, 0, 0); }
            const f32x4 dv_ = *(const LAS f32x4*)(DEC + 32 * kp + 16 * hh + 4 * quad);
            sloc[kp][hh] = dv_ * sloc[kp][hh] + s; u2[hh] = sloc[kp][hh]; }
        if (US_FP8) *(GAS v2u*)(UD + (size_t)ch * US_CH + w * US_W + kp * US_KS + lane * US_LN) = (v2u){pk4_fp8(u2[0][0], u2[0][1], u2[0][2], u2[0][3]), pk4_fp8(u2[1][0], u2[1][1], u2[1][2], u2[1][3])};
        else store16_sc1(UD + (size_t)ch * 32768 + w * 4096 + kp * 1024 + lane * 16, (v4u){cvtpk(u2[0][0], u2[0][1]), cvtpk(u2[0][2], u2[0][3]), cvtpk(u2[1][0], u2[1][1]), cvtpk(u2[1][2], u2[1][3])}); }
    LDS_BAR();
    { f32x4 oacc[4];
#pragma unroll
      for (int mi = 0; mi < 4; ++mi) { oacc[mi] = (f32x4){0.f, 0.f, 0.f, 0.f};
#pragma unroll
          for (int ks = 0; ks < 2; ++ks) { const bf16x8 af = *(const LAS bf16x8*)(L + SC_P + (16 * mi + row16) * 144 + (32 * ks + 8 * quad) * 2);
              oacc[mi] = __builtin_amdgcn_mfma_f32_16x16x32_bf16(af, vfr[ks], oacc[mi], 0, 0, 0); } }
#pragma unroll
      for (int hh = 0; hh < 2; ++hh) { if (OI_FP8) { if (hh == 0) *(GAS v4u*)(OI + tile_off(b, h, c, w * 1024 + lane * 16)) = (v4u){pk4_fp8(oacc[0][0], oacc[0][1], oacc[0][2], oacc[0][3]), pk4_fp8(oacc[1][0], oacc[1][1], oacc[1][2], oacc[1][3]), pk4_fp8(oacc[2][0], oacc[2][1], oacc[2][2], oacc[2][3]), pk4_fp8(oacc[3][0], oacc[3][1], oacc[3][2], oacc[3][3])}; }
          else *(GAS v4u*)(OI + tile_off(b, h, c, w * 2048 + hh * 1024 + lane * 16)) =
          (v4u){cvtpk(oacc[2 * hh][0], oacc[2 * hh][1]), cvtpk(oacc[2 * hh][2], oacc[2 * hh][3]), cvtpk(oacc[2 * hh + 1][0], oacc[2 * hh + 1][1]), cvtpk(oacc[2 * hh + 1][2], oacc[2 * hh + 1][3])}; } }
    }
#undef SC2A_LOAD
}
__device__ __forceinline__ void scan2c_range(Frame& F, int u_lo, int u_hi, const unsigned char* UD, const unsigned char* QHF, const bf16* G0, const float* norm_g, bf16* O0, const float* DECG, unsigned char* O08 = nullptr) {
    if (u_lo >= u_hi) return;
    LAS unsigned char* L = F.lds + RING_OFF;
    LAS float* SS = (LAS float*)(L + SC_SS);
    const int lane = F.lane, w = F.wave, row16 = lane & 15, quad = lane >> 4;
    unsigned pg[8]; v4u poi[2], psf[4], pqh[16]; f32x4 pdc[4][2];
    f32x4 carry[4][2];
#pragma unroll
    for (int ks = 0; ks < 4; ++ks) { carry[ks][0] = (f32x4){0.f, 0.f, 0.f, 0.f}; carry[ks][1] = (f32x4){0.f, 0.f, 0.f, 0.f}; }
    { const int glen = u_hi - u_lo, c_lo = u_lo & 63, ngrp = c_lo / glen, ubh = u_lo - c_lo;
      for (int gq = 0; gq < ngrp; ++gq) { const int ul = ubh + (gq + 1) * glen - 1;
#pragma unroll
          for (int ks = 0; ks < 4; ++ks) { float a4[4], b4[4];
              if (US_FP8) { const v2u t_ = *(const GAS v2u*)(UD + (size_t)ul * US_CH + w * US_W + ks * US_KS + lane * US_LN); un4_fp8(t_.x, a4); un4_fp8(t_.y, b4); }
              else { const v4u t_ = *(const GAS v4u*)(UD + (size_t)ul * 32768 + w * 4096 + ks * 1024 + lane * 16); a4[0] = bflo(t_.x); a4[1] = bfhi(t_.x); a4[2] = bflo(t_.y); a4[3] = bfhi(t_.y); b4[0] = bflo(t_.z); b4[1] = bfhi(t_.z); b4[2] = bflo(t_.w); b4[3] = bfhi(t_.w); }
              const f32x4 da = *(const GAS f32x4*)(DECG + (size_t)ul * 128 + 32 * ks + 4 * quad), db = *(const GAS f32x4*)(DECG + (size_t)ul * 128 + 32 * ks + 16 + 4 * quad);
              carry[ks][0] = da * carry[ks][0] + (f32x4){a4[0], a4[1], a4[2], a4[3]}; carry[ks][1] = db * carry[ks][1] + (f32x4){b4[0], b4[1], b4[2], b4[3]}; } } }
#define SC2C_LOAD(u_) do { const int b_ = (u_) >> 9, h_ = ((u_) >> 6) & 7, c_ = (u_) & 63; \
        _Pragma("unroll") for (int j = 0; j < 8; ++j) pg[j] = *(const GAS unsigned*)(G0 + ((size_t)b_ * SEQ + c_ * 64 + 8 * w + j) * D + (size_t)h_ * 128 + 2 * lane); \
        _Pragma("unroll") for (int hh = 0; hh < 2; ++hh) { if (OI_FP8) { if (hh == 0) poi[0] = *(const GAS v4u*)((const unsigned char*)O0 + tile_off(b_, h_, c_, w * 1024 + lane * 16)); } else poi[hh] = *(const GAS v4u*)((const unsigned char*)O0 + tile_off(b_, h_, c_, w * 2048 + hh * 1024 + lane * 16)); } \
        _Pragma("unroll") for (int ks = 0; ks < 4; ++ks) { const bool in_ = (u_) > u_lo;     \
            if (US_FP8) { const v2u t_ = in_ ? *(const GAS v2u*)(UD + (size_t)((u_) - 1) * US_CH + w * US_W + ks * US_KS + lane * US_LN) : (v2u){0u, 0u}; psf[ks] = (v4u){t_.x, t_.y, 0u, 0u}; } \
            else psf[ks] = in_ ? *(const GAS v4u*)(UD + (size_t)((u_) - 1) * 32768 + w * 4096 + ks * 1024 + lane * 16) : (v4u){0u, 0u, 0u, 0u}; \
            pdc[ks][0] = in_ ? *(const GAS f32x4*)(DECG + (size_t)((u_) - 1) * 128 + 32 * ks + 4 * quad) : (f32x4){1.f, 1.f, 1.f, 1.f}; \
            pdc[ks][1] = in_ ? *(const GAS f32x4*)(DECG + (size_t)((u_) - 1) * 128 + 32 * ks + 16 + 4 * quad) : (f32x4){1.f, 1.f, 1.f, 1.f}; } \
        _Pragma("unroll") for (int f = 0; f < 16; ++f) { if (QH_FP8) { const v2u t_ = *(const GAS v2u*)(QHF + (size_t)(u_) * 8192 + f * 512 + lane * 8); pqh[f] = (v4u){t_.x, t_.y, 0u, 0u}; } else pqh[f] = *(const GAS v4u*)(QHF + (size_t)(u_) * 16384 + f * 1024 + lane * 16); } } while (0)
    SC2C_LOAD(u_lo);
    for (int u = u_lo; u < u_hi; ++u) {
        const int b = u >> 9, h = (u >> 6) & 7, c = u & 63;
        const size_t gcol = (size_t)h * 128 + 2 * lane;
        unsigned cg[8];
#pragma unroll
        for (int j = 0; j < 8; ++j) cg[j] = pg[j];
        v4u sfb[4];
#pragma unroll
        for (int ks = 0; ks < 4; ++ks) { float a4[4], b4[4];
            if (US_FP8) { un4_fp8(psf[ks].x, a4); un4_fp8(psf[ks].y, b4); }
            else { a4[0] = bflo(psf[ks].x); a4[1] = bfhi(psf[ks].x); a4[2] = bflo(psf[ks].y); a4[3] = bfhi(psf[ks].y); b4[0] = bflo(psf[ks].z); b4[1] = bfhi(psf[ks].z); b4[2] = bflo(psf[ks].w); b4[3] = bfhi(psf[ks].w); }
#pragma unroll
            for (int e = 0; e < 4; ++e) { a4[e] += pdc[ks][0][e] * carry[ks][0][e]; b4[e] += pdc[ks][1][e] * carry[ks][1][e]; }
            sfb[ks] = (v4u){cvtpk(a4[0], a4[1]), cvtpk(a4[2], a4[3]), cvtpk(b4[0], b4[1]), cvtpk(b4[2], b4[3])}; }
        f32x4 oacc[4];
#pragma unroll
        for (int mi = 0; mi < 4; ++mi) { if (OI_FP8) { float t4[4]; un4_fp8(mi == 0 ? poi[0].x : mi == 1 ? poi[0].y : mi == 2 ? poi[0].z : poi[0].w, t4); oacc[mi] = (f32x4){t4[0], t4[1], t4[2], t4[3]}; }
            else { const unsigned lo = mi & 1 ? poi[mi >> 1].z : poi[mi >> 1].x, hi2 = mi & 1 ? poi[mi >> 1].w : poi[mi >> 1].y; oacc[mi] = (f32x4){bflo(lo), bfhi(lo), bflo(hi2), bfhi(hi2)}; } }
#pragma unroll
        for (int mi = 0; mi < 4; ++mi)
#pragma unroll
            for (int ks = 0; ks < 4; ++ks) { v4u qa = pqh[mi * 4 + ks];
                if (QH_FP8) { float a4[4], b4[4]; un4_fp8(qa.x, a4); un4_fp8(qa.y, b4); qa = (v4u){cvtpk(a4[0], a4[1]), cvtpk(a4[2], a4[3]), cvtpk(b4[0], b4[1]), cvtpk(b4[2], b4[3])}; }
                oacc[mi] = __builtin_amdgcn_mfma_f32_16x16x32_bf16(__builtin_bit_cast(bf16x8, qa), __builtin_bit_cast(bf16x8, sfb[ks]), oacc[mi], 0, 0, 0); }
        if (u + 1 < u_hi) SC2C_LOAD(u + 1);
#pragma unroll
        for (int mi = 0; mi < 4; ++mi)
#pragma unroll
            for (int j = 0; j < 4; ++j) { const float v = oacc[mi][j]; const float q = row16_sum(v * v);
                const int t = 16 * mi + 4 * quad + j;
                if (row16 == 0) SS[t * 8 + w] = q;
                *(LAS float*)(L + SC_OUT + t * 528 + (16 * w + row16) * 4) = v; }
        LDS_BAR();
        const float ng0 = norm_g[h * 128 + 2 * lane], ng1 = norm_g[h * 128 + 2 * lane + 1];
#pragma unroll
        for (int j = 0; j < 8; ++j) { const int r = 8 * w + j;
            const f32x4 sa = *(const LAS f32x4*)(SS + r * 8), sb = *(const LAS f32x4*)(SS + r * 8 + 4);
            const float rstd = __builtin_amdgcn_rsqf((((sa.x + sa.y) + (sa.z + sa.w)) + ((sb.x + sb.y) + (sb.z + sb.w))) * (1.0f / 128.0f) + RMS_EPS);
            const f32x2 v = *(const LAS f32x2*)(L + SC_OUT + r * 528 + 8 * lane);
            float o0_ = v.x * rstd * ng0 * pg8::sigmoidf_(bflo(cg[j])), o1_ = v.y * rstd * ng1 * pg8::sigmoidf_(bfhi(cg[j]));
            if (O08) *(GAS unsigned short*)(O08 + ((size_t)b * SEQ + c * 64 + r) * D + gcol) = (unsigned short)__builtin_amdgcn_cvt_pk_fp8_f32(o0_, o1_, 0, false);
            else *(GAS unsigned*)(O0 + ((size_t)b * SEQ + c * 64 + r) * D + gcol) = cvtpk(o0_, o1_); }
        LDS_BAR();
    }
#undef SC2C_LOAD
}

constexpr int RT_WT = 0, RT_LCNT = 65536, RT_LBASE = RT_LCNT + 64, RT_INFO = RT_LBASE + 64, RT_LG = RT_INFO + 3072;
static_assert(RT_LG + 8192 <= RING_BYTES, "router LDS map");
template <bool RB16, int RESMODE> __device__ __forceinline__ void ln_router_phase(Frame& F, const float* R, const void* res, const float* lng, const float* lnb, const float* router_w, const float* router_b,
                                                bf16* X1B, unsigned char* X18, gu32* cnt, int* DEST, float* GATE) {
    LAS unsigned char* L = F.lds + RING_OFF;
    LAS float* WT = (LAS float*)(L + RT_WT); LAS int* lcnt = (LAS int*)(L + RT_LCNT); LAS int* lbase = (LAS int*)(L + RT_LBASE); LAS int* info = (LAS int*)(L + RT_INFO); LAS float* LG = (LAS float*)(L + RT_LG);
    for (int idx = F.tid; idx < 16 * D; idx += NWAVES * 64) { const int col = idx >> 4, e = idx & 15; WT[e * D + col] = router_w[idx]; }
    if (F.tid < 16) lcnt[F.tid] = 0;
    f32x4 gv[4], bv[4];
#pragma unroll
    for (int j = 0; j < 4; ++j) { gv[j] = *(const f32x4*)(lng + 4 * F.lane + 256 * j); bv[j] = *(const f32x4*)(lnb + 4 * F.lane + 256 * j); }
    __syncthreads();
    const int lane = F.lane;
    for (int base = F.vcu * 128; base < M; base += F.G * 128) {
        f32x4 v[4][4];
#define LNR_LOAD(it_) do { const int lr0_ = F.wave * 16 + (it_) * 4; \
            _Pragma("unroll") for (int r = 0; r < 4; ++r) { \
                if (RB16 || RESMODE) { const GAS v2u* xr = (const GAS v2u*)((const bf16*)R + (size_t)(base + lr0_ + r) * D) + lane; \
                    _Pragma("unroll") for (int j = 0; j < 4; ++j) { const v2u t = xr[64 * j]; v[r][j] = (f32x4){bflo(t.x), bfhi(t.x), bflo(t.y), bfhi(t.y)}; } } \
                else { const GAS f32x4* xr = (const GAS f32x4*)(R + (size_t)(base + lr0_ + r) * D) + lane; \
                    _Pragma("unroll") for (int j = 0; j < 4; ++j) v[r][j] = xr[64 * j]; } \
                if (RESMODE == 1) { const GAS f32x4* rr = (const GAS f32x4*)((const float*)res + (size_t)(base + lr0_ + r) * D) + lane;     \
                    _Pragma("unroll") for (int j = 0; j < 4; ++j) v[r][j] = rr[64 * j] * DN_ALPHA + v[r][j]; } \
                if (RESMODE == 2) { const GAS v2u* rr = (const GAS v2u*)((const bf16*)res + (size_t)(base + lr0_ + r) * D) + lane; \
                    _Pragma("unroll") for (int j = 0; j < 4; ++j) { const v2u t = rr[64 * j]; v[r][j] = (f32x4){bflo(t.x), bfhi(t.x), bflo(t.y), bfhi(t.y)} * DN_ALPHA + v[r][j]; } } } \
        } while (0)
        LNR_LOAD(0);
#pragma unroll 1
        for (int it = 0; it < 4; ++it) {
            const int lr0 = F.wave * 16 + it * 4;
#pragma unroll
            for (int r = 0; r < 4; ++r) { float s = 0.f;
#pragma unroll
                for (int j = 0; j < 4; ++j) s += (v[r][j].x + v[r][j].y) + (v[r][j].z + v[r][j].w);
                const float mean = wave_sum(s) * (1.f / D); float s2 = 0.f;
#pragma unroll
                for (int j = 0; j < 4; ++j) { v[r][j] = v[r][j] - mean; s2 += (v[r][j].x * v[r][j].x + v[r][j].y * v[r][j].y) + (v[r][j].z * v[r][j].z + v[r][j].w * v[r][j].w); }
                const float rstd = 1.f / sqrtf(wave_sum(s2) * (1.f / D) + LN_EPS);
                GAS v2u* o8 = (GAS v2u*)(X1B + (size_t)(base + lr0 + r) * D) + lane;
#pragma unroll
                for (int j = 0; j < 4; ++j) { v[r][j] = v[r][j] * rstd * gv[j] + bv[j]; v2u o; o.x = pk2(v[r][j].x, v[r][j].y); o.y = pk2(v[r][j].z, v[r][j].w); o8[64 * j] = o;
                    if (X18) { int w8 = 0; w8 = __builtin_amdgcn_cvt_pk_fp8_f32(v[r][j].x, v[r][j].y, w8, false); w8 = __builtin_amdgcn_cvt_pk_fp8_f32(v[r][j].z, v[r][j].w, w8, true);
                        *(GAS unsigned*)(X18 + (size_t)(base + lr0 + r) * D + 4 * lane + 256 * j) = (unsigned)w8; } } }
            float val[64];
#pragma unroll
            for (int e = 0; e < 16; ++e) { f32x4 wv[4];
#pragma unroll
                for (int j = 0; j < 4; ++j) wv[j] = *(const LAS f32x4*)(WT + e * D + 4 * lane + 256 * j);
#pragma unroll
                for (int r = 0; r < 4; ++r) { float p = 0.f;
#pragma unroll
                    for (int j = 0; j < 4; ++j) p += (v[r][j].x * wv[j].x + v[r][j].y * wv[j].y) + (v[r][j].z * wv[j].z + v[r][j].w * wv[j].w);
                    val[r * 16 + e] = p; } }
#pragma unroll
            for (int st = 0; st < 6; ++st) { const int m = 32 >> st, n = 64 >> st; const bool up = (lane & m) != 0;
                if (st == 2) { if (it + 1 < 4) LNR_LOAD(it + 1); }
#pragma unroll
                for (int i = 0; i < n / 2; ++i) { const float a = val[i], b2 = val[i + n / 2]; const float keep = up ? b2 : a, send = up ? a : b2; val[i] = keep + __shfl_xor(send, m); } }
            LG[(lr0 + (lane >> 4)) * 16 + (lane & 15)] = val[0];
        }
#undef LNR_LOAD
        LDS_WAIT(); asm volatile("" ::: "memory");
        if (lane < 16) {
            const int lr = F.wave * 16 + lane;
            float lg[16];
#pragma unroll
            for (int q = 0; q < 4; ++q) { const f32x4 t = *(const LAS f32x4*)(LG + lr * 16 + 4 * q); lg[4 * q] = t.x; lg[4 * q + 1] = t.y; lg[4 * q + 2] = t.z; lg[4 * q + 3] = t.w; }
            float mx = lg[0];
#pragma unroll
            for (int e = 1; e < 16; ++e) mx = fmaxf(mx, lg[e]);
            float pe[16], sum = 0.f;
#pragma unroll
            for (int e = 0; e < 16; ++e) { pe[e] = __expf(lg[e] - mx); sum += pe[e]; }
            const float inv = 1.0f / sum; float sel[16];
#pragma unroll
            for (int e = 0; e < 16; ++e) { pe[e] *= inv; sel[e] = pe[e] + router_b[e]; }
            float gs[4];
#pragma unroll
            for (int g = 0; g < 4; ++g) { const float a = sel[4 * g], b2 = sel[4 * g + 1], c2 = sel[4 * g + 2], d2 = sel[4 * g + 3];
                const float hi1 = fmaxf(a, b2), lo1 = fminf(a, b2), hi2 = fmaxf(c2, d2), lo2 = fminf(c2, d2);
                gs[g] = fmaxf(hi1, hi2) + fmaxf(fminf(hi1, hi2), fmaxf(lo1, lo2)); }
            int gb = 0; float gbv = gs[0];
#pragma unroll
            for (int g = 1; g < 4; ++g) if (gs[g] > gbv) { gbv = gs[g]; gb = g; }
            float s4[4], p4[4];
#pragma unroll
            for (int k = 0; k < 4; ++k) { s4[k] = gb == 0 ? sel[k] : gb == 1 ? sel[4 + k] : gb == 2 ? sel[8 + k] : sel[12 + k]; p4[k] = gb == 0 ? pe[k] : gb == 1 ? pe[4 + k] : gb == 2 ? pe[8 + k] : pe[12 + k]; }
            int i0 = 0; float b0 = s4[0];
#pragma unroll
            for (int k = 1; k < 4; ++k) if (s4[k] > b0) { b0 = s4[k]; i0 = k; }
            int i1 = -1; float b1 = -INFINITY;
#pragma unroll
            for (int k = 0; k < 4; ++k) if (k != i0 && (i1 < 0 || s4[k] > b1)) { b1 = s4[k]; i1 = k; }
            const float q0 = i0 == 0 ? p4[0] : i0 == 1 ? p4[1] : i0 == 2 ? p4[2] : p4[3], q1 = i1 == 0 ? p4[0] : i1 == 1 ? p4[1] : i1 == 2 ? p4[2] : p4[3];
            const float den = 1.0f / (q0 + q1);
            const int e0 = gb * 4 + i0, e1 = gb * 4 + i1;
            const int p0 = __hip_atomic_fetch_add(lcnt + e0, 1, __ATOMIC_RELAXED, __HIP_MEMORY_SCOPE_WORKGROUP), p1 = __hip_atomic_fetch_add(lcnt + e1, 1, __ATOMIC_RELAXED, __HIP_MEMORY_SCOPE_WORKGROUP);
            info[lr] = e0; info[128 + lr] = e1; info[256 + lr] = p0; info[384 + lr] = p1; info[512 + lr] = __float_as_int(q0 * den); info[640 + lr] = __float_as_int(q1 * den);
        }
        __syncthreads();
        if (F.tid < 16) { const int n = lcnt[F.tid]; lbase[F.tid] = n ? (int)__hip_atomic_fetch_add(cnt + 64 * F.tid, (unsigned)n, RLX_AGENT) : 0; }
        __syncthreads();
        if (F.tid < 128) { const int lr = F.tid, row = base + lr; const int e0 = info[lr], e1 = info[128 + lr];
            const int d0 = e0 * ECAP + lbase[e0] + info[256 + lr], d1 = e1 * ECAP + lbase[e1] + info[384 + lr];
            DEST[d0] = row * 2; GATE[d0] = __int_as_float(info[512 + lr]); DEST[d1] = row * 2 + 1; GATE[d1] = __int_as_float(info[640 + lr]); }
        __syncthreads();
        if (F.tid < 16) lcnt[F.tid] = 0;
        __syncthreads();
    }
}
__device__ __forceinline__ int moe_table(Frame& F, gu32* cnt) {
    LAS int* tab = (LAS int*)(F.lds + MOETAB_OFF);
    __syncthreads();
    if (F.wave == 0) {
        const int e = F.lane & 15; const int n = (int)__hip_atomic_load(cnt + 64 * e, RLX_AGENT); const int nt = (n + 255) >> 8;
        int incl = nt;
#pragma unroll
        for (int d = 1; d < 16; d <<= 1) { const int t = __shfl_up(incl, d, 16); if (e >= d) incl += t; }
        if (F.lane < 16) { tab[e] = incl - nt; tab[17 + e] = (incl - nt) * 256; tab[34 + e] = n; if (e == 15) { tab[16] = incl; tab[33] = incl * 256; } }
    }
    __syncthreads();
    return tab[16] * 4;
}
struct Ln2Raw { v4u a[2], y0[2], y1[2]; };
template <bool Y8> __device__ __forceinline__ void ln2_load(Ln2Raw& r, const bf16* X1B, const bf16* Y2, int m, int lane) {
#pragma unroll
    for (int j = 0; j < 2; ++j) { const size_t c = 8 * lane + 512 * j;
        r.a[j] = *(const GAS v4u*)(X1B + (size_t)m * D + c);
        if (Y8) { const v2u t0 = *(const GAS v2u*)((const unsigned char*)Y2 + (size_t)(2 * m) * D + c), t1 = *(const GAS v2u*)((const unsigned char*)Y2 + (size_t)(2 * m + 1) * D + c);
            r.y0[j] = (v4u){t0.x, t0.y, 0u, 0u}; r.y1[j] = (v4u){t1.x, t1.y, 0u, 0u}; }
        else { r.y0[j] = *(const GAS v4u*)(Y2 + (size_t)(2 * m) * D + c); r.y1[j] = *(const GAS v4u*)(Y2 + (size_t)(2 * m + 1) * D + c); } }
}
template <bool FINAL, bool Y8 = false> __device__ __forceinline__ void ln2_phase(Frame& F, const bf16* X1B, const bf16* Y2, const float* lng, const float* lnb, bf16* XOUT, float* out, unsigned char* X8 = nullptr) {
    float gv[16], bv[16];
#pragma unroll
    for (int j = 0; j < 2; ++j)
#pragma unroll
        for (int i = 0; i < 8; ++i) { gv[8 * j + i] = lng[8 * F.lane + 512 * j + i]; bv[8 * j + i] = lnb[8 * F.lane + 512 * j + i]; }
    const int gw = F.vcu * NWAVES + F.wave, NGW = F.G * NWAVES;
    Ln2Raw cur, nxt;
    if (gw < M) ln2_load<Y8>(cur, X1B, Y2, gw, F.lane);
    for (int m = gw; m < M; m += NGW) {
        if (m + NGW < M) ln2_load<Y8>(nxt, X1B, Y2, m + NGW, F.lane);
        float v[16]; float s = 0.f;
#pragma unroll
        for (int j = 0; j < 2; ++j) { const v4u a = cur.a[j];
            if (Y8) { float p0[4], p1[4], q0[4], q1[4]; un4_fp8(cur.y0[j].x, p0); un4_fp8(cur.y0[j].y, p1); un4_fp8(cur.y1[j].x, q0); un4_fp8(cur.y1[j].y, q1);
#pragma unroll
                for (int i = 0; i < 4; ++i) { const float ya = i < 2 ? (p0[2 * i] + q0[2 * i]) : (p1[2 * i - 4] + q1[2 * i - 4]), yb = i < 2 ? (p0[2 * i + 1] + q0[2 * i + 1]) : (p1[2 * i - 3] + q1[2 * i - 3]);
                    v[8 * j + 2 * i] = DN_ALPHA * bflo(a[i]) + ya; v[8 * j + 2 * i + 1] = DN_ALPHA * bfhi(a[i]) + yb; } }
            else { const v4u y0 = cur.y0[j], y1 = cur.y1[j];
#pragma unroll
                for (int i = 0; i < 4; ++i) { v[8 * j + 2 * i] = DN_ALPHA * bflo(a[i]) + (bflo(y0[i]) + bflo(y1[i])); v[8 * j + 2 * i + 1] = DN_ALPHA * bfhi(a[i]) + (bfhi(y0[i]) + bfhi(y1[i])); } } }
#pragma unroll
        for (int i = 0; i < 16; ++i) s += v[i];
        const float mean = wave_sum(s) * (1.f / D); float s2 = 0.f;
#pragma unroll
        for (int i = 0; i < 16; ++i) { v[i] -= mean; s2 += v[i] * v[i]; }
        const float rstd = 1.f / sqrtf(wave_sum(s2) * (1.f / D) + LN_EPS);
#pragma unroll
        for (int i = 0; i < 16; ++i) v[i] = v[i] * rstd * gv[i] + bv[i];
#pragma unroll
        for (int j = 0; j < 2; ++j) { const size_t c = (size_t)m * D + 8 * F.lane + 512 * j;
            if (FINAL) { *(GAS f32x4*)(out + c) = (f32x4){v[8 * j], v[8 * j + 1], v[8 * j + 2], v[8 * j + 3]}; *(GAS f32x4*)(out + c + 4) = (f32x4){v[8 * j + 4], v[8 * j + 5], v[8 * j + 6], v[8 * j + 7]}; }
            else { *(GAS v4u*)(XOUT + c) = (v4u){pk2(v[8 * j], v[8 * j + 1]), pk2(v[8 * j + 2], v[8 * j + 3]), pk2(v[8 * j + 4], v[8 * j + 5]), pk2(v[8 * j + 6], v[8 * j + 7])};
                if (X8) { int w0 = 0, w1 = 0; w0 = __builtin_amdgcn_cvt_pk_fp8_f32(v[8 * j], v[8 * j + 1], w0, false); w0 = __builtin_amdgcn_cvt_pk_fp8_f32(v[8 * j + 2], v[8 * j + 3], w0, true);
                    w1 = __builtin_amdgcn_cvt_pk_fp8_f32(v[8 * j + 4], v[8 * j + 5], w1, false); w1 = __builtin_amdgcn_cvt_pk_fp8_f32(v[8 * j + 6], v[8 * j + 7], w1, true); *(GAS v2u*)(X8 + c) = (v2u){(unsigned)w0, (unsigned)w1}; } } }
        cur = nxt;
    }
}
__device__ __forceinline__ void combine_phase(Frame& F, const bf16* O1, const bf16* O2, const float* subln_g, const float* tab, bf16* OA) {
    const float lam = tab[1024];
    float gv[8];
#pragma unroll
    for (int i = 0; i < 8; ++i) gv[i] = subln_g[8 * (F.lane & 15) + i] * (1.0f - LAMBDA_INIT);
    const int gw = F.vcu * NWAVES + F.wave, NGW = F.G * NWAVES;
    for (int m = gw; m < M; m += NGW) {
#pragma unroll
        for (int j = 0; j < 2; ++j) { const size_t c = (size_t)m * D + 8 * F.lane + 512 * j;
            const v4u a = *(const GAS v4u*)(O1 + c), b2 = *(const GAS v4u*)(O2 + c); float v[8]; float q = 0.f;
#pragma unroll
            for (int i = 0; i < 4; ++i) { v[2 * i] = bflo(a[i]) - lam * bflo(b2[i]); v[2 * i + 1] = bfhi(a[i]) - lam * bfhi(b2[i]); q += v[2 * i] * v[2 * i] + v[2 * i + 1] * v[2 * i + 1]; }
            q += __shfl_xor(q, 1); q += __shfl_xor(q, 2); q += __shfl_xor(q, 4); q += __shfl_xor(q, 8);
            const float rstd = 1.0f / sqrtf(q * (1.0f / 128.0f) + RMS_EPS);
            *(GAS v4u*)(OA + c) = (v4u){pk2(v[0] * rstd * gv[0], v[1] * rstd * gv[1]), pk2(v[2] * rstd * gv[2], v[3] * rstd * gv[3]), pk2(v[4] * rstd * gv[4], v[5] * rstd * gv[5]), pk2(v[6] * rstd * gv[6], v[7] * rstd * gv[7])}; }
    }
}

struct Args { const float* in[19]; float* out; unsigned char* ws; int ph_lo, ph_hi, li, pad; };
__global__ void __launch_bounds__(NWAVES * 64, 2) yoco_fwd(Args args) {
    extern __shared__ __attribute__((aligned(16))) unsigned char lds[];
    Frame F;
    F.lds = (LAS unsigned char*)lds;
    F.tid = threadIdx.x; F.lane = F.tid & 63; F.wave = __builtin_amdgcn_readfirstlane(F.tid >> 6);
    F.G = gridDim.x; { const int bx = blockIdx.x; F.vcu = (F.G % 8 == 0) ? (bx % 8) * (F.G / 8) + bx / 8 : bx; }
    unsigned char* ws = args.ws;
    F.ctl = (gu32*)(ws + WS_CTL);
    Inputs in;
    in.x = args.in[0]; in.a_w_in = args.in[1]; in.a_lb = args.in[2]; in.a_norm_g = args.in[3]; in.a_w_out = args.in[4]; in.kv_w = args.in[5]; in.b_w_q = args.in[6]; in.b_lam = args.in[7];
    in.b_subln_g = args.in[8]; in.b_w_out = args.in[9]; in.ln1_g = args.in[10]; in.ln1_b = args.in[11]; in.ln2_g = args.in[12]; in.ln2_b = args.in[13]; in.router_w = args.in[14]; in.router_b = args.in[15];
    in.moe_w_gate = args.in[16]; in.moe_w_up = args.in[17]; in.moe_w_down = args.in[18];
    for (int u = F.tid; u < (LDS_BYTES - LDSCTL_OFF) / 4; u += NWAVES * 64) ((LAS unsigned*)(F.lds + LDSCTL_OFF))[u] = 0u;
    __syncthreads();
    XcdBarrier bar; bar.bar = (unsigned*)(F.ctl + CW_BAR) + args.li * XCD_BAR_WORDS; bar.x = 0; bar.st = nullptr;
    if (N_LAUNCH_MODE == 1) bar = xcd_barrier_post((unsigned*)(F.ctl + CW_BAR) + args.li * XCD_BAR_WORDS, (volatile LAS unsigned*)(F.lds + MISC_OFF) + 8);
    const int lo = args.ph_lo, hi = args.ph_hi;
#ifndef PHASE_MASK
#define PHASE_MASK 0xffff
#endif
#define IN(k) (((PHASE_MASK >> (k)) & 1) && lo <= (k) && (k) < hi)
#define RETID() do { int t_ = threadIdx.x; asm volatile("" : "+v"(t_)); F.tid = t_; F.lane = t_ & 63; } while (0)
#ifndef REPEAT_MASK
#define REPEAT_MASK 0
#endif
#define NREP(k) (((REPEAT_MASK >> (k)) & 1) ? 2 : 1)
#define REP(k) for (int rep_ = 0; rep_ < NREP(k); ++rep_, (rep_ < NREP(k) ? xcd_barrier(bar) : (void)0))
#ifdef DIAG_PHASE
#define SEAM(k) do { if (IN(k) && IN((k) + 1)) xcd_barrier(bar); if (blockIdx.x == 0 && F.tid == 0) ((unsigned long long*)(ws + WS_TAB + 8192))[(k) + 1] = __builtin_amdgcn_s_memrealtime(); } while (0)
#else
#define BARW(j) do { if (SHADOW_CONV && N_LAUNCH_MODE == 1) xcd_barrier_w(bar, [&]() { shadow_convert(F, in, ws, (j)); }); else xcd_barrier(bar); } while (0)
#define SEAM_ORD(k) ((k) <= 1 ? (k) : (k) <= 9 ? (k) + 1 : (k))
#define SEAM(k) do { if (IN(k) && IN((k) + 1)) BARW(SEAM_ORD(k)); } while (0)
#endif
    bf16* const bA = (bf16*)(ws + WS_A); bf16* const bB = (bf16*)(ws + WS_B); bf16* const bC = (bf16*)(ws + WS_C); bf16* const bD = (bf16*)(ws + WS_D); bf16* const bE = (bf16*)(ws + WS_E); bf16* const bF = (bf16*)(ws + WS_F);
    const float* const tab = (const float*)(ws + WS_TAB);
    int* const DEST = (int*)(ws + WS_DEST); float* const GATE = (float*)(ws + WS_GATE);

#ifdef DIAG_PHASE
    if (blockIdx.x == 0 && F.tid == 0) ((unsigned long long*)(ws + WS_TAB + 8192))[0] = __builtin_amdgcn_s_memrealtime();
#endif
    if (IN(0)) REP(0) { RETID(); p0_prologue(F, in, ws); moe_weight_convert(F, in, ws, 0, (SHADOW_CONV && N_LAUNCH_MODE == 1) ? SH_P0 : MOE_NIT, F.vcu * NWAVES + F.wave, F.G * NWAVES); } SEAM(0);
    if (IN(1)) REP(1) { RETID();
        { pg8::Gemm g{bA, (const bf16*)(ws + WS_WIN), D}; pg8::StaticOrder S; S.init(M, proj_count(false) * D, D, F.G, (int)blockIdx.x);
          pg8::EpiProj E{bB, bC, bD, bE, tab, proj_gmap(false)};
          pg8::gemm_phase<pg8::EpiProj, pg8::StaticOrder, true>(F.lds + RING_OFF, g, S, E); }
        if constexpr (FP8_PROJ != 0) {
            __syncthreads();
            pg8::Gemm g{bF, ws + WS_WIN8, D}; pg8::StaticOrder S; S.init(M, proj_count(true) * D, D, F.G, (int)blockIdx.x);
            pg8::EpiProj E{bB, bC, bD, bE, tab, proj_gmap(true)};
            pg8::gemm_phase<pg8::EpiProj, pg8::StaticOrder, true, true>(F.lds + RING_OFF, g, S, E); }
    } SEAM(1);
    if (IN(2)) REP(2) { RETID();
        unsigned char* UD = (unsigned char*)args.out; unsigned char* QHF = (US_FP8 && QH_FP8) ? (unsigned char*)args.out + 64 * MiB : (unsigned char*)bA; float* DECG = (float*)(ws + WS_DEST);
        const int upw = (4096 + F.G - 1) / F.G;
        { const int u0 = F.vcu * upw, u1 = (F.vcu + 1) * upw < 4096 ? (F.vcu + 1) * upw : 4096; scan2a_range(F, u0, u1, bB, bC, bD, UD, QHF, (unsigned char*)bF, DECG); }
#ifdef PROBE_2A
        xcd_barrier(bar);
        { const int u0 = F.vcu * upw, u1 = (F.vcu + 1) * upw < 4096 ? (F.vcu + 1) * upw : 4096; scan2a_range(F, u0, u1, bB, bC, bD, UD, QHF, (unsigned char*)bF, DECG); }
#endif
        BARW(2);
        { const int u0 = F.vcu * upw, u1 = (F.vcu + 1) * upw < 4096 ? (F.vcu + 1) * upw : 4096; scan2c_range(F, u0, u1, UD, QHF, bE, in.a_norm_g, bF, DECG, FP8_WO ? (unsigned char*)bD : nullptr); }
    } SEAM(2);
    if (IN(3)) REP(3) { RETID();
        pg8::Gemm g{FP8_WO ? (const void*)bD : (const void*)bF, (const void*)(ws + WS_WOUT), D}; pg8::StaticOrder S; S.init(M, D, D, F.G, (int)blockIdx.x);
        if constexpr (MIX_SPLIT) { pg8::EpiBf16 E{bB, D, 0, 0, 1.0f}; pg8::gemm_phase<pg8::EpiBf16, pg8::StaticOrder, true>(F.lds + RING_OFF, g, S, E); }
#ifndef XRES_BF16
#define XRES_BF16 1
#endif
        else if constexpr (XRES_BF16) { pg8::EpiResid<true, R_BF16 != 0> E{bA, (float*)bB, DN_ALPHA}; pg8::gemm_phase<pg8::EpiResid<true, R_BF16 != 0>, pg8::StaticOrder, ALIGN_P3, FP8_WO != 0>(F.lds + RING_OFF, g, S, E); }
        else { pg8::EpiResid<false, R_BF16 != 0> E{in.x, (float*)bB, DN_ALPHA}; pg8::gemm_phase<pg8::EpiResid<false, R_BF16 != 0>, pg8::StaticOrder, ALIGN_P3>(F.lds + RING_OFF, g, S, E); }
    } SEAM(3);
#ifdef PROBE_P4
    if (IN(4)) { ln_router_phase<R_BF16 != 0, MIX_SPLIT ? 1 : 0>(F, (const float*)bB, in.x, in.ln1_g, in.ln1_b, in.router_w, in.router_b, bA, nullptr, F.ctl + CW_CNT + 2048, (int*)args.out, (float*)args.out + 16 * ECAP); xcd_barrier(bar); }
#endif
    if (IN(4)) REP(4) { RETID(); ln_router_phase<R_BF16 != 0, MIX_SPLIT == 2 ? 2 : MIX_SPLIT ? 1 : 0>(F, (const float*)bB, MIX_SPLIT == 2 ? (const void*)bA : (const void*)in.x, in.ln1_g, in.ln1_b, in.router_w, in.router_b, bA, FP8_L0 ? (unsigned char*)bF : nullptr, F.ctl + CW_CNT, DEST, GATE); } SEAM(4);
    if (IN(5)) REP(5) { RETID();
        const int total = moe_table(F, F.ctl + CW_CNT);
        pg8::MoeOrder S{(const LAS int*)(F.lds + MOETAB_OFF), F.G, (int)blockIdx.x, total, D, DEST, (size_t)D * D, true, (const LAS int*)(F.lds + RING_OFF + pg8::STAGE_BYTES)};
        S.fill_rows((LAS int*)(F.lds + RING_OFF + pg8::STAGE_BYTES));
        if constexpr (FP8_L0) { pg8::Gemm g{bF, ws + WS_WGU, D}; pg8::EpiGateUp8 E{(unsigned char*)bD}; pg8::gemm_phase<pg8::EpiGateUp8, pg8::MoeOrder, true, true, 1, true>(F.lds + RING_OFF, g, S, E); }
        else { pg8::Gemm g{bA, ws + WS_WGU, D}; pg8::EpiGateUp E{bD}; pg8::gemm_phase<pg8::EpiGateUp, pg8::MoeOrder, true>(F.lds + RING_OFF, g, S, E); }
    } SEAM(5);
    if (IN(6)) REP(6) { RETID();
        const int total = (N_LAUNCH_MODE == 1 && IN(5)) ? ((const LAS int*)(F.lds + MOETAB_OFF))[16] * 4 : moe_table(F, F.ctl + CW_CNT);
        pg8::Gemm g{bD, ws + WS_WD, DEXP};
        pg8::MoeOrder S{(const LAS int*)(F.lds + MOETAB_OFF), F.G, (int)blockIdx.x, total, DEXP, DEST, (size_t)D * DEXP, false, nullptr};
        S.fill_dest((LAS int*)(F.lds + RING_OFF + pg8::STAGE_BYTES), GATE);
        pg8::EpiDown<Y2L0_FP8 != 0> E{bB, DEST, GATE, (const LAS int*)(F.lds + RING_OFF + pg8::STAGE_BYTES)};
        pg8::gemm_phase<pg8::EpiDown<Y2L0_FP8 != 0>, pg8::MoeOrder, true, FP8_L0 != 0, 1, true>(F.lds + RING_OFF, g, S, E);
    } SEAM(6);
    if (IN(7)) REP(7) { RETID(); ln2_phase<false, Y2L0_FP8 != 0>(F, bA, bB, in.ln2_g, in.ln2_b, bF, nullptr, FP8_QKV ? (unsigned char*)bD : nullptr); } SEAM(7);
#ifdef PROBE_BARS
    if (IN(7)) for (int xb = 0; xb < PROBE_BARS; ++xb) xcd_barrier(bar);
#endif
    if (IN(8)) REP(8) { RETID();
        pg8::Gemm g{FP8_QKV ? (const void*)bD : (const void*)bF, ws + WS_WQKV, D}; pg8::StaticOrder S; S.init(M, 3 * D, D, F.G, (int)blockIdx.x);
        pg8::EpiBf16 E{bA, D, D, (size_t)(BUFSZ / 2), 1.0f};
#ifdef PROBE_KREP_P8
        pg8::gemm_phase<pg8::EpiBf16, pg8::StaticOrder, true, FP8_QKV != 0, PROBE_KREP_P8>(F.lds + RING_OFF, g, S, E);
#else
        pg8::gemm_phase<pg8::EpiBf16, pg8::StaticOrder, true, FP8_QKV != 0>(F.lds + RING_OFF, g, S, E);
#endif
    } SEAM(8);
    if (IN(9)) REP(9) { RETID();
        LAS float* gs = (LAS float*)(F.lds + LDSCTL_OFF + 2048);
        { int t9 = F.tid; asm volatile("" : "+v"(t9));
          if (t9 < 128) gs[t9] = in.b_subln_g[t9] * (1.0f - LAMBDA_INIT); }
        __syncthreads();
        const attn_body::DiffTensors AT{(const attn_body::bf16*)bA, (const attn_body::bf16*)bB, (const attn_body::bf16*)bC, (attn_body::bf16*)bD, (const float*)(lds + LDSCTL_OFF + 2048), tab[1024]};
        attn_body::attn_phase<8>((char*)lds + RING_OFF, AT, F.vcu, F.G);
    } SEAM(9);
    if (IN(11)) REP(11) { RETID();
        pg8::Gemm g{bD, (const bf16*)(ws + WS_WBO), D}; pg8::StaticOrder S; S.init(M, D, D, F.G, (int)blockIdx.x);
        if constexpr (MIX_SPLIT) { pg8::EpiBf16 E{bA, D, 0, 0, 1.0f}; pg8::gemm_phase<pg8::EpiBf16, pg8::StaticOrder, true>(F.lds + RING_OFF, g, S, E); }
        else { pg8::EpiResid<true, R_BF16 != 0> E{bF, (float*)bA, DN_ALPHA}; pg8::gemm_phase<pg8::EpiResid<true, R_BF16 != 0>, pg8::StaticOrder, ALIGN_P3, ATTN_OUT_FP8 != 0>(F.lds + RING_OFF, g, S, E); }
    } SEAM(11);
    if (IN(12)) REP(12) { RETID(); ln_router_phase<R_BF16 != 0, MIX_SPLIT ? 2 : 0>(F, (const float*)bA, bF, in.ln1_g + D, in.ln1_b + D, in.router_w, in.router_b, bC, FP8_L1 ? (unsigned char*)bE : nullptr, F.ctl + CW_CNT + 1024, DEST, GATE); } SEAM(12);
    if (IN(13)) REP(13) { RETID();
        const int total = moe_table(F, F.ctl + CW_CNT + 1024);
        pg8::MoeOrder S{(const LAS int*)(F.lds + MOETAB_OFF), F.G, (int)blockIdx.x, total, D, DEST, (size_t)D * D, true, (const LAS int*)(F.lds + RING_OFF + pg8::STAGE_BYTES)};
        S.fill_rows((LAS int*)(F.lds + RING_OFF + pg8::STAGE_BYTES));
        if constexpr (FP8_L1) { pg8::Gemm g{bE, ws + WS_WGU + 32 * MiB, D}; pg8::EpiGateUp8 E{(unsigned char*)bD}; pg8::gemm_phase<pg8::EpiGateUp8, pg8::MoeOrder, true, true, 1, true>(F.lds + RING_OFF, g, S, E); }
        else { pg8::Gemm g{bC, ws + WS_WGU + 32 * MiB, D}; pg8::EpiGateUp E{bD}; pg8::gemm_phase<pg8::EpiGateUp, pg8::MoeOrder, true>(F.lds + RING_OFF, g, S, E); }
    } SEAM(13);
    if (IN(14)) REP(14) { RETID();
        const int total = (N_LAUNCH_MODE == 1 && IN(13)) ? ((const LAS int*)(F.lds + MOETAB_OFF))[16] * 4 : moe_table(F, F.ctl + CW_CNT + 1024);
        pg8::Gemm g{bD, ws + WS_WD + 16 * MiB, DEXP};
        pg8::MoeOrder S{(const LAS int*)(F.lds + MOETAB_OFF), F.G, (int)blockIdx.x, total, DEXP, DEST, (size_t)D * DEXP, false, nullptr};
        S.fill_dest((LAS int*)(F.lds + RING_OFF + pg8::STAGE_BYTES), GATE);
        pg8::EpiDown<Y2L1_FP8 != 0> E{bA, DEST, GATE, (const LAS int*)(F.lds + RING_OFF + pg8::STAGE_BYTES)};
        pg8::gemm_phase<pg8::EpiDown<Y2L1_FP8 != 0>, pg8::MoeOrder, true, FP8_L1 != 0, 1, true>(F.lds + RING_OFF, g, S, E);
    } SEAM(14);
#ifdef DIAG_PHASE
    if (IN(15)) REP(15) { RETID();
        const unsigned long long* ts = (const unsigned long long*)(ws + WS_TAB + 8192);
        const float us = (float)(__hip_atomic_load(ts + DIAG_PHASE + 1, RLX_AGENT) - __hip_atomic_load(ts + DIAG_PHASE, RLX_AGENT)) * 0.01f, cval = sqrtf(us);
        const int gw = F.vcu * NWAVES + F.wave, NGW = F.G * NWAVES;
        for (int m = gw; m < M; m += NGW) { GAS f32x4* o = (GAS f32x4*)(args.out + (size_t)m * D) + F.lane;
#pragma unroll
            for (int j = 0; j < 4; ++j) o[64 * j] = (f32x4){cval, cval, cval, cval}; }
    }
#else
    if (IN(15)) REP(15) { RETID(); ln2_phase<true, Y2L1_FP8 != 0>(F, bC, bA, in.ln2_g + D, in.ln2_b + D, nullptr, args.out); }
#endif
#undef IN
#undef SEAM
}

extern "C" void kernel_launch(void* const* d_in, const int* in_sizes, int n_in, void* d_out, int out_size, void* d_ws, size_t ws_size, hipStream_t stream) {
    static int grid = 0;
    if (grid == 0) {
        if (n_in != 19 || in_sizes[0] != M * D || out_size != M * D || ws_size < WS_END) { fprintf(stderr, "kernel_launch: unexpected shapes (n_in %d, in0 %d, out %d, ws %zu); nothing launched\n", n_in, n_in > 0 ? in_sizes[0] : -1, out_size, ws_size); grid = -1; return; }
        int dev = 0, cus = 0, per_cu = 0;
        if (hipGetDevice(&dev) != hipSuccess || hipDeviceGetAttribute(&cus, hipDeviceAttributeMultiprocessorCount, dev) != hipSuccess) { grid = -1; return; }
        if (hipFuncSetAttribute((const void*)yoco_fwd, hipFuncAttributeMaxDynamicSharedMemorySize, LDS_BYTES) != hipSuccess) { fprintf(stderr, "kernel_launch: hipFuncSetAttribute failed\n"); grid = -1; return; }
        if (hipOccupancyMaxActiveBlocksPerMultiprocessor(&per_cu, (const void*)yoco_fwd, NWAVES * 64, LDS_BYTES) != hipSuccess || per_cu < 1) { fprintf(stderr, "kernel_launch: occupancy query reports %d workgroups per CU\n", per_cu); }
        (void)hipGetLastError();
        grid = cus;
    }
    if (grid < 0) return;
    if (hipMemsetAsync((char*)d_ws + WS_CTL, 0, CTL_ZERO_BYTES, stream) != hipSuccess) return;
    Args a{};
    for (int i = 0; i < 19; ++i) a.in[i] = (const float*)d_in[i];
    a.out = (float*)d_out; a.ws = (unsigned char*)d_ws;
#ifdef PROBE_REPEAT
    if (N_LAUNCH_MODE == 1) { const int cuts[4] = {0, PROBE_REPEAT + 1, PROBE_REPEAT + 1, N_PHASES};
        for (int l = 0; l < 3; ++l) { a.ph_lo = (l == 1) ? PROBE_REPEAT : cuts[l]; a.ph_hi = cuts[l + 1]; a.li = l; if (a.ph_lo < a.ph_hi) hipLaunchKernelGGL(yoco_fwd, dim3(grid), dim3(NWAVES * 64), LDS_BYTES, stream, a); } }
#else
    if (N_LAUNCH_MODE == 1) { a.ph_lo = 0; a.ph_hi = N_PHASES; hipLaunchKernelGGL(yoco_fwd, dim3(grid), dim3(NWAVES * 64), LDS_BYTES, stream, a); }
#endif
    else for (int p = 0; p < N_PHASES; ++p) { a.ph_lo = p; a.ph_hi = p + 1; hipLaunchKernelGGL(yoco_fwd, dim3(grid), dim3(NWAVES * 64), LDS_BYTES, stream, a); }
}
```
